# Optimizing an MI355X kernel written in HIP

```python
import jax, jax.numpy as jnp
from jax import lax
import numpy as np

D_MODEL = 1024
BATCH = 32
SEQ = 2048
DEPTH = 1

CONV_WIDTH = 512
CONV_GROUPS = 8
CONV_K = 3
SB_HEADS = 8
SB_HEAD_DIM = 64
SB_WIDTH = SB_HEADS * SB_HEAD_DIM
MIX_WIDTH = CONV_WIDTH + SB_WIDTH
PROJ_WIDTH = 3 * CONV_WIDTH + 3 * SB_WIDTH
SPLITS = (CONV_WIDTH, 2 * CONV_WIDTH, 3 * CONV_WIDTH,
          3 * CONV_WIDTH + SB_WIDTH, 3 * CONV_WIDTH + 2 * SB_WIDTH)
Q_BLOCK = 128
MEM_LEN = 256
MEM_HEADS = 4
MEM_HEAD_DIM = D_MODEL // MEM_HEADS
N_GROUPS = 4
EXPERTS_PER_GROUP = 8
N_EXPERTS = N_GROUPS * EXPERTS_PER_GROUP
TOP_K = 2
D_EXPERT = D_MODEL // 2
DISPATCH_BLOCK = 256
DEEPNORM_ALPHA = (2 * DEPTH) ** 0.25
DEEPNORM_BETA = (8 * DEPTH) ** -0.25
LN_EPS = 1e-5
RMS_EPS = 1e-6

kernel_name = 'hybrid_conv_stickbreak_memxattn_hmoe_deepnorm'


def layer_norm(x, g, b):
    xf = x.astype(jnp.float32)
    mu = jnp.mean(xf, axis=-1, keepdims=True)
    var = jnp.mean(jnp.square(xf - mu), axis=-1, keepdims=True)
    y = (xf - mu) * lax.rsqrt(var + LN_EPS) * g.astype(jnp.float32) + b.astype(jnp.float32)
    return y.astype(x.dtype)


def group_rms_norm(y, n_groups, gain):
    bn, s, w = y.shape
    yf = y.astype(jnp.float32).reshape(bn, s, n_groups, w // n_groups)
    yf = yf * lax.rsqrt(jnp.mean(jnp.square(yf), axis=-1, keepdims=True) + RMS_EPS)
    return (yf.reshape(bn, s, w) * gain.astype(jnp.float32)).astype(y.dtype)


def causal_depthwise_conv(u, w):
    c = u.shape[-1]
    return lax.conv_general_dilated(
        u, w.astype(u.dtype)[:, None, :], window_strides=(1,),
        padding=[(CONV_K - 1, 0)], dimension_numbers=('NWC', 'WIO', 'NWC'),
        feature_group_count=c)


def stick_breaking_attention(q, k, v):
    s_len = q.shape[1]
    scale = SB_HEAD_DIM ** -0.5
    outs = []
    for start in range(0, s_len, Q_BLOCK):
        end = start + Q_BLOCK
        z = jnp.einsum('bqhd,bkhd->bhqk', q[:, start:end], k[:, :end]).astype(jnp.float32) * scale
        t_pos = start + jnp.arange(Q_BLOCK)[:, None]
        s_pos = jnp.arange(end)[None, :]
        before = s_pos < t_pos
        log1m = jnp.where(before, jax.nn.log_sigmoid(-z), 0.0)
        between = lax.cumsum(log1m, axis=3, reverse=True) - log1m
        a = jnp.where(before, jnp.exp(jax.nn.log_sigmoid(z) + between), 0.0)
        outs.append(jnp.einsum('bhqk,bkhd->bqhd', a.astype(v.dtype), v[:, :end]))
    return jnp.concatenate(outs, axis=1)


def hybrid_mixer(x, w_in, conv_w, gn_conv, gn_sb, w_out):
    bn, s, _ = x.shape
    proj = x @ w_in
    cb, cc, ch, q, k, v = jnp.split(proj, SPLITS, axis=-1)
    y_conv = cb * causal_depthwise_conv(cc * ch, conv_w)
    y_conv = group_rms_norm(y_conv, CONV_GROUPS, gn_conv)
    heads = lambda t: t.reshape(bn, s, SB_HEADS, SB_HEAD_DIM)
    y_sb = stick_breaking_attention(heads(q), heads(k), heads(v)).reshape(bn, s, SB_WIDTH)
    y_sb = group_rms_norm(y_sb, SB_HEADS, gn_sb)
    return jnp.concatenate([y_conv, y_sb], axis=-1) @ w_out


def memory_cross_attention(x, mem, w_q, w_k, w_v, w_o):
    bn, s, d = x.shape
    q = (x @ w_q).reshape(bn, s, MEM_HEADS, MEM_HEAD_DIM)
    k = (mem @ w_k).reshape(bn, MEM_LEN, MEM_HEADS, MEM_HEAD_DIM)
    v = (mem @ w_v).reshape(bn, MEM_LEN, MEM_HEADS, MEM_HEAD_DIM)
    sc = jnp.einsum('bqhd,bmhd->bhqm', q, k).astype(jnp.float32) * (MEM_HEAD_DIM ** -0.5)
    p = jax.nn.softmax(sc, axis=-1).astype(v.dtype)
    o = jnp.einsum('bhqm,bmhd->bqhd', p, v).reshape(bn, s, d)
    return o @ w_o


def routed_experts(xf, expert_id, gate, w_gate, w_up, w_down):
    n, d = xf.shape
    n_assign = n * TOP_K
    flat_e = expert_id.reshape(n_assign)
    order = jnp.argsort(flat_e)
    sorted_e = flat_e[order]
    tok = order // TOP_K
    counts = jnp.bincount(flat_e, length=N_EXPERTS)
    padded = (counts + DISPATCH_BLOCK - 1) // DISPATCH_BLOCK * DISPATCH_BLOCK
    padded_end = jnp.cumsum(padded)
    padded_start = padded_end - padded
    start = jnp.cumsum(counts) - counts
    dest = padded_start[sorted_e] + jnp.arange(n_assign) - start[sorted_e]
    n_blocks = -(-n_assign // DISPATCH_BLOCK) + N_EXPERTS
    block_expert = jnp.minimum(
        jnp.searchsorted(padded_end, jnp.arange(n_blocks) * DISPATCH_BLOCK, side='right'),
        N_EXPERTS - 1)
    xs = jnp.zeros((n_blocks * DISPATCH_BLOCK, d), xf.dtype).at[dest].set(xf[tok])

    def expert_block(args):
        xb, e = args
        h = jax.nn.silu(xb @ w_gate[e]) * (xb @ w_up[e])
        return h @ w_down[e]

    ys = lax.map(expert_block, (xs.reshape(n_blocks, DISPATCH_BLOCK, d), block_expert))
    ys = ys.reshape(-1, d)[dest] * gate.reshape(n_assign)[order][:, None].astype(xf.dtype)
    return jnp.zeros_like(xf).at[tok].add(ys)


def hierarchical_moe(x, w_rg, b_rg, w_re, b_re, w_gate, w_up, w_down):
    bn, s, d = x.shape
    xf = x.reshape(-1, d)
    n = xf.shape[0]
    g_logits = (xf @ w_rg).astype(jnp.float32) + b_rg.astype(jnp.float32)
    g_prob = jax.nn.softmax(g_logits, axis=-1)
    grp = jnp.argmax(g_logits, axis=-1)
    e_logits = ((xf @ w_re).astype(jnp.float32) + b_re.astype(jnp.float32)).reshape(
        n, N_GROUPS, EXPERTS_PER_GROUP)
    e_in_grp = jnp.take_along_axis(e_logits, grp[:, None, None], axis=1)[:, 0]
    top_logit, top_idx = lax.top_k(e_in_grp, TOP_K)
    gate = jnp.take_along_axis(g_prob, grp[:, None], axis=1) * jax.nn.softmax(top_logit, axis=-1)
    expert_id = grp[:, None] * EXPERTS_PER_GROUP + top_idx
    return routed_experts(xf, expert_id, gate, w_gate, w_up, w_down).reshape(bn, s, d)


def setup_inputs(seed: int = 0) -> dict:
    key = jax.random.key(seed)
    ks = jax.random.split(key, 26)
    L = DEPTH
    nrm = lambda k, shape, sc: jax.random.normal(k, shape, jnp.float32) * sc
    gain = lambda k, shape: 1.0 + 0.02 * jax.random.normal(k, shape, jnp.float32)
    bias = lambda k, shape: 0.02 * jax.random.normal(k, shape, jnp.float32)
    in_col_scale = jnp.asarray(np.concatenate([
        np.ones(PROJ_WIDTH - SB_WIDTH, np.float32),
        np.full(SB_WIDTH, DEEPNORM_BETA, np.float32)]))
    return {
        'x': nrm(ks[0], (BATCH, SEQ, D_MODEL), 1.0),
        'mem': nrm(ks[1], (BATCH, MEM_LEN, D_MODEL), 1.0),
        'w_in': nrm(ks[2], (L, D_MODEL, PROJ_WIDTH), D_MODEL ** -0.5) * in_col_scale,
        'conv_w': nrm(ks[3], (L, CONV_K, CONV_WIDTH), CONV_K ** -0.5),
        'gn_conv': gain(ks[4], (L, CONV_WIDTH)),
        'gn_sb': gain(ks[5], (L, SB_WIDTH)),
        'w_out': nrm(ks[6], (L, MIX_WIDTH, D_MODEL), MIX_WIDTH ** -0.5 * DEEPNORM_BETA),
        'ln1_g': gain(ks[7], (L, D_MODEL)),
        'ln1_b': bias(ks[8], (L, D_MODEL)),
        'w_mq': nrm(ks[9], (L, D_MODEL, D_MODEL), D_MODEL ** -0.5),
        'w_mk': nrm(ks[10], (L, D_MODEL, D_MODEL), D_MODEL ** -0.5),
        'w_mv': nrm(ks[11], (L, D_MODEL, D_MODEL), D_MODEL ** -0.5 * DEEPNORM_BETA),
        'w_mo': nrm(ks[12], (L, D_MODEL, D_MODEL), D_MODEL ** -0.5 * DEEPNORM_BETA),
        'ln2_g': gain(ks[13], (L, D_MODEL)),
        'ln2_b': bias(ks[14], (L, D_MODEL)),
        'w_router_group': nrm(ks[15], (L, D_MODEL, N_GROUPS), D_MODEL ** -0.5),
        'b_router_group': nrm(ks[16], (L, N_GROUPS), 0.01),
        'w_router_expert': nrm(ks[17], (L, D_MODEL, N_EXPERTS), D_MODEL ** -0.5),
        'b_router_expert': nrm(ks[18], (L, N_EXPERTS), 0.01),
        'w_gate': nrm(ks[19], (L, N_EXPERTS, D_MODEL, D_EXPERT), D_MODEL ** -0.5),
        'w_up': nrm(ks[20], (L, N_EXPERTS, D_MODEL, D_EXPERT), D_MODEL ** -0.5),
        'w_down': nrm(ks[21], (L, N_EXPERTS, D_EXPERT, D_MODEL), D_EXPERT ** -0.5 * DEEPNORM_BETA),
        'ln3_g': gain(ks[22], (L, D_MODEL)),
        'ln3_b': bias(ks[23], (L, D_MODEL)),
    }


def reference(x, mem, w_in, conv_w, gn_conv, gn_sb, w_out, ln1_g, ln1_b,
              w_mq, w_mk, w_mv, w_mo, ln2_g, ln2_b,
              w_router_group, b_router_group, w_router_expert, b_router_expert,
              w_gate, w_up, w_down, ln3_g, ln3_b):
    for l in range(DEPTH):
        h = hybrid_mixer(x, w_in[l], conv_w[l], gn_conv[l], gn_sb[l], w_out[l])
        x = layer_norm(DEEPNORM_ALPHA * x + h, ln1_g[l], ln1_b[l])
        h = memory_cross_attention(x, mem, w_mq[l], w_mk[l], w_mv[l], w_mo[l])
        x = layer_norm(DEEPNORM_ALPHA * x + h, ln2_g[l], ln2_b[l])
        h = hierarchical_moe(x, w_router_group[l], b_router_group[l],
                             w_router_expert[l], b_router_expert[l],
                             w_gate[l], w_up[l], w_down[l])
        x = layer_norm(DEEPNORM_ALPHA * x + h, ln3_g[l], ln3_b[l])
    return x
```

```cpp
#include <hip/hip_runtime.h>
#include <hip/hip_cooperative_groups.h>
#include <cstdio>
#include <cstdint>
namespace cg = cooperative_groups;

#ifndef MK_ONE_LAUNCH
#define MK_ONE_LAUNCH 0
#endif

typedef unsigned short bf16_t;
typedef short bf16x8 __attribute__((ext_vector_type(8)));
typedef float f32x4 __attribute__((ext_vector_type(4)));
typedef float f32x16 __attribute__((ext_vector_type(16)));
typedef unsigned u32x4 __attribute__((ext_vector_type(4)));
typedef unsigned u32x2 __attribute__((ext_vector_type(2)));

constexpr int NB = 32, SEQ = 2048, DM = 1024, NTOK = NB * SEQ;
constexpr int MEML = 256, NMEM = NB * MEML;
constexpr int NPROJ = 2560;
constexpr int PW = 3072;
constexpr int C_CB = 0, C_CC = 512, C_CH = 1024, C_Q = 1536, C_K = 2048, C_V = 2560;
constexpr int NHEAD = 8, HD = 64;
constexpr int MH = 4, MHD = 256;
constexpr int NEXP = 32, DEXP = 512, NLOG = 36, NLOGP = 64;
constexpr int CAP = 2 * NTOK;
constexpr float ALPHA = 1.189207115002721f;
constexpr float LN_EPS = 1e-5f, RMS_EPS = 1e-6f;
constexpr float LOG2E = 1.4426950408889634f;
constexpr float QS_SB = 0.125f * LOG2E;
constexpr float QS_X = 0.0625f * LOG2E;

constexpr size_t MiB = 1u << 20;
constexpr size_t WS_STATS1 = 0;
constexpr size_t WS_STATS2 = 1 * MiB;
constexpr size_t WS_CNT = 2 * MiB;
constexpr size_t WS_CS1 = 2 * MiB + 4096;
constexpr size_t WS_CS2 = WS_CS1 + 8192;
constexpr size_t WS_CSGU = 3 * MiB;
constexpr size_t WS_EID = 4 * MiB;
constexpr size_t WS_GATE = 5 * MiB;
constexpr size_t WS_LOGIT = 8 * MiB;
constexpr size_t WS_ROWL = 24 * MiB;
constexpr size_t WS_WRT = 40 * MiB;
constexpr size_t WS_WIN = 64 * MiB;
constexpr size_t WS_WOUT = 70 * MiB;
constexpr size_t WS_WMQ = 72 * MiB, WS_WMK = 74 * MiB, WS_WMV = 76 * MiB, WS_WMO = 78 * MiB;
constexpr size_t WS_WGU = 80 * MiB;
constexpr size_t WS_WD = 144 * MiB;
constexpr size_t WS_XB = 192 * MiB;
constexpr size_t WS_T1B = 192 * MiB;
constexpr size_t WS_MEMB = 320 * MiB;
constexpr size_t WS_MEMK = 336 * MiB;
constexpr size_t WS_MEMVT = 352 * MiB;
constexpr size_t WS_PROJ = 368 * MiB;
constexpr size_t WS_QM = 368 * MiB;
constexpr size_t WS_OB = 496 * MiB;
constexpr size_t WS_Y = 368 * MiB;
constexpr size_t WS_VT = 688 * MiB;
constexpr size_t WS_YMIX = 752 * MiB;
constexpr size_t WS_T2B = 752 * MiB;
constexpr size_t WS_H = 880 * MiB;
constexpr size_t WS_END = 1016 * MiB;

constexpr int LDS_BYTES = 147456;
constexpr int NPHASE = 12;

struct Params {
    const float *x, *mem, *w_in, *conv_w, *gn_conv, *gn_sb, *w_out, *ln1_g, *ln1_b, *w_mq, *w_mk, *w_mv, *w_mo, *ln2_g, *ln2_b,
        *w_rg, *b_rg, *w_re, *b_re, *w_gate, *w_up, *w_down, *ln3_g, *ln3_b;
    float* out; unsigned char* ws; int ph_lo, ph_hi;
};

__device__ __forceinline__ float bf2f(bf16_t v) { return __uint_as_float((unsigned)v << 16); }
__device__ __forceinline__ bf16_t f2bf(float f) { unsigned u = __float_as_uint(f); return (bf16_t)((u + 0x7fffu + ((u >> 16) & 1u)) >> 16); }
__device__ __forceinline__ unsigned pk2(float lo, float hi) { return (unsigned)f2bf(lo) | ((unsigned)f2bf(hi) << 16); }
__device__ __forceinline__ float wave_sum(float v) {
#pragma unroll
    for (int o = 1; o < 64; o <<= 1) v += __shfl_xor(v, o);
    return v;
}
__device__ __forceinline__ float wave_max(float v) {
#pragma unroll
    for (int o = 1; o < 64; o <<= 1) v = fmaxf(v, __shfl_xor(v, o));
    return v;
}
#define MFMA32(a, b, c) __builtin_amdgcn_mfma_f32_32x32x16_bf16((a), (b), (c), 0, 0, 0)

template <int NBLK, class AR, class BR>
__device__ __forceinline__ void wave_tile(int K, AR arow, BR brow, f32x16 (&c)[2][2 * NBLK]) {
    const int lane = threadIdx.x & 63, r = lane & 31, h = lane >> 5;
    const bf16_t* ap[2]; const bf16_t* bp[2 * NBLK];
#pragma unroll
    for (int i = 0; i < 2; ++i) ap[i] = arow(32 * i + r) + 8 * h;
#pragma unroll
    for (int j = 0; j < 2 * NBLK; ++j) bp[j] = brow(32 * j + r) + 8 * h;
#pragma unroll
    for (int i = 0; i < 2; ++i)
#pragma unroll
        for (int j = 0; j < 2 * NBLK; ++j)
#pragma unroll
            for (int q = 0; q < 16; ++q) c[i][j][q] = 0.f;
#pragma unroll 2
    for (int k = 0; k < K; k += 16) {
        bf16x8 fa[2], fb[2 * NBLK];
#pragma unroll
        for (int i = 0; i < 2; ++i) fa[i] = *(const bf16x8*)(ap[i] + k);
#pragma unroll
        for (int j = 0; j < 2 * NBLK; ++j) fb[j] = *(const bf16x8*)(bp[j] + k);
#pragma unroll
        for (int i = 0; i < 2; ++i)
#pragma unroll
            for (int j = 0; j < 2 * NBLK; ++j) c[i][j] = MFMA32(fa[i], fb[j], c[i][j]);
    }
}
#define TROW(i, q) (32 * (i) + ((q) & 3) + 8 * ((q) >> 2) + 4 * ((int)(threadIdx.x & 63) >> 5))
#define TCOL(j) (32 * (j) + (int)(threadIdx.x & 31))

struct RowStat { float mean, rstd; };
__device__ __forceinline__ RowStat row_stat(const float* st, int row) {
    const float s = st[2 * row], q = st[2 * row + 1];
    RowStat r; r.mean = s * (1.f / DM); const float var = fmaxf(q * (1.f / DM) - r.mean * r.mean, 0.f); r.rstd = 1.0f / sqrtf(var + LN_EPS); return r;
}

__device__ __forceinline__ void transpose_item(const float* W, int K, int N, int k0, int n0, bf16_t* WT, int orow0, const float* ks, float ns, float* scr, int lane) {
#pragma unroll 8
    for (int i = 0; i < 32; ++i) { const int kk = 2 * i + (lane >> 5); float v = W[(size_t)(k0 + kk) * N + n0 + (lane & 31)]; if (ks) v *= ks[k0 + kk]; scr[kk * 33 + (lane & 31)] = v * ns; }
    asm volatile("s_waitcnt vmcnt(0) lgkmcnt(0)" ::: "memory");
    const int c = lane & 7;
#pragma unroll
    for (int j = 0; j < 4; ++j) { const int n = (lane >> 3) + 8 * j; const float* s = scr + (8 * c) * 33 + n;
        u32x4 o; o.x = pk2(s[0 * 33], s[1 * 33]); o.y = pk2(s[2 * 33], s[3 * 33]); o.z = pk2(s[4 * 33], s[5 * 33]); o.w = pk2(s[6 * 33], s[7 * 33]);
        *(u32x4*)(WT + (size_t)(orow0 + n) * K + k0 + 8 * c) = o; }
    asm volatile("s_waitcnt lgkmcnt(0)" ::: "memory");
}
__device__ void phase_prep(const Params& p, unsigned char* lds) {
    unsigned char* ws = p.ws;
    const int tid = threadIdx.x, lane = tid & 63, wave = tid >> 6;
    const int gw = blockIdx.x * 8 + wave, NGW = gridDim.x * 8;
    const int gt = blockIdx.x * 512 + tid, NGT = gridDim.x * 512;
    float* scr = (float*)(lds + wave * 16384);
    bf16_t* WIN = (bf16_t*)(ws + WS_WIN); bf16_t* WOUT = (bf16_t*)(ws + WS_WOUT); bf16_t* WMQ = (bf16_t*)(ws + WS_WMQ); bf16_t* WMK = (bf16_t*)(ws + WS_WMK);
    bf16_t* WMV = (bf16_t*)(ws + WS_WMV); bf16_t* WMO = (bf16_t*)(ws + WS_WMO); bf16_t* WGU = (bf16_t*)(ws + WS_WGU); bf16_t* WD = (bf16_t*)(ws + WS_WD);
    constexpr int I_IN = 16 * 96, I_SQ = 16 * 32, I_G = 32 * 16 * 16, I_D = 32 * 8 * 32;
    constexpr int NITEMS = I_IN + 5 * I_SQ + 2 * I_G + I_D;
    for (int it = gw; it < NITEMS; it += NGW) {
        int r = it;
        if (r < I_IN) { const int kb = r / 96, nb = r % 96, n0 = nb * 32; transpose_item(p.w_in, DM, PW, kb * 64, n0, WIN, n0, nullptr, (n0 >= C_Q && n0 < C_K) ? QS_SB : 1.f, scr, lane); continue; } r -= I_IN;
        if (r < I_SQ) { transpose_item(p.w_out, DM, DM, (r / 32) * 64, (r % 32) * 32, WOUT, (r % 32) * 32, nullptr, 1.f, scr, lane); continue; } r -= I_SQ;
        if (r < I_SQ) { transpose_item(p.w_mq, DM, DM, (r / 32) * 64, (r % 32) * 32, WMQ, (r % 32) * 32, p.ln1_g, QS_X, scr, lane); continue; } r -= I_SQ;
        if (r < I_SQ) { transpose_item(p.w_mk, DM, DM, (r / 32) * 64, (r % 32) * 32, WMK, (r % 32) * 32, nullptr, 1.f, scr, lane); continue; } r -= I_SQ;
        if (r < I_SQ) { transpose_item(p.w_mv, DM, DM, (r / 32) * 64, (r % 32) * 32, WMV, (r % 32) * 32, nullptr, 1.f, scr, lane); continue; } r -= I_SQ;
        if (r < I_SQ) { transpose_item(p.w_mo, DM, DM, (r / 32) * 64, (r % 32) * 32, WMO, (r % 32) * 32, nullptr, 1.f, scr, lane); continue; } r -= I_SQ;
        if (r < 2 * I_G) { const int up = r >= I_G; if (up) r -= I_G; const int e = r / 256, q = r % 256, kb = q / 16, nb = q % 16, n0 = nb * 32;
            const float* W = (up ? p.w_up : p.w_gate) + (size_t)e * DM * DEXP; const int orow0 = 256 * (n0 / 128) + (up ? 128 : 0) + (n0 % 128);
            transpose_item(W, DM, DEXP, kb * 64, n0, WGU + (size_t)e * 1024 * 1024, orow0, p.ln2_g, 1.f, scr, lane); continue; } r -= 2 * I_G;
        { const int e = r / 256, q = r % 256, kb = q / 32, nb = q % 32; transpose_item(p.w_down + (size_t)e * DEXP * DM, DEXP, DM, kb * 64, nb * 32, WD + (size_t)e * 1024 * 512, nb * 32, nullptr, 1.f, scr, lane); }
    }
    { bf16_t* WRT = (bf16_t*)(ws + WS_WRT);
      for (int i = gt; i < 256 * DM; i += NGT) { const int n = i / DM, k = i % DM; float v = 0.f;
          if (n < 4) v = p.w_rg[k * 4 + n] * p.ln2_g[k]; else if (n < NLOG) v = p.w_re[k * 32 + (n - 4)] * p.ln2_g[k];
          WRT[i] = f2bf(v); } }
    { float* cs1 = (float*)(ws + WS_CS1); float* bs1 = cs1 + 1024; float* cs2 = (float*)(ws + WS_CS2); float* bs2 = cs2 + 64;
      float* csg = (float*)(ws + WS_CSGU); float* bsg = csg + NEXP * 1024;
      constexpr int NV = 1024 + 64 + NEXP * 1024;
      for (int i = gt; i < NV; i += NGT) {
          if (i < 1024) { const int n = i; float cs = 0.f, bs = 0.f;
              for (int k = 0; k < DM; ++k) { const float w = p.w_mq[(size_t)k * DM + n]; cs += bf2f(f2bf(w * p.ln1_g[k] * QS_X)); bs += p.ln1_b[k] * w; }
              cs1[n] = cs; bs1[n] = bs * QS_X; }
          else if (i < 1088) { const int n = i - 1024; float cs = 0.f, bs = 0.f;
              if (n < NLOG) { for (int k = 0; k < DM; ++k) { const float w = n < 4 ? p.w_rg[k * 4 + n] : p.w_re[k * 32 + (n - 4)]; cs += bf2f(f2bf(w * p.ln2_g[k])); bs += p.ln2_b[k] * w; }
                  bs += n < 4 ? p.b_rg[n] : p.b_re[n - 4]; }
              cs2[n] = cs; bs2[n] = bs; }
          else { const int j = i - 1088, e = j / 1024, row = j % 1024, pn = row / 256, rr = row % 256, up = rr >= 128, n = pn * 128 + (rr & 127);
              const float* W = (up ? p.w_up : p.w_gate) + (size_t)e * DM * DEXP; float cs = 0.f, bs = 0.f;
              for (int k = 0; k < DM; ++k) { const float w = W[(size_t)k * DEXP + n]; cs += bf2f(f2bf(w * p.ln2_g[k])); bs += p.ln2_b[k] * w; }
              csg[j] = cs; bsg[j] = bs; }
      } }
    { bf16_t* XB = (bf16_t*)(ws + WS_XB); bf16_t* MB = (bf16_t*)(ws + WS_MEMB);
      const f32x4* x4 = (const f32x4*)p.x; u32x2* xb2 = (u32x2*)XB;
      for (int i = gt; i < NTOK * DM / 4; i += NGT) { const f32x4 v = x4[i]; u32x2 o; o.x = pk2(v.x, v.y); o.y = pk2(v.z, v.w); xb2[i] = o; }
      const f32x4* m4 = (const f32x4*)p.mem; u32x2* mb2 = (u32x2*)MB;
      for (int i = gt; i < NMEM * DM / 4; i += NGT) { const f32x4 v = m4[i]; u32x2 o; o.x = pk2(v.x, v.y); o.y = pk2(v.z, v.w); mb2[i] = o; } }
    { float* s1 = (float*)(ws + WS_STATS1); float* s2 = (float*)(ws + WS_STATS2); unsigned* cnt = (unsigned*)(ws + WS_CNT);
      for (int i = gt; i < 2 * NTOK; i += NGT) { s1[i] = 0.f; s2[i] = 0.f; }
      if (gt < 64) cnt[gt] = 0u; }
}

__device__ void phase_proj_simple(const Params& p) {
    unsigned char* ws = p.ws; const int wave = threadIdx.x >> 6; const int gw = blockIdx.x * 8 + wave, NGW = gridDim.x * 8;
    const bf16_t* XB = (const bf16_t*)(ws + WS_XB); const bf16_t* WIN = (const bf16_t*)(ws + WS_WIN); const bf16_t* MB = (const bf16_t*)(ws + WS_MEMB);
    const bf16_t* WMK = (const bf16_t*)(ws + WS_WMK); const bf16_t* WMV = (const bf16_t*)(ws + WS_WMV);
    bf16_t* PROJ = (bf16_t*)(ws + WS_PROJ); bf16_t* VT = (bf16_t*)(ws + WS_VT); bf16_t* MK = (bf16_t*)(ws + WS_MEMK); bf16_t* MVT = (bf16_t*)(ws + WS_MEMVT);
    constexpr int TA = (NTOK / 64) * (NPROJ / 64), TB = (512 / 64) * (NTOK / 64), TC = (NMEM / 64) * (DM / 64), TD = (DM / 64) * (NMEM / 64);
    for (int t = gw; t < TA + TB + TC + TD; t += NGW) {
        const bf16_t *A, *Bt; bf16_t* O; int ldo, tm, tn, r = t;
        if (r < TA) { A = XB; Bt = WIN; O = PROJ; ldo = NPROJ; tm = r / (NPROJ / 64); tn = r % (NPROJ / 64); }
        else if ((r -= TA) < TB) { A = WIN + (size_t)C_V * DM; Bt = XB; O = VT; ldo = NTOK; tm = r / (NTOK / 64); tn = r % (NTOK / 64); }
        else if ((r -= TB) < TC) { A = MB; Bt = WMK; O = MK; ldo = DM; tm = r / (DM / 64); tn = r % (DM / 64); }
        else { r -= TC; A = WMV; Bt = MB; O = MVT; ldo = NMEM; tm = r / (NMEM / 64); tn = r % (NMEM / 64); }
        f32x16 c[2][2];
        wave_tile<1>(DM, [&](int i) { return A + (size_t)(tm * 64 + i) * DM; }, [&](int j) { return Bt + (size_t)(tn * 64 + j) * DM; }, c);
#pragma unroll
        for (int i = 0; i < 2; ++i)
#pragma unroll
            for (int j = 0; j < 2; ++j)
#pragma unroll
                for (int q = 0; q < 16; ++q) O[(size_t)(tm * 64 + TROW(i, q)) * ldo + tn * 64 + TCOL(j)] = f2bf(c[i][j][q]);
    }
}

__device__ void phase_conv_simple(const Params& p) {
    unsigned char* ws = p.ws; const int lane = threadIdx.x & 63, wave = threadIdx.x >> 6; const int gw = blockIdx.x * 8 + wave, NGW = gridDim.x * 8;
    const bf16_t* PROJ = (const bf16_t*)(ws + WS_PROJ); bf16_t* YMIX = (bf16_t*)(ws + WS_YMIX);
    for (int it = gw; it < NTOK * 8; it += NGW) {
        const int tok = it >> 3, g = it & 7, c = g * 64 + lane, t = tok % SEQ;
        float acc = 0.f;
#pragma unroll
        for (int k = 0; k < 3; ++k) { const int tt = t - 2 + k; if (tt >= 0) { const bf16_t* row = PROJ + (size_t)(tok - 2 + k) * NPROJ; acc += p.conv_w[k * 512 + c] * (bf2f(row[C_CC + c]) * bf2f(row[C_CH + c])); } }
        const float y = bf2f(PROJ[(size_t)tok * NPROJ + C_CB + c]) * acc;
        const float ms = wave_sum(y * y) * (1.f / 64.f);
        YMIX[(size_t)tok * DM + c] = f2bf(y * (1.0f / sqrtf(ms + RMS_EPS)) * p.gn_conv[c]);
    }
}
__device__ void phase_sb_simple(const Params& p) {
    unsigned char* ws = p.ws; const int lane = threadIdx.x & 63, wave = threadIdx.x >> 6; const int gw = blockIdx.x * 8 + wave, NGW = gridDim.x * 8;
    const bf16_t* PROJ = (const bf16_t*)(ws + WS_PROJ); const bf16_t* VT = (const bf16_t*)(ws + WS_VT); bf16_t* YMIX = (bf16_t*)(ws + WS_YMIX);
    for (int it = gw; it < NTOK * NHEAD; it += NGW) {
        const int tok = it / NHEAD, h = it % NHEAD, b = tok / SEQ, t = tok % SEQ;
        float q[64], o[64];
        { const bf16_t* qp = PROJ + (size_t)tok * NPROJ + C_Q + h * 64;
#pragma unroll
          for (int d = 0; d < 64; ++d) { q[d] = bf2f(qp[d]); o[d] = 0.f; } }
        float R = 0.f;
        for (int c0 = t - 1; c0 >= 0; c0 -= 64) {
            const int s = c0 - lane; const bool valid = s >= 0; const int sc = valid ? s : 0;
            const bf16_t* kp = PROJ + (size_t)(b * SEQ + sc) * NPROJ + C_K + h * 64;
            float dot = 0.f;
#pragma unroll
            for (int d8 = 0; d8 < 8; ++d8) { const bf16x8 kv = *(const bf16x8*)(kp + d8 * 8);
#pragma unroll
                for (int j = 0; j < 8; ++j) dot += q[d8 * 8 + j] * bf2f((bf16_t)kv[j]); }
            const float sp = fmaxf(dot, 0.f) + __log2f(1.0f + exp2f(-fabsf(dot)));
            const float L = valid ? -sp : 0.f;
            float incl = L;
#pragma unroll
            for (int off = 1; off < 64; off <<= 1) { const float n = __shfl_up(incl, off); if (lane >= off) incl += n; }
            const float w = valid ? exp2f(dot + L + (R + incl - L)) : 0.f;
            R += __shfl(incl, 63);
            const bf16_t* vp = VT + (size_t)(h * 64) * NTOK + b * SEQ + sc;
#pragma unroll
            for (int d = 0; d < 64; ++d) o[d] += w * bf2f(vp[(size_t)d * NTOK]);
        }
        float ss = 0.f, mine = 0.f;
#pragma unroll
        for (int d = 0; d < 64; ++d) { const float v = wave_sum(o[d]); ss += v * v; if (d == lane) mine = v; }
        YMIX[(size_t)tok * DM + 512 + h * 64 + lane] = f2bf(mine * (1.0f / sqrtf(ss * (1.f / 64.f) + RMS_EPS)) * p.gn_sb[h * 64 + lane]);
    }
}

template <bool STATS, class Epi>
__device__ __forceinline__ void gemm_simple(const bf16_t* A, const bf16_t* Bt, int M, int N, int K, float* st, Epi epi) {
    const int wave = threadIdx.x >> 6, lane = threadIdx.x & 63; const int gw = blockIdx.x * 8 + wave, NGW = gridDim.x * 8;
    const int tn_n = N / 64, nt = (M / 64) * tn_n;
    for (int t = gw; t < nt; t += NGW) {
        const int tm = t / tn_n, tn = t % tn_n;
        f32x16 c[2][2];
        wave_tile<1>(K, [&](int i) { return A + (size_t)(tm * 64 + i) * K; }, [&](int j) { return Bt + (size_t)(tn * 64 + j) * K; }, c);
#pragma unroll
        for (int i = 0; i < 2; ++i)
#pragma unroll
            for (int q = 0; q < 16; ++q) { const int row = tm * 64 + TROW(i, q); float s = 0.f, qq = 0.f;
#pragma unroll
                for (int j = 0; j < 2; ++j) { const float v = epi(row, tn * 64 + TCOL(j), c[i][j][q]); s += v; qq += v * v; }
                if (STATS) {
#pragma unroll
                    for (int o = 1; o < 32; o <<= 1) { s += __shfl_xor(s, o); qq += __shfl_xor(qq, o); }
                    if ((lane & 31) == 0) { atomicAdd(st + 2 * row, s); atomicAdd(st + 2 * row + 1, qq); } } }
    }
}
__device__ void phase_outproj_simple(const Params& p) {
    unsigned char* ws = p.ws; bf16_t* T1B = (bf16_t*)(ws + WS_T1B); const float* x = p.x;
    gemm_simple<true>((const bf16_t*)(ws + WS_YMIX), (const bf16_t*)(ws + WS_WOUT), NTOK, DM, DM, (float*)(ws + WS_STATS1),
        [=](int row, int col, float v) { const float t = ALPHA * x[(size_t)row * DM + col] + v; T1B[(size_t)row * DM + col] = f2bf(t); return t; });
}
__device__ void phase_mq_simple(const Params& p) {
    unsigned char* ws = p.ws; bf16_t* QM = (bf16_t*)(ws + WS_QM); const float* st = (const float*)(ws + WS_STATS1); const float* cs = (const float*)(ws + WS_CS1); const float* bs = cs + 1024;
    gemm_simple<false>((const bf16_t*)(ws + WS_T1B), (const bf16_t*)(ws + WS_WMQ), NTOK, DM, DM, nullptr,
        [=](int row, int col, float v) { const RowStat r = row_stat(st, row); QM[(size_t)row * DM + col] = f2bf(r.rstd * (v - r.mean * cs[col]) + bs[col]); return 0.f; });
}
__device__ void phase_xattn_simple(const Params& p, unsigned char* lds) {
    unsigned char* ws = p.ws; const int lane = threadIdx.x & 63, wave = threadIdx.x >> 6; const int gw = blockIdx.x * 8 + wave, NGW = gridDim.x * 8;
    const bf16_t* QM = (const bf16_t*)(ws + WS_QM); const bf16_t* MK = (const bf16_t*)(ws + WS_MEMK); const bf16_t* MVT = (const bf16_t*)(ws + WS_MEMVT); bf16_t* OB = (bf16_t*)(ws + WS_OB);
    float* qs = (float*)(lds + wave * 4096); float* ps = qs + 256;
    for (int it = gw; it < NTOK * MH; it += NGW) {
        const int tok = it / MH, h = it % MH, b = tok / SEQ;
        const bf16_t* qp = QM + (size_t)tok * DM + h * MHD;
#pragma unroll
        for (int j = 0; j < 4; ++j) qs[lane + 64 * j] = bf2f(qp[lane + 64 * j]);
        asm volatile("s_waitcnt lgkmcnt(0)" ::: "memory");
        float sc[4];
#pragma unroll
        for (int j = 0; j < 4; ++j) { const int key = lane + 64 * j; const bf16_t* kp = MK + (size_t)(b * MEML + key) * DM + h * MHD; float dot = 0.f;
#pragma unroll 2
            for (int d8 = 0; d8 < 32; ++d8) { const bf16x8 kv = *(const bf16x8*)(kp + d8 * 8);
#pragma unroll
                for (int e = 0; e < 8; ++e) dot += qs[d8 * 8 + e] * bf2f((bf16_t)kv[e]); }
            sc[j] = dot; }
        const float mx = wave_max(fmaxf(fmaxf(sc[0], sc[1]), fmaxf(sc[2], sc[3])));
        float sum = 0.f;
#pragma unroll
        for (int j = 0; j < 4; ++j) { sc[j] = exp2f(sc[j] - mx); sum += sc[j]; }
        sum = wave_sum(sum); const float inv = 1.0f / sum;
#pragma unroll
        for (int j = 0; j < 4; ++j) ps[lane + 64 * j] = sc[j] * inv;
        asm volatile("s_waitcnt lgkmcnt(0)" ::: "memory");
#pragma unroll
        for (int j = 0; j < 4; ++j) { const int d = lane + 64 * j; const bf16_t* vp = MVT + (size_t)(h * MHD + d) * NMEM + b * MEML; float acc = 0.f;
#pragma unroll 2
            for (int k8 = 0; k8 < 32; ++k8) { const bf16x8 vv = *(const bf16x8*)(vp + k8 * 8);
#pragma unroll
                for (int e = 0; e < 8; ++e) acc += ps[k8 * 8 + e] * bf2f((bf16_t)vv[e]); }
            OB[(size_t)tok * DM + h * MHD + d] = f2bf(acc); }
        asm volatile("s_waitcnt lgkmcnt(0)" ::: "memory");
    }
}
__device__ void phase_mo_simple(const Params& p) {
    unsigned char* ws = p.ws; bf16_t* T2B = (bf16_t*)(ws + WS_T2B); const bf16_t* T1B = (const bf16_t*)(ws + WS_T1B); const float* st1 = (const float*)(ws + WS_STATS1);
    const float* g1 = p.ln1_g; const float* b1 = p.ln1_b;
    gemm_simple<true>((const bf16_t*)(ws + WS_OB), (const bf16_t*)(ws + WS_WMO), NTOK, DM, DM, (float*)(ws + WS_STATS2),
        [=](int row, int col, float v) { const RowStat r = row_stat(st1, row); const float x1 = (bf2f(T1B[(size_t)row * DM + col]) - r.mean) * r.rstd * g1[col] + b1[col];
            const float t = ALPHA * x1 + v; T2B[(size_t)row * DM + col] = f2bf(t); return t; });
}
__device__ void phase_router_simple(const Params& p) {
    unsigned char* ws = p.ws; float* LG = (float*)(ws + WS_LOGIT); const float* st = (const float*)(ws + WS_STATS2); const float* cs = (const float*)(ws + WS_CS2); const float* bs = cs + 64;
    gemm_simple<false>((const bf16_t*)(ws + WS_T2B), (const bf16_t*)(ws + WS_WRT), NTOK, 64, DM, nullptr,
        [=](int row, int col, float v) { const RowStat r = row_stat(st, row); LG[(size_t)row * NLOGP + col] = r.rstd * (v - r.mean * cs[col]) + bs[col]; return 0.f; });
}
__device__ void phase_route(const Params& p) {
    unsigned char* ws = p.ws; const int gt = blockIdx.x * 512 + threadIdx.x, NGT = gridDim.x * 512;
    const float* LG = (const float*)(ws + WS_LOGIT); int* EID = (int*)(ws + WS_EID); float* GATE = (float*)(ws + WS_GATE); unsigned* CNT = (unsigned*)(ws + WS_CNT); int* ROWL = (int*)(ws + WS_ROWL);
    for (int tok = gt; tok < NTOK; tok += NGT) {
        const float* lg = LG + (size_t)tok * NLOGP;
        int grp = 0; float gm = lg[0];
#pragma unroll
        for (int g = 1; g < 4; ++g) if (lg[g] > gm) { gm = lg[g]; grp = g; }
        float gs = 0.f;
#pragma unroll
        for (int g = 0; g < 4; ++g) gs += __expf(lg[g] - gm);
        const float gprob = 1.0f / gs;
        const float* el = lg + 4 + grp * 8;
        int i1 = 0; float l1 = el[0];
#pragma unroll
        for (int j = 1; j < 8; ++j) if (el[j] > l1) { l1 = el[j]; i1 = j; }
        int i2 = -1; float l2 = 0.f;
#pragma unroll
        for (int j = 0; j < 8; ++j) if (j != i1 && (i2 < 0 || el[j] > l2)) { l2 = el[j]; i2 = j; }
        const float e2 = __expf(l2 - l1), w1 = 1.0f / (1.0f + e2), w2 = e2 * w1;
        const int ea = grp * 8 + i1, eb = grp * 8 + i2;
        EID[2 * tok] = ea; EID[2 * tok + 1] = eb; GATE[2 * tok] = gprob * w1; GATE[2 * tok + 1] = gprob * w2;
        const unsigned pa = atomicAdd(CNT + ea, 1u); ROWL[(size_t)ea * CAP + pa] = 2 * tok;
        const unsigned pb = atomicAdd(CNT + eb, 1u); ROWL[(size_t)eb * CAP + pb] = 2 * tok + 1;
    }
}
__device__ void phase_moe1_simple(const Params& p) {
    unsigned char* ws = p.ws; const int wave = threadIdx.x >> 6; const int gw = blockIdx.x * 8 + wave, NGW = gridDim.x * 8;
    const unsigned* CNT = (const unsigned*)(ws + WS_CNT); const int* ROWL = (const int*)(ws + WS_ROWL); const bf16_t* T2B = (const bf16_t*)(ws + WS_T2B); const bf16_t* WGU = (const bf16_t*)(ws + WS_WGU);
    const float* st = (const float*)(ws + WS_STATS2); const float* csg = (const float*)(ws + WS_CSGU); const float* bsg = csg + NEXP * 1024; bf16_t* H = (bf16_t*)(ws + WS_H);
    int tbase = 0, hoff = 0;
    for (int e = 0; e < NEXP; ++e) {
        const int cnt = (int)CNT[e], nrt = (cnt + 63) / 64, ntile = nrt * 8;
        for (int t = gw - tbase; t < ntile; t += NGW) { if (t < 0) continue;
            const int tm = t / 8, ct = t % 8, pn = ct >> 1, hf = ct & 1; const int* rl = ROWL + (size_t)e * CAP; const bf16_t* W = WGU + (size_t)e * 1024 * 1024;
            f32x16 c[2][4];
            wave_tile<2>(DM, [&](int i) { int r = tm * 64 + i; r = r < cnt ? r : cnt - 1; return T2B + (size_t)(rl[r] >> 1) * DM; },
                         [&](int j) { const int row = 256 * pn + (j >= 64 ? 128 : 0) + 64 * hf + (j & 63); return W + (size_t)row * DM; }, c);
#pragma unroll
            for (int i = 0; i < 2; ++i)
#pragma unroll
                for (int q = 0; q < 16; ++q) { const int r = tm * 64 + TROW(i, q); if (r < cnt) { const RowStat rs = row_stat(st, rl[r] >> 1);
#pragma unroll
                    for (int j = 0; j < 2; ++j) { const int cg_ = 256 * pn + 64 * hf + TCOL(j), cu_ = cg_ + 128;
                        const float g = rs.rstd * (c[i][j][q] - rs.mean * csg[e * 1024 + cg_]) + bsg[e * 1024 + cg_];
                        const float u = rs.rstd * (c[i][j + 2][q] - rs.mean * csg[e * 1024 + cu_]) + bsg[e * 1024 + cu_];
                        H[(size_t)(hoff + r) * DEXP + 128 * pn + 64 * hf + TCOL(j)] = f2bf(g / (1.0f + __expf(-g)) * u); } } }
        }
        tbase = (tbase + ntile) % NGW; hoff += (cnt + 255) / 256 * 256;
    }
}
__device__ void phase_moe2_simple(const Params& p) {
    unsigned char* ws = p.ws; const int wave = threadIdx.x >> 6; const int gw = blockIdx.x * 8 + wave, NGW = gridDim.x * 8;
    const unsigned* CNT = (const unsigned*)(ws + WS_CNT); const int* ROWL = (const int*)(ws + WS_ROWL); const bf16_t* H = (const bf16_t*)(ws + WS_H); const bf16_t* WD = (const bf16_t*)(ws + WS_WD);
    const float* GATE = (const float*)(ws + WS_GATE); bf16_t* Y = (bf16_t*)(ws + WS_Y);
    int tbase = 0, hoff = 0;
    for (int e = 0; e < NEXP; ++e) {
        const int cnt = (int)CNT[e], nrt = (cnt + 63) / 64, ntile = nrt * 16;
        for (int t = gw - tbase; t < ntile; t += NGW) { if (t < 0) continue;
            const int tm = t / 16, tn = t % 16; const int* rl = ROWL + (size_t)e * CAP; const bf16_t* W = WD + (size_t)e * 1024 * 512;
            f32x16 c[2][2];
            wave_tile<1>(DEXP, [&](int i) { int r = tm * 64 + i; r = r < cnt ? r : cnt - 1; return H + (size_t)(hoff + r) * DEXP; }, [&](int j) { return W + (size_t)(tn * 64 + j) * DEXP; }, c);
#pragma unroll
            for (int i = 0; i < 2; ++i)
#pragma unroll
                for (int q = 0; q < 16; ++q) { const int r = tm * 64 + TROW(i, q); if (r < cnt) { const int a = rl[r]; const float g = GATE[a];
#pragma unroll
                    for (int j = 0; j < 2; ++j) Y[(size_t)a * DM + tn * 64 + TCOL(j)] = f2bf(g * c[i][j][q]); } }
        }
        tbase = (tbase + ntile) % NGW; hoff += (cnt + 255) / 256 * 256;
    }
}
__device__ void phase_final(const Params& p) {
    unsigned char* ws = p.ws; const int lane = threadIdx.x & 63, wave = threadIdx.x >> 6; const int gw = blockIdx.x * 8 + wave, NGW = gridDim.x * 8;
    const bf16_t* T2B = (const bf16_t*)(ws + WS_T2B); const bf16_t* Y = (const bf16_t*)(ws + WS_Y); const float* st = (const float*)(ws + WS_STATS2);
    for (int tok = gw; tok < NTOK; tok += NGW) {
        const RowStat rs = row_stat(st, tok);
        float v[16]; float s = 0.f;
#pragma unroll
        for (int j = 0; j < 4; ++j) { const int c0 = 256 * j + 4 * lane;
            const u32x2 t2 = *(const u32x2*)(T2B + (size_t)tok * DM + c0), y0 = *(const u32x2*)(Y + (size_t)(2 * tok) * DM + c0), y1 = *(const u32x2*)(Y + (size_t)(2 * tok + 1) * DM + c0);
            const f32x4 g2 = *(const f32x4*)(p.ln2_g + c0), b2 = *(const f32x4*)(p.ln2_b + c0);
            const unsigned tw[2] = {t2.x, t2.y}, aw[2] = {y0.x, y0.y}, bw[2] = {y1.x, y1.y};
#pragma unroll
            for (int e = 0; e < 4; ++e) { const float tt = bf2f((bf16_t)(tw[e >> 1] >> (16 * (e & 1)))), ya = bf2f((bf16_t)(aw[e >> 1] >> (16 * (e & 1)))), yb = bf2f((bf16_t)(bw[e >> 1] >> (16 * (e & 1))));
                const float x2 = (tt - rs.mean) * rs.rstd * g2[e] + b2[e]; const float t3 = ALPHA * x2 + ya + yb; v[4 * j + e] = t3; s += t3; } }
        const float mean = wave_sum(s) * (1.f / DM); float qq = 0.f;
#pragma unroll
        for (int i = 0; i < 16; ++i) { v[i] -= mean; qq += v[i] * v[i]; }
        const float rstd = 1.0f / sqrtf(wave_sum(qq) * (1.f / DM) + LN_EPS);
#pragma unroll
        for (int j = 0; j < 4; ++j) { const int c0 = 256 * j + 4 * lane; const f32x4 g3 = *(const f32x4*)(p.ln3_g + c0), b3 = *(const f32x4*)(p.ln3_b + c0);
            f32x4 o; o.x = v[4 * j] * rstd * g3.x + b3.x; o.y = v[4 * j + 1] * rstd * g3.y + b3.y; o.z = v[4 * j + 2] * rstd * g3.z + b3.z; o.w = v[4 * j + 3] * rstd * g3.w + b3.w;
            *(f32x4*)(p.out + (size_t)tok * DM + c0) = o; }
    }
}

__global__ void __launch_bounds__(512, 2) fwd_kernel(Params p) {
    extern __shared__ __attribute__((aligned(16))) unsigned char lds[];
    cg::grid_group grid = cg::this_grid();
#ifndef ONLY
#define ONLY -1
#endif
#ifdef PMASK
#define RUNP(k) ((PMASK >> (k)) & 1)
#else
#define RUNP(k) (ONLY < 0 || ONLY == (k))
#endif
    const int lo = p.ph_lo, hi = p.ph_hi;
#define IN(k) (RUNP(k) && lo <= (k) && (k) < hi)
#define SEAM(k) do { if (lo <= (k) && (k) + 1 < hi) grid.sync(); } while (0)
    if (IN(0)) { phase_prep(p, lds); } SEAM(0);
    if (IN(1)) { phase_proj_simple(p); } SEAM(1);
    if (IN(2)) { phase_conv_simple(p); phase_sb_simple(p); } SEAM(2);
    if (IN(3)) { phase_outproj_simple(p); } SEAM(3);
    if (IN(4)) { phase_mq_simple(p); } SEAM(4);
    if (IN(5)) { phase_xattn_simple(p, lds); } SEAM(5);
    if (IN(6)) { phase_mo_simple(p); } SEAM(6);
    if (IN(7)) { phase_router_simple(p); } SEAM(7);
    if (IN(8)) { phase_route(p); } SEAM(8);
    if (IN(9)) { phase_moe1_simple(p); } SEAM(9);
    if (IN(10)) { phase_moe2_simple(p); } SEAM(10);
    if (IN(11)) { phase_final(p); }
}

extern "C" void kernel_launch(void* const* d_in, const int* in_sizes, int n_in, void* d_out, int out_size, void* d_ws, size_t ws_size, hipStream_t stream) {
    static int grid = 0;
    if (grid == 0) {
        if (n_in != 24 || out_size != NTOK * DM || ws_size < WS_END) { fprintf(stderr, "kernel_launch: unexpected problem: n_in %d out %d ws %zu\n", n_in, out_size, ws_size); grid = -1; return; }
        int dev = 0, cus = 0, per_cu = 0;
        (void)hipGetDevice(&dev); (void)hipDeviceGetAttribute(&cus, hipDeviceAttributeMultiprocessorCount, dev);
        (void)hipFuncSetAttribute((const void*)fwd_kernel, hipFuncAttributeMaxDynamicSharedMemorySize, LDS_BYTES);
        (void)hipOccupancyMaxActiveBlocksPerMultiprocessor(&per_cu, (const void*)fwd_kernel, 512, LDS_BYTES);
        if (per_cu < 1) { fprintf(stderr, "kernel_launch: occupancy query reports %d blocks per CU\n", per_cu); }
        grid = cus;
    }
    if (grid < 0) return;
    Params p{};
    const float** f = (const float**)&p;
    for (int i = 0; i < 24; ++i) f[i] = (const float*)d_in[i];
    p.out = (float*)d_out; p.ws = (unsigned char*)d_ws;
#if MK_ONE_LAUNCH
    p.ph_lo = 0; p.ph_hi = NPHASE;
    void* args[] = {&p};
    hipError_t e = hipLaunchCooperativeKernel((void*)fwd_kernel, dim3(grid), dim3(512), args, LDS_BYTES, stream);
    if (e != hipSuccess) fprintf(stderr, "cooperative launch failed: %s\n", hipGetErrorString(e));
#else
    for (int ph = 0; ph < NPHASE; ++ph) {
        p.ph_lo = ph; p.ph_hi = ph + 1;
        void* args[] = {&p};
        hipError_t e = hipLaunchCooperativeKernel((void*)fwd_kernel, dim3(grid), dim3(512), args, LDS_BYTES, stream);
        if (e != hipSuccess) { fprintf(stderr, "launch %d failed: %s\n", ph, hipGetErrorString(e)); break; }
    }
#endif
}
```

```cpp
#include <hip/hip_runtime.h>
#include <hip/hip_cooperative_groups.h>
#include <cstdio>
#include <cstdint>
namespace cg = cooperative_groups;

#ifndef MK_ONE_LAUNCH
#define MK_ONE_LAUNCH 1
#endif

typedef unsigned short bf16_t;
typedef short bf16x8 __attribute__((ext_vector_type(8)));
typedef float f32x4 __attribute__((ext_vector_type(4)));
typedef float f32x16 __attribute__((ext_vector_type(16)));
typedef unsigned u32x4 __attribute__((ext_vector_type(4)));
typedef unsigned u32x2 __attribute__((ext_vector_type(2)));

constexpr int NB = 32, SEQ = 2048, DM = 1024, NTOK = NB * SEQ;
constexpr int MEML = 256, NMEM = NB * MEML;
constexpr int NPROJ = 2560;
constexpr int PW = 3072;
constexpr int C_CB = 0, C_CC = 512, C_CH = 1024, C_Q = 1536, C_K = 2048, C_V = 2560;
constexpr int NHEAD = 8, HD = 64;
constexpr int MH = 4, MHD = 256;
constexpr int NEXP = 32, DEXP = 512, NLOG = 36, NLOGP = 64;
constexpr int CAP = 2 * NTOK;
constexpr float ALPHA = 1.189207115002721f;
constexpr float LN_EPS = 1e-5f, RMS_EPS = 1e-6f;
constexpr float LOG2E = 1.4426950408889634f;
constexpr float QS_SB = 0.125f * LOG2E;
constexpr float QS_X = 0.0625f * LOG2E;

constexpr size_t MiB = 1u << 20;
constexpr size_t WS_STATS1 = 0;
constexpr size_t WS_STATS2 = 1 * MiB;
constexpr size_t WS_CNT = 2 * MiB;
constexpr size_t WS_CS1 = 2 * MiB + 4096;
constexpr size_t WS_CS2 = WS_CS1 + 8192;
constexpr size_t WS_CSGU = 3 * MiB;
constexpr size_t WS_EID = 4 * MiB;
constexpr size_t WS_GATE = 5 * MiB;
constexpr size_t WS_LOGIT = 8 * MiB;
constexpr size_t WS_ROWL = 24 * MiB;
constexpr size_t WS_WRT = 40 * MiB;
constexpr size_t WS_WIN = 64 * MiB;
constexpr size_t WS_WOUT = 70 * MiB;
constexpr size_t WS_WMQ = 72 * MiB, WS_WMK = 74 * MiB, WS_WMV = 76 * MiB, WS_WMO = 78 * MiB;
constexpr size_t WS_WGU = 80 * MiB;
constexpr size_t WS_WD = 144 * MiB;
constexpr size_t WS_XB = 192 * MiB;
constexpr size_t WS_T1B = 192 * MiB;
constexpr size_t WS_MEMB = 320 * MiB;
constexpr size_t WS_MEMK = 336 * MiB;
constexpr size_t WS_MEMVT = 352 * MiB;
constexpr size_t WS_PROJ = 368 * MiB;
constexpr size_t WS_QM = 368 * MiB;
constexpr size_t WS_OB = 496 * MiB;
constexpr size_t WS_Y = 368 * MiB;
constexpr size_t WS_VT = 688 * MiB;
constexpr size_t WS_YMIX = 752 * MiB;
constexpr size_t WS_T2B = 752 * MiB;
constexpr size_t WS_H = 880 * MiB;
constexpr size_t WS_END = 1016 * MiB;

constexpr int LDS_BYTES = 147456;
constexpr int NPHASE = 12;

struct Params {
    const float *x, *mem, *w_in, *conv_w, *gn_conv, *gn_sb, *w_out, *ln1_g, *ln1_b, *w_mq, *w_mk, *w_mv, *w_mo, *ln2_g, *ln2_b,
        *w_rg, *b_rg, *w_re, *b_re, *w_gate, *w_up, *w_down, *ln3_g, *ln3_b;
    float* out; unsigned char* ws; int ph_lo, ph_hi;
};

__device__ __forceinline__ float bf2f(bf16_t v) { return __uint_as_float((unsigned)v << 16); }
__device__ __forceinline__ bf16_t f2bf(float f) { unsigned u = __float_as_uint(f); return (bf16_t)((u + 0x7fffu + ((u >> 16) & 1u)) >> 16); }
__device__ __forceinline__ unsigned pk2(float lo, float hi) { return (unsigned)f2bf(lo) | ((unsigned)f2bf(hi) << 16); }
__device__ __forceinline__ float wave_sum(float v) {
#pragma unroll
    for (int o = 1; o < 64; o <<= 1) v += __shfl_xor(v, o);
    return v;
}
__device__ __forceinline__ float wave_max(float v) {
#pragma unroll
    for (int o = 1; o < 64; o <<= 1) v = fmaxf(v, __shfl_xor(v, o));
    return v;
}
#define MFMA32(a, b, c) __builtin_amdgcn_mfma_f32_32x32x16_bf16((a), (b), (c), 0, 0, 0)

template <int NBLK, class AR, class BR>
__device__ __forceinline__ void wave_tile(int K, AR arow, BR brow, f32x16 (&c)[2][2 * NBLK]) {
    const int lane = threadIdx.x & 63, r = lane & 31, h = lane >> 5;
    const bf16_t* ap[2]; const bf16_t* bp[2 * NBLK];
#pragma unroll
    for (int i = 0; i < 2; ++i) ap[i] = arow(32 * i + r) + 8 * h;
#pragma unroll
    for (int j = 0; j < 2 * NBLK; ++j) bp[j] = brow(32 * j + r) + 8 * h;
#pragma unroll
    for (int i = 0; i < 2; ++i)
#pragma unroll
        for (int j = 0; j < 2 * NBLK; ++j)
#pragma unroll
            for (int q = 0; q < 16; ++q) c[i][j][q] = 0.f;
#pragma unroll 2
    for (int k = 0; k < K; k += 16) {
        bf16x8 fa[2], fb[2 * NBLK];
#pragma unroll
        for (int i = 0; i < 2; ++i) fa[i] = *(const bf16x8*)(ap[i] + k);
#pragma unroll
        for (int j = 0; j < 2 * NBLK; ++j) fb[j] = *(const bf16x8*)(bp[j] + k);
#pragma unroll
        for (int i = 0; i < 2; ++i)
#pragma unroll
            for (int j = 0; j < 2 * NBLK; ++j) c[i][j] = MFMA32(fa[i], fb[j], c[i][j]);
    }
}
#define TROW(i, q) (32 * (i) + ((q) & 3) + 8 * ((q) >> 2) + 4 * ((int)(threadIdx.x & 63) >> 5))
#define TCOL(j) (32 * (j) + (int)(threadIdx.x & 31))

struct RowStat { float mean, rstd; };
__device__ __forceinline__ RowStat row_stat(const float* st, int row) {
    const float s = st[2 * row], q = st[2 * row + 1];
    RowStat r; r.mean = s * (1.f / DM); const float var = fmaxf(q * (1.f / DM) - r.mean * r.mean, 0.f); r.rstd = 1.0f / sqrtf(var + LN_EPS); return r;
}

__device__ __forceinline__ void transpose_item(const float* W, int K, int N, int k0, int n0, bf16_t* WT, int orow0, const float* ks, float ns, float* scr, int lane) {
#pragma unroll 8
    for (int i = 0; i < 32; ++i) { const int kk = 2 * i + (lane >> 5); float v = W[(size_t)(k0 + kk) * N + n0 + (lane & 31)]; if (ks) v *= ks[k0 + kk]; scr[kk * 33 + (lane & 31)] = v * ns; }
    asm volatile("s_waitcnt vmcnt(0) lgkmcnt(0)" ::: "memory");
    const int c = lane & 7;
#pragma unroll
    for (int j = 0; j < 4; ++j) { const int n = (lane >> 3) + 8 * j; const float* s = scr + (8 * c) * 33 + n;
        u32x4 o; o.x = pk2(s[0 * 33], s[1 * 33]); o.y = pk2(s[2 * 33], s[3 * 33]); o.z = pk2(s[4 * 33], s[5 * 33]); o.w = pk2(s[6 * 33], s[7 * 33]);
        *(u32x4*)(WT + (size_t)(orow0 + n) * K + k0 + 8 * c) = o; }
    asm volatile("s_waitcnt lgkmcnt(0)" ::: "memory");
}
__device__ void phase_prep(const Params& p, unsigned char* lds) {
    unsigned char* ws = p.ws;
    const int tid = threadIdx.x, lane = tid & 63, wave = tid >> 6;
    const int gw = blockIdx.x * 8 + wave, NGW = gridDim.x * 8;
    const int gt = blockIdx.x * 512 + tid, NGT = gridDim.x * 512;
    float* scr = (float*)(lds + wave * 16384);
    bf16_t* WIN = (bf16_t*)(ws + WS_WIN); bf16_t* WOUT = (bf16_t*)(ws + WS_WOUT); bf16_t* WMQ = (bf16_t*)(ws + WS_WMQ); bf16_t* WMK = (bf16_t*)(ws + WS_WMK);
    bf16_t* WMV = (bf16_t*)(ws + WS_WMV); bf16_t* WMO = (bf16_t*)(ws + WS_WMO); bf16_t* WGU = (bf16_t*)(ws + WS_WGU); bf16_t* WD = (bf16_t*)(ws + WS_WD);
    constexpr int I_IN = 16 * 96, I_SQ = 16 * 32, I_G = 32 * 16 * 16, I_D = 32 * 8 * 32;
    constexpr int NITEMS = I_IN + 5 * I_SQ + 2 * I_G + I_D;
    for (int it = gw; it < NITEMS; it += NGW) {
        int r = it;
        if (r < I_IN) { const int kb = r / 96, nb = r % 96, n0 = nb * 32; transpose_item(p.w_in, DM, PW, kb * 64, n0, WIN, n0, nullptr, (n0 >= C_Q && n0 < C_K) ? QS_SB : 1.f, scr, lane); continue; } r -= I_IN;
        if (r < I_SQ) { transpose_item(p.w_out, DM, DM, (r / 32) * 64, (r % 32) * 32, WOUT, (r % 32) * 32, nullptr, 1.f, scr, lane); continue; } r -= I_SQ;
        if (r < I_SQ) { transpose_item(p.w_mq, DM, DM, (r / 32) * 64, (r % 32) * 32, WMQ, (r % 32) * 32, p.ln1_g, QS_X, scr, lane); continue; } r -= I_SQ;
        if (r < I_SQ) { transpose_item(p.w_mk, DM, DM, (r / 32) * 64, (r % 32) * 32, WMK, (r % 32) * 32, nullptr, 1.f, scr, lane); continue; } r -= I_SQ;
        if (r < I_SQ) { transpose_item(p.w_mv, DM, DM, (r / 32) * 64, (r % 32) * 32, WMV, (r % 32) * 32, nullptr, 1.f, scr, lane); continue; } r -= I_SQ;
        if (r < I_SQ) { transpose_item(p.w_mo, DM, DM, (r / 32) * 64, (r % 32) * 32, WMO, (r % 32) * 32, nullptr, 1.f, scr, lane); continue; } r -= I_SQ;
        if (r < 2 * I_G) { const int up = r >= I_G; if (up) r -= I_G; const int e = r / 256, q = r % 256, kb = q / 16, nb = q % 16, n0 = nb * 32;
            const float* W = (up ? p.w_up : p.w_gate) + (size_t)e * DM * DEXP; const int orow0 = 256 * (n0 / 128) + (up ? 128 : 0) + (n0 % 128);
            transpose_item(W, DM, DEXP, kb * 64, n0, WGU + (size_t)e * 1024 * 1024, orow0, p.ln2_g, 1.f, scr, lane); continue; } r -= 2 * I_G;
        { const int e = r / 256, q = r % 256, kb = q / 32, nb = q % 32; transpose_item(p.w_down + (size_t)e * DEXP * DM, DEXP, DM, kb * 64, nb * 32, WD + (size_t)e * 1024 * 512, nb * 32, nullptr, 1.f, scr, lane); }
    }
    { bf16_t* WRT = (bf16_t*)(ws + WS_WRT);
      for (int i = gt; i < 256 * DM; i += NGT) { const int n = i / DM, k = i % DM; float v = 0.f;
          if (n < 4) v = p.w_rg[k * 4 + n] * p.ln2_g[k]; else if (n < NLOG) v = p.w_re[k * 32 + (n - 4)] * p.ln2_g[k];
          WRT[i] = f2bf(v); } }
    { float* cs1 = (float*)(ws + WS_CS1); float* bs1 = cs1 + 1024; float* cs2 = (float*)(ws + WS_CS2); float* bs2 = cs2 + 64;
      float* csg = (float*)(ws + WS_CSGU); float* bsg = csg + NEXP * 1024;
      constexpr int NV = 1024 + 64 + NEXP * 1024;
      for (int i = gt; i < NV; i += NGT) {
          if (i < 1024) { const int n = i; float cs = 0.f, bs = 0.f;
              for (int k = 0; k < DM; ++k) { const float w = p.w_mq[(size_t)k * DM + n]; cs += bf2f(f2bf(w * p.ln1_g[k] * QS_X)); bs += p.ln1_b[k] * w; }
              cs1[n] = cs; bs1[n] = bs * QS_X; }
          else if (i < 1088) { const int n = i - 1024; float cs = 0.f, bs = 0.f;
              if (n < NLOG) { for (int k = 0; k < DM; ++k) { const float w = n < 4 ? p.w_rg[k * 4 + n] : p.w_re[k * 32 + (n - 4)]; cs += bf2f(f2bf(w * p.ln2_g[k])); bs += p.ln2_b[k] * w; }
                  bs += n < 4 ? p.b_rg[n] : p.b_re[n - 4]; }
              cs2[n] = cs; bs2[n] = bs; }
          else { const int j = i - 1088, e = j / 1024, row = j % 1024, pn = row / 256, rr = row % 256, up = rr >= 128, n = pn * 128 + (rr & 127);
              const float* W = (up ? p.w_up : p.w_gate) + (size_t)e * DM * DEXP; float cs = 0.f, bs = 0.f;
              for (int k = 0; k < DM; ++k) { const float w = W[(size_t)k * DEXP + n]; cs += bf2f(f2bf(w * p.ln2_g[k])); bs += p.ln2_b[k] * w; }
              csg[j] = cs; bsg[j] = bs; }
      } }
    { bf16_t* XB = (bf16_t*)(ws + WS_XB); bf16_t* MB = (bf16_t*)(ws + WS_MEMB);
      const f32x4* x4 = (const f32x4*)p.x; u32x2* xb2 = (u32x2*)XB;
      for (int i = gt; i < NTOK * DM / 4; i += NGT) { const f32x4 v = x4[i]; u32x2 o; o.x = pk2(v.x, v.y); o.y = pk2(v.z, v.w); xb2[i] = o; }
      const f32x4* m4 = (const f32x4*)p.mem; u32x2* mb2 = (u32x2*)MB;
      for (int i = gt; i < NMEM * DM / 4; i += NGT) { const f32x4 v = m4[i]; u32x2 o; o.x = pk2(v.x, v.y); o.y = pk2(v.z, v.w); mb2[i] = o; } }
    { float* s1 = (float*)(ws + WS_STATS1); float* s2 = (float*)(ws + WS_STATS2); unsigned* cnt = (unsigned*)(ws + WS_CNT);
      for (int i = gt; i < 2 * NTOK; i += NGT) { s1[i] = 0.f; s2[i] = 0.f; }
      if (gt < 64) cnt[gt] = 0u; }
}

__device__ void phase_proj_simple(const Params& p) {
    unsigned char* ws = p.ws; const int wave = threadIdx.x >> 6; const int gw = blockIdx.x * 8 + wave, NGW = gridDim.x * 8;
    const bf16_t* XB = (const bf16_t*)(ws + WS_XB); const bf16_t* WIN = (const bf16_t*)(ws + WS_WIN); const bf16_t* MB = (const bf16_t*)(ws + WS_MEMB);
    const bf16_t* WMK = (const bf16_t*)(ws + WS_WMK); const bf16_t* WMV = (const bf16_t*)(ws + WS_WMV);
    bf16_t* PROJ = (bf16_t*)(ws + WS_PROJ); bf16_t* VT = (bf16_t*)(ws + WS_VT); bf16_t* MK = (bf16_t*)(ws + WS_MEMK); bf16_t* MVT = (bf16_t*)(ws + WS_MEMVT);
    constexpr int TA = (NTOK / 64) * (NPROJ / 64), TB = (512 / 64) * (NTOK / 64), TC = (NMEM / 64) * (DM / 64), TD = (DM / 64) * (NMEM / 64);
    for (int t = gw; t < TA + TB + TC + TD; t += NGW) {
        const bf16_t *A, *Bt; bf16_t* O; int ldo, tm, tn, r = t;
        if (r < TA) { A = XB; Bt = WIN; O = PROJ; ldo = NPROJ; tm = r / (NPROJ / 64); tn = r % (NPROJ / 64); }
        else if ((r -= TA) < TB) { A = WIN + (size_t)C_V * DM; Bt = XB; O = VT; ldo = NTOK; tm = r / (NTOK / 64); tn = r % (NTOK / 64); }
        else if ((r -= TB) < TC) { A = MB; Bt = WMK; O = MK; ldo = DM; tm = r / (DM / 64); tn = r % (DM / 64); }
        else { r -= TC; A = WMV; Bt = MB; O = MVT; ldo = NMEM; tm = r / (NMEM / 64); tn = r % (NMEM / 64); }
        f32x16 c[2][2];
        wave_tile<1>(DM, [&](int i) { return A + (size_t)(tm * 64 + i) * DM; }, [&](int j) { return Bt + (size_t)(tn * 64 + j) * DM; }, c);
#pragma unroll
        for (int i = 0; i < 2; ++i)
#pragma unroll
            for (int j = 0; j < 2; ++j)
#pragma unroll
                for (int q = 0; q < 16; ++q) O[(size_t)(tm * 64 + TROW(i, q)) * ldo + tn * 64 + TCOL(j)] = f2bf(c[i][j][q]);
    }
}

__device__ void phase_conv_simple(const Params& p) {
    unsigned char* ws = p.ws; const int lane = threadIdx.x & 63, wave = threadIdx.x >> 6; const int gw = blockIdx.x * 8 + wave, NGW = gridDim.x * 8;
    const bf16_t* PROJ = (const bf16_t*)(ws + WS_PROJ); bf16_t* YMIX = (bf16_t*)(ws + WS_YMIX);
    for (int it = gw; it < NTOK * 8; it += NGW) {
        const int tok = it >> 3, g = it & 7, c = g * 64 + lane, t = tok % SEQ;
        float acc = 0.f;
#pragma unroll
        for (int k = 0; k < 3; ++k) { const int tt = t - 2 + k; if (tt >= 0) { const bf16_t* row = PROJ + (size_t)(tok - 2 + k) * NPROJ; acc += p.conv_w[k * 512 + c] * (bf2f(row[C_CC + c]) * bf2f(row[C_CH + c])); } }
        const float y = bf2f(PROJ[(size_t)tok * NPROJ + C_CB + c]) * acc;
        const float ms = wave_sum(y * y) * (1.f / 64.f);
        YMIX[(size_t)tok * DM + c] = f2bf(y * (1.0f / sqrtf(ms + RMS_EPS)) * p.gn_conv[c]);
    }
}
__device__ void phase_sb_simple(const Params& p) {
    unsigned char* ws = p.ws; const int lane = threadIdx.x & 63, wave = threadIdx.x >> 6; const int gw = blockIdx.x * 8 + wave, NGW = gridDim.x * 8;
    const bf16_t* PROJ = (const bf16_t*)(ws + WS_PROJ); const bf16_t* VT = (const bf16_t*)(ws + WS_VT); bf16_t* YMIX = (bf16_t*)(ws + WS_YMIX);
    for (int it = gw; it < NTOK * NHEAD; it += NGW) {
        const int tok = it / NHEAD, h = it % NHEAD, b = tok / SEQ, t = tok % SEQ;
        float q[64], o[64];
        { const bf16_t* qp = PROJ + (size_t)tok * NPROJ + C_Q + h * 64;
#pragma unroll
          for (int d = 0; d < 64; ++d) { q[d] = bf2f(qp[d]); o[d] = 0.f; } }
        float R = 0.f;
        for (int c0 = t - 1; c0 >= 0; c0 -= 64) {
            const int s = c0 - lane; const bool valid = s >= 0; const int sc = valid ? s : 0;
            const bf16_t* kp = PROJ + (size_t)(b * SEQ + sc) * NPROJ + C_K + h * 64;
            float dot = 0.f;
#pragma unroll
            for (int d8 = 0; d8 < 8; ++d8) { const bf16x8 kv = *(const bf16x8*)(kp + d8 * 8);
#pragma unroll
                for (int j = 0; j < 8; ++j) dot += q[d8 * 8 + j] * bf2f((bf16_t)kv[j]); }
            const float sp = fmaxf(dot, 0.f) + __log2f(1.0f + exp2f(-fabsf(dot)));
            const float L = valid ? -sp : 0.f;
            float incl = L;
#pragma unroll
            for (int off = 1; off < 64; off <<= 1) { const float n = __shfl_up(incl, off); if (lane >= off) incl += n; }
            const float w = valid ? exp2f(dot + L + (R + incl - L)) : 0.f;
            R += __shfl(incl, 63);
            const bf16_t* vp = VT + (size_t)(h * 64) * NTOK + b * SEQ + sc;
#pragma unroll
            for (int d = 0; d < 64; ++d) o[d] += w * bf2f(vp[(size_t)d * NTOK]);
        }
        float ss = 0.f, mine = 0.f;
#pragma unroll
        for (int d = 0; d < 64; ++d) { const float v = wave_sum(o[d]); ss += v * v; if (d == lane) mine = v; }
        YMIX[(size_t)tok * DM + 512 + h * 64 + lane] = f2bf(mine * (1.0f / sqrtf(ss * (1.f / 64.f) + RMS_EPS)) * p.gn_sb[h * 64 + lane]);
    }
}

template <bool STATS, class Epi>
__device__ __forceinline__ void gemm_simple(const bf16_t* A, const bf16_t* Bt, int M, int N, int K, float* st, Epi epi) {
    const int wave = threadIdx.x >> 6, lane = threadIdx.x & 63; const int gw = blockIdx.x * 8 + wave, NGW = gridDim.x * 8;
    const int tn_n = N / 64, nt = (M / 64) * tn_n;
    for (int t = gw; t < nt; t += NGW) {
        const int tm = t / tn_n, tn = t % tn_n;
        f32x16 c[2][2];
        wave_tile<1>(K, [&](int i) { return A + (size_t)(tm * 64 + i) * K; }, [&](int j) { return Bt + (size_t)(tn * 64 + j) * K; }, c);
#pragma unroll
        for (int i = 0; i < 2; ++i)
#pragma unroll
            for (int q = 0; q < 16; ++q) { const int row = tm * 64 + TROW(i, q); float s = 0.f, qq = 0.f;
#pragma unroll
                for (int j = 0; j < 2; ++j) { const float v = epi(row, tn * 64 + TCOL(j), c[i][j][q]); s += v; qq += v * v; }
                if (STATS) {
#pragma unroll
                    for (int o = 1; o < 32; o <<= 1) { s += __shfl_xor(s, o); qq += __shfl_xor(qq, o); }
                    if ((lane & 31) == 0) { atomicAdd(st + 2 * row, s); atomicAdd(st + 2 * row + 1, qq); } } }
    }
}
__device__ void phase_outproj_simple(const Params& p) {
    unsigned char* ws = p.ws; bf16_t* T1B = (bf16_t*)(ws + WS_T1B); const float* x = p.x;
    gemm_simple<true>((const bf16_t*)(ws + WS_YMIX), (const bf16_t*)(ws + WS_WOUT), NTOK, DM, DM, (float*)(ws + WS_STATS1),
        [=](int row, int col, float v) { const float t = ALPHA * x[(size_t)row * DM + col] + v; T1B[(size_t)row * DM + col] = f2bf(t); return t; });
}
__device__ void phase_mq_simple(const Params& p) {
    unsigned char* ws = p.ws; bf16_t* QM = (bf16_t*)(ws + WS_QM); const float* st = (const float*)(ws + WS_STATS1); const float* cs = (const float*)(ws + WS_CS1); const float* bs = cs + 1024;
    gemm_simple<false>((const bf16_t*)(ws + WS_T1B), (const bf16_t*)(ws + WS_WMQ), NTOK, DM, DM, nullptr,
        [=](int row, int col, float v) { const RowStat r = row_stat(st, row); QM[(size_t)row * DM + col] = f2bf(r.rstd * (v - r.mean * cs[col]) + bs[col]); return 0.f; });
}
__device__ void phase_xattn_simple(const Params& p, unsigned char* lds) {
    unsigned char* ws = p.ws; const int lane = threadIdx.x & 63, wave = threadIdx.x >> 6; const int gw = blockIdx.x * 8 + wave, NGW = gridDim.x * 8;
    const bf16_t* QM = (const bf16_t*)(ws + WS_QM); const bf16_t* MK = (const bf16_t*)(ws + WS_MEMK); const bf16_t* MVT = (const bf16_t*)(ws + WS_MEMVT); bf16_t* OB = (bf16_t*)(ws + WS_OB);
    float* qs = (float*)(lds + wave * 4096); float* ps = qs + 256;
    for (int it = gw; it < NTOK * MH; it += NGW) {
        const int tok = it / MH, h = it % MH, b = tok / SEQ;
        const bf16_t* qp = QM + (size_t)tok * DM + h * MHD;
#pragma unroll
        for (int j = 0; j < 4; ++j) qs[lane + 64 * j] = bf2f(qp[lane + 64 * j]);
        asm volatile("s_waitcnt lgkmcnt(0)" ::: "memory");
        float sc[4];
#pragma unroll
        for (int j = 0; j < 4; ++j) { const int key = lane + 64 * j; const bf16_t* kp = MK + (size_t)(b * MEML + key) * DM + h * MHD; float dot = 0.f;
#pragma unroll 2
            for (int d8 = 0; d8 < 32; ++d8) { const bf16x8 kv = *(const bf16x8*)(kp + d8 * 8);
#pragma unroll
                for (int e = 0; e < 8; ++e) dot += qs[d8 * 8 + e] * bf2f((bf16_t)kv[e]); }
            sc[j] = dot; }
        const float mx = wave_max(fmaxf(fmaxf(sc[0], sc[1]), fmaxf(sc[2], sc[3])));
        float sum = 0.f;
#pragma unroll
        for (int j = 0; j < 4; ++j) { sc[j] = exp2f(sc[j] - mx); sum += sc[j]; }
        sum = wave_sum(sum); const float inv = 1.0f / sum;
#pragma unroll
        for (int j = 0; j < 4; ++j) ps[lane + 64 * j] = sc[j] * inv;
        asm volatile("s_waitcnt lgkmcnt(0)" ::: "memory");
#pragma unroll
        for (int j = 0; j < 4; ++j) { const int d = lane + 64 * j; const bf16_t* vp = MVT + (size_t)(h * MHD + d) * NMEM + b * MEML; float acc = 0.f;
#pragma unroll 2
            for (int k8 = 0; k8 < 32; ++k8) { const bf16x8 vv = *(const bf16x8*)(vp + k8 * 8);
#pragma unroll
                for (int e = 0; e < 8; ++e) acc += ps[k8 * 8 + e] * bf2f((bf16_t)vv[e]); }
            OB[(size_t)tok * DM + h * MHD + d] = f2bf(acc); }
        asm volatile("s_waitcnt lgkmcnt(0)" ::: "memory");
    }
}
__device__ void phase_mo_simple(const Params& p) {
    unsigned char* ws = p.ws; bf16_t* T2B = (bf16_t*)(ws + WS_T2B); const bf16_t* T1B = (const bf16_t*)(ws + WS_T1B); const float* st1 = (const float*)(ws + WS_STATS1);
    const float* g1 = p.ln1_g; const float* b1 = p.ln1_b;
    gemm_simple<true>((const bf16_t*)(ws + WS_OB), (const bf16_t*)(ws + WS_WMO), NTOK, DM, DM, (float*)(ws + WS_STATS2),
        [=](int row, int col, float v) { const RowStat r = row_stat(st1, row); const float x1 = (bf2f(T1B[(size_t)row * DM + col]) - r.mean) * r.rstd * g1[col] + b1[col];
            const float t = ALPHA * x1 + v; T2B[(size_t)row * DM + col] = f2bf(t); return t; });
}
__device__ void phase_router_simple(const Params& p) {
    unsigned char* ws = p.ws; float* LG = (float*)(ws + WS_LOGIT); const float* st = (const float*)(ws + WS_STATS2); const float* cs = (const float*)(ws + WS_CS2); const float* bs = cs + 64;
    gemm_simple<false>((const bf16_t*)(ws + WS_T2B), (const bf16_t*)(ws + WS_WRT), NTOK, 64, DM, nullptr,
        [=](int row, int col, float v) { const RowStat r = row_stat(st, row); LG[(size_t)row * NLOGP + col] = r.rstd * (v - r.mean * cs[col]) + bs[col]; return 0.f; });
}
__device__ void phase_route(const Params& p) {
    unsigned char* ws = p.ws; const int gt = blockIdx.x * 512 + threadIdx.x, NGT = gridDim.x * 512;
    const float* LG = (const float*)(ws + WS_LOGIT); int* EID = (int*)(ws + WS_EID); float* GATE = (float*)(ws + WS_GATE); unsigned* CNT = (unsigned*)(ws + WS_CNT); int* ROWL = (int*)(ws + WS_ROWL);
    for (int tok = gt; tok < NTOK; tok += NGT) {
        const float* lg = LG + (size_t)tok * NLOGP;
        int grp = 0; float gm = lg[0];
#pragma unroll
        for (int g = 1; g < 4; ++g) if (lg[g] > gm) { gm = lg[g]; grp = g; }
        float gs = 0.f;
#pragma unroll
        for (int g = 0; g < 4; ++g) gs += __expf(lg[g] - gm);
        const float gprob = 1.0f / gs;
        const float* el = lg + 4 + grp * 8;
        int i1 = 0; float l1 = el[0];
#pragma unroll
        for (int j = 1; j < 8; ++j) if (el[j] > l1) { l1 = el[j]; i1 = j; }
        int i2 = -1; float l2 = 0.f;
#pragma unroll
        for (int j = 0; j < 8; ++j) if (j != i1 && (i2 < 0 || el[j] > l2)) { l2 = el[j]; i2 = j; }
        const float e2 = __expf(l2 - l1), w1 = 1.0f / (1.0f + e2), w2 = e2 * w1;
        const int ea = grp * 8 + i1, eb = grp * 8 + i2;
        EID[2 * tok] = ea; EID[2 * tok + 1] = eb; GATE[2 * tok] = gprob * w1; GATE[2 * tok + 1] = gprob * w2;
        const unsigned pa = atomicAdd(CNT + ea, 1u); ROWL[(size_t)ea * CAP + pa] = 2 * tok;
        const unsigned pb = atomicAdd(CNT + eb, 1u); ROWL[(size_t)eb * CAP + pb] = 2 * tok + 1;
    }
}
__device__ void phase_moe1_simple(const Params& p) {
    unsigned char* ws = p.ws; const int wave = threadIdx.x >> 6; const int gw = blockIdx.x * 8 + wave, NGW = gridDim.x * 8;
    const unsigned* CNT = (const unsigned*)(ws + WS_CNT); const int* ROWL = (const int*)(ws + WS_ROWL); const bf16_t* T2B = (const bf16_t*)(ws + WS_T2B); const bf16_t* WGU = (const bf16_t*)(ws + WS_WGU);
    const float* st = (const float*)(ws + WS_STATS2); const float* csg = (const float*)(ws + WS_CSGU); const float* bsg = csg + NEXP * 1024; bf16_t* H = (bf16_t*)(ws + WS_H);
    int tbase = 0, hoff = 0;
    for (int e = 0; e < NEXP; ++e) {
        const int cnt = (int)CNT[e], nrt = (cnt + 63) / 64, ntile = nrt * 8;
        for (int t = gw - tbase; t < ntile; t += NGW) { if (t < 0) continue;
            const int tm = t / 8, ct = t % 8, pn = ct >> 1, hf = ct & 1; const int* rl = ROWL + (size_t)e * CAP; const bf16_t* W = WGU + (size_t)e * 1024 * 1024;
            f32x16 c[2][4];
            wave_tile<2>(DM, [&](int i) { int r = tm * 64 + i; r = r < cnt ? r : cnt - 1; return T2B + (size_t)(rl[r] >> 1) * DM; },
                         [&](int j) { const int row = 256 * pn + (j >= 64 ? 128 : 0) + 64 * hf + (j & 63); return W + (size_t)row * DM; }, c);
#pragma unroll
            for (int i = 0; i < 2; ++i)
#pragma unroll
                for (int q = 0; q < 16; ++q) { const int r = tm * 64 + TROW(i, q); if (r < cnt) { const RowStat rs = row_stat(st, rl[r] >> 1);
#pragma unroll
                    for (int j = 0; j < 2; ++j) { const int cg_ = 256 * pn + 64 * hf + TCOL(j), cu_ = cg_ + 128;
                        const float g = rs.rstd * (c[i][j][q] - rs.mean * csg[e * 1024 + cg_]) + bsg[e * 1024 + cg_];
                        const float u = rs.rstd * (c[i][j + 2][q] - rs.mean * csg[e * 1024 + cu_]) + bsg[e * 1024 + cu_];
                        H[(size_t)(hoff + r) * DEXP + 128 * pn + 64 * hf + TCOL(j)] = f2bf(g / (1.0f + __expf(-g)) * u); } } }
        }
        tbase = (tbase + ntile) % NGW; hoff += (cnt + 255) / 256 * 256;
    }
}
__device__ void phase_moe2_simple(const Params& p) {
    unsigned char* ws = p.ws; const int wave = threadIdx.x >> 6; const int gw = blockIdx.x * 8 + wave, NGW = gridDim.x * 8;
    const unsigned* CNT = (const unsigned*)(ws + WS_CNT); const int* ROWL = (const int*)(ws + WS_ROWL); const bf16_t* H = (const bf16_t*)(ws + WS_H); const bf16_t* WD = (const bf16_t*)(ws + WS_WD);
    const float* GATE = (const float*)(ws + WS_GATE); bf16_t* Y = (bf16_t*)(ws + WS_Y);
    int tbase = 0, hoff = 0;
    for (int e = 0; e < NEXP; ++e) {
        const int cnt = (int)CNT[e], nrt = (cnt + 63) / 64, ntile = nrt * 16;
        for (int t = gw - tbase; t < ntile; t += NGW) { if (t < 0) continue;
            const int tm = t / 16, tn = t % 16; const int* rl = ROWL + (size_t)e * CAP; const bf16_t* W = WD + (size_t)e * 1024 * 512;
            f32x16 c[2][2];
            wave_tile<1>(DEXP, [&](int i) { int r = tm * 64 + i; r = r < cnt ? r : cnt - 1; return H + (size_t)(hoff + r) * DEXP; }, [&](int j) { return W + (size_t)(tn * 64 + j) * DEXP; }, c);
#pragma unroll
            for (int i = 0; i < 2; ++i)
#pragma unroll
                for (int q = 0; q < 16; ++q) { const int r = tm * 64 + TROW(i, q); if (r < cnt) { const int a = rl[r]; const float g = GATE[a];
#pragma unroll
                    for (int j = 0; j < 2; ++j) Y[(size_t)a * DM + tn * 64 + TCOL(j)] = f2bf(g * c[i][j][q]); } }
        }
        tbase = (tbase + ntile) % NGW; hoff += (cnt + 255) / 256 * 256;
    }
}
__device__ void phase_final(const Params& p) {
    unsigned char* ws = p.ws; const int lane = threadIdx.x & 63, wave = threadIdx.x >> 6; const int gw = blockIdx.x * 8 + wave, NGW = gridDim.x * 8;
    const bf16_t* T2B = (const bf16_t*)(ws + WS_T2B); const bf16_t* Y = (const bf16_t*)(ws + WS_Y); const float* st = (const float*)(ws + WS_STATS2);
    for (int tok = gw; tok < NTOK; tok += NGW) {
        const RowStat rs = row_stat(st, tok);
        float v[16]; float s = 0.f;
#pragma unroll
        for (int j = 0; j < 4; ++j) { const int c0 = 256 * j + 4 * lane;
            const u32x2 t2 = *(const u32x2*)(T2B + (size_t)tok * DM + c0), y0 = *(const u32x2*)(Y + (size_t)(2 * tok) * DM + c0), y1 = *(const u32x2*)(Y + (size_t)(2 * tok + 1) * DM + c0);
            const f32x4 g2 = *(const f32x4*)(p.ln2_g + c0), b2 = *(const f32x4*)(p.ln2_b + c0);
            const unsigned tw[2] = {t2.x, t2.y}, aw[2] = {y0.x, y0.y}, bw[2] = {y1.x, y1.y};
#pragma unroll
            for (int e = 0; e < 4; ++e) { const float tt = bf2f((bf16_t)(tw[e >> 1] >> (16 * (e & 1)))), ya = bf2f((bf16_t)(aw[e >> 1] >> (16 * (e & 1)))), yb = bf2f((bf16_t)(bw[e >> 1] >> (16 * (e & 1))));
                const float x2 = (tt - rs.mean) * rs.rstd * g2[e] + b2[e]; const float t3 = ALPHA * x2 + ya + yb; v[4 * j + e] = t3; s += t3; } }
        const float mean = wave_sum(s) * (1.f / DM); float qq = 0.f;
#pragma unroll
        for (int i = 0; i < 16; ++i) { v[i] -= mean; qq += v[i] * v[i]; }
        const float rstd = 1.0f / sqrtf(wave_sum(qq) * (1.f / DM) + LN_EPS);
#pragma unroll
        for (int j = 0; j < 4; ++j) { const int c0 = 256 * j + 4 * lane; const f32x4 g3 = *(const f32x4*)(p.ln3_g + c0), b3 = *(const f32x4*)(p.ln3_b + c0);
            f32x4 o; o.x = v[4 * j] * rstd * g3.x + b3.x; o.y = v[4 * j + 1] * rstd * g3.y + b3.y; o.z = v[4 * j + 2] * rstd * g3.z + b3.z; o.w = v[4 * j + 3] * rstd * g3.w + b3.w;
            *(f32x4*)(p.out + (size_t)tok * DM + c0) = o; }
    }
}

__global__ void __launch_bounds__(512, 2) fwd_kernel(Params p) {
    extern __shared__ __attribute__((aligned(16))) unsigned char lds[];
    cg::grid_group grid = cg::this_grid();
#ifndef ONLY
#define ONLY -1
#endif
#ifdef PMASK
#define RUNP(k) ((PMASK >> (k)) & 1)
#else
#define RUNP(k) (ONLY < 0 || ONLY == (k))
#endif
    const int lo = p.ph_lo, hi = p.ph_hi;
#define IN(k) (RUNP(k) && lo <= (k) && (k) < hi)
#define SEAM(k) do { if (lo <= (k) && (k) + 1 < hi) grid.sync(); } while (0)
    if (IN(0)) { phase_prep(p, lds); } SEAM(0);
    if (IN(1)) { phase_proj_simple(p); } SEAM(1);
    if (IN(2)) { phase_conv_simple(p); phase_sb_simple(p); } SEAM(2);
    if (IN(3)) { phase_outproj_simple(p); } SEAM(3);
    if (IN(4)) { phase_mq_simple(p); } SEAM(4);
    if (IN(5)) { phase_xattn_simple(p, lds); } SEAM(5);
    if (IN(6)) { phase_mo_simple(p); } SEAM(6);
    if (IN(7)) { phase_router_simple(p); } SEAM(7);
    if (IN(8)) { phase_route(p); } SEAM(8);
    if (IN(9)) { phase_moe1_simple(p); } SEAM(9);
    if (IN(10)) { phase_moe2_simple(p); } SEAM(10);
    if (IN(11)) { phase_final(p); }
}

extern "C" void kernel_launch(void* const* d_in, const int* in_sizes, int n_in, void* d_out, int out_size, void* d_ws, size_t ws_size, hipStream_t stream) {
    static int grid = 0;
    if (grid == 0) {
        if (n_in != 24 || out_size != NTOK * DM || ws_size < WS_END) { fprintf(stderr, "kernel_launch: unexpected problem: n_in %d out %d ws %zu\n", n_in, out_size, ws_size); grid = -1; return; }
        int dev = 0, cus = 0, per_cu = 0;
        (void)hipGetDevice(&dev); (void)hipDeviceGetAttribute(&cus, hipDeviceAttributeMultiprocessorCount, dev);
        (void)hipFuncSetAttribute((const void*)fwd_kernel, hipFuncAttributeMaxDynamicSharedMemorySize, LDS_BYTES);
        (void)hipOccupancyMaxActiveBlocksPerMultiprocessor(&per_cu, (const void*)fwd_kernel, 512, LDS_BYTES);
        if (per_cu < 1) { fprintf(stderr, "kernel_launch: occupancy query reports %d blocks per CU\n", per_cu); }
        grid = cus;
    }
    if (grid < 0) return;
    Params p{};
    const float** f = (const float**)&p;
    for (int i = 0; i < 24; ++i) f[i] = (const float*)d_in[i];
    p.out = (float*)d_out; p.ws = (unsigned char*)d_ws;
#if MK_ONE_LAUNCH
    p.ph_lo = 0; p.ph_hi = NPHASE;
    void* args[] = {&p};
    hipError_t e = hipLaunchCooperativeKernel((void*)fwd_kernel, dim3(grid), dim3(512), args, LDS_BYTES, stream);
    if (e != hipSuccess) fprintf(stderr, "cooperative launch failed: %s\n", hipGetErrorString(e));
#else
    for (int ph = 0; ph < NPHASE; ++ph) {
        p.ph_lo = ph; p.ph_hi = ph + 1;
        void* args[] = {&p};
        hipError_t e = hipLaunchCooperativeKernel((void*)fwd_kernel, dim3(grid), dim3(512), args, LDS_BYTES, stream);
        if (e != hipSuccess) { fprintf(stderr, "launch %d failed: %s\n", ph, hipGetErrorString(e)); break; }
    }
#endif
}
```

```cpp
#include <hip/hip_runtime.h>
#include <hip/hip_cooperative_groups.h>
#include <cstdio>
#include <cstdint>
namespace cg = cooperative_groups;

#ifndef MK_ONE_LAUNCH
#define MK_ONE_LAUNCH 1
#endif

typedef unsigned short bf16_t;
typedef short bf16x8 __attribute__((ext_vector_type(8)));
typedef float f32x4 __attribute__((ext_vector_type(4)));
typedef float f32x16 __attribute__((ext_vector_type(16)));
typedef unsigned u32x4 __attribute__((ext_vector_type(4)));
typedef unsigned u32x2 __attribute__((ext_vector_type(2)));

constexpr int NB = 32, SEQ = 2048, DM = 1024, NTOK = NB * SEQ;
constexpr int MEML = 256, NMEM = NB * MEML;
constexpr int NPROJ = 2560;
constexpr int PW = 3072;
constexpr int C_CB = 0, C_CC = 512, C_CH = 1024, C_Q = 1536, C_K = 2048, C_V = 2560;
constexpr int NHEAD = 8, HD = 64;
constexpr int MH = 4, MHD = 256;
constexpr int NEXP = 32, DEXP = 512, NLOG = 36, NLOGP = 64;
constexpr int CAP = 2 * NTOK;
constexpr float ALPHA = 1.189207115002721f;
constexpr float LN_EPS = 1e-5f, RMS_EPS = 1e-6f;
constexpr float LOG2E = 1.4426950408889634f;
constexpr float QS_SB = 0.125f * LOG2E;
constexpr float QS_X = 0.0625f * LOG2E;

constexpr size_t MiB = 1u << 20;
constexpr size_t WS_STATS1 = 0;
constexpr size_t WS_STATS2 = 1 * MiB;
constexpr size_t WS_CNT = 2 * MiB;
constexpr size_t WS_CS1 = 2 * MiB + 4096;
constexpr size_t WS_CS2 = WS_CS1 + 8192;
constexpr size_t WS_CSGU = 3 * MiB;
constexpr size_t WS_EID = 4 * MiB;
constexpr size_t WS_GATE = 5 * MiB;
constexpr size_t WS_LOGIT = 8 * MiB;
constexpr size_t WS_ROWL = 24 * MiB;
constexpr size_t WS_WRT = 40 * MiB;
constexpr size_t WS_WIN = 64 * MiB;
constexpr size_t WS_WOUT = 70 * MiB;
constexpr size_t WS_WMQ = 72 * MiB, WS_WMK = 74 * MiB, WS_WMV = 76 * MiB, WS_WMO = 78 * MiB;
constexpr size_t WS_WGU = 80 * MiB;
constexpr size_t WS_WD = 144 * MiB;
constexpr size_t WS_XB = 192 * MiB;
constexpr size_t WS_T1B = 192 * MiB;
constexpr size_t WS_MEMB = 320 * MiB;
constexpr size_t WS_MEMK = 336 * MiB;
constexpr size_t WS_MEMVT = 352 * MiB;
constexpr size_t WS_PROJ = 368 * MiB;
constexpr size_t WS_QM = 368 * MiB;
constexpr size_t WS_OB = 496 * MiB;
constexpr size_t WS_Y = 368 * MiB;
constexpr size_t WS_VT = 688 * MiB;
constexpr size_t WS_YMIX = 752 * MiB;
constexpr size_t WS_T2B = 752 * MiB;
constexpr size_t WS_H = 880 * MiB;
constexpr size_t WS_END = 1016 * MiB;

constexpr int LDS_BYTES = 147456;
constexpr int NPHASE = 12;

struct Params {
    const float *x, *mem, *w_in, *conv_w, *gn_conv, *gn_sb, *w_out, *ln1_g, *ln1_b, *w_mq, *w_mk, *w_mv, *w_mo, *ln2_g, *ln2_b,
        *w_rg, *b_rg, *w_re, *b_re, *w_gate, *w_up, *w_down, *ln3_g, *ln3_b;
    float* out; unsigned char* ws; int ph_lo, ph_hi;
};

__device__ __forceinline__ float bf2f(bf16_t v) { return __uint_as_float((unsigned)v << 16); }
__device__ __forceinline__ bf16_t f2bf(float f) { unsigned u = __float_as_uint(f); return (bf16_t)((u + 0x7fffu + ((u >> 16) & 1u)) >> 16); }
__device__ __forceinline__ unsigned pk2(float lo, float hi) { return (unsigned)f2bf(lo) | ((unsigned)f2bf(hi) << 16); }
__device__ __forceinline__ float wave_sum(float v) {
#pragma unroll
    for (int o = 1; o < 64; o <<= 1) v += __shfl_xor(v, o);
    return v;
}
__device__ __forceinline__ float wave_max(float v) {
#pragma unroll
    for (int o = 1; o < 64; o <<= 1) v = fmaxf(v, __shfl_xor(v, o));
    return v;
}
#define MFMA32(a, b, c) __builtin_amdgcn_mfma_f32_32x32x16_bf16((a), (b), (c), 0, 0, 0)

template <int NBLK, class AR, class BR>
__device__ __forceinline__ void wave_tile(int K, AR arow, BR brow, f32x16 (&c)[2][2 * NBLK]) {
    const int lane = threadIdx.x & 63, r = lane & 31, h = lane >> 5;
    const bf16_t* ap[2]; const bf16_t* bp[2 * NBLK];
#pragma unroll
    for (int i = 0; i < 2; ++i) ap[i] = arow(32 * i + r) + 8 * h;
#pragma unroll
    for (int j = 0; j < 2 * NBLK; ++j) bp[j] = brow(32 * j + r) + 8 * h;
#pragma unroll
    for (int i = 0; i < 2; ++i)
#pragma unroll
        for (int j = 0; j < 2 * NBLK; ++j)
#pragma unroll
            for (int q = 0; q < 16; ++q) c[i][j][q] = 0.f;
#pragma unroll 2
    for (int k = 0; k < K; k += 16) {
        bf16x8 fa[2], fb[2 * NBLK];
#pragma unroll
        for (int i = 0; i < 2; ++i) fa[i] = *(const bf16x8*)(ap[i] + k);
#pragma unroll
        for (int j = 0; j < 2 * NBLK; ++j) fb[j] = *(const bf16x8*)(bp[j] + k);
#pragma unroll
        for (int i = 0; i < 2; ++i)
#pragma unroll
            for (int j = 0; j < 2 * NBLK; ++j) c[i][j] = MFMA32(fa[i], fb[j], c[i][j]);
    }
}
#define TROW(i, q) (32 * (i) + ((q) & 3) + 8 * ((q) >> 2) + 4 * ((int)(threadIdx.x & 63) >> 5))
#define TCOL(j) (32 * (j) + (int)(threadIdx.x & 31))

struct RowStat { float mean, rstd; };
__device__ __forceinline__ RowStat row_stat(const float* st, int row) {
    const float s = st[2 * row], q = st[2 * row + 1];
    RowStat r; r.mean = s * (1.f / DM); const float var = fmaxf(q * (1.f / DM) - r.mean * r.mean, 0.f); r.rstd = 1.0f / sqrtf(var + LN_EPS); return r;
}

__device__ __forceinline__ void transpose_item(const float* W, int K, int N, int k0, int n0, bf16_t* WT, int orow0, const float* ks, float ns, float* scr, int lane) {
#pragma unroll 8
    for (int i = 0; i < 32; ++i) { const int kk = 2 * i + (lane >> 5); float v = W[(size_t)(k0 + kk) * N + n0 + (lane & 31)]; if (ks) v *= ks[k0 + kk]; scr[kk * 33 + (lane & 31)] = v * ns; }
    asm volatile("s_waitcnt vmcnt(0) lgkmcnt(0)" ::: "memory");
    const int c = lane & 7;
#pragma unroll
    for (int j = 0; j < 4; ++j) { const int n = (lane >> 3) + 8 * j; const float* s = scr + (8 * c) * 33 + n;
        u32x4 o; o.x = pk2(s[0 * 33], s[1 * 33]); o.y = pk2(s[2 * 33], s[3 * 33]); o.z = pk2(s[4 * 33], s[5 * 33]); o.w = pk2(s[6 * 33], s[7 * 33]);
        *(u32x4*)(WT + (size_t)(orow0 + n) * K + k0 + 8 * c) = o; }
    asm volatile("s_waitcnt lgkmcnt(0)" ::: "memory");
}
__device__ void phase_prep(const Params& p, unsigned char* lds) {
    unsigned char* ws = p.ws;
    const int tid = threadIdx.x, lane = tid & 63, wave = tid >> 6;
    const int gw = blockIdx.x * 8 + wave, NGW = gridDim.x * 8;
    const int gt = blockIdx.x * 512 + tid, NGT = gridDim.x * 512;
    float* scr = (float*)(lds + wave * 16384);
    bf16_t* WIN = (bf16_t*)(ws + WS_WIN); bf16_t* WOUT = (bf16_t*)(ws + WS_WOUT); bf16_t* WMQ = (bf16_t*)(ws + WS_WMQ); bf16_t* WMK = (bf16_t*)(ws + WS_WMK);
    bf16_t* WMV = (bf16_t*)(ws + WS_WMV); bf16_t* WMO = (bf16_t*)(ws + WS_WMO); bf16_t* WGU = (bf16_t*)(ws + WS_WGU); bf16_t* WD = (bf16_t*)(ws + WS_WD);
    constexpr int I_IN = 16 * 96, I_SQ = 16 * 32, I_G = 32 * 16 * 16, I_D = 32 * 8 * 32;
    constexpr int NITEMS = I_IN + 5 * I_SQ + 2 * I_G + I_D;
    for (int it = gw; it < NITEMS; it += NGW) {
        int r = it;
        if (r < I_IN) { const int kb = r / 96, nb = r % 96, n0 = nb * 32; transpose_item(p.w_in, DM, PW, kb * 64, n0, WIN, n0, nullptr, (n0 >= C_Q && n0 < C_K) ? QS_SB : 1.f, scr, lane); continue; } r -= I_IN;
        if (r < I_SQ) { transpose_item(p.w_out, DM, DM, (r / 32) * 64, (r % 32) * 32, WOUT, (r % 32) * 32, nullptr, 1.f, scr, lane); continue; } r -= I_SQ;
        if (r < I_SQ) { transpose_item(p.w_mq, DM, DM, (r / 32) * 64, (r % 32) * 32, WMQ, (r % 32) * 32, p.ln1_g, QS_X, scr, lane); continue; } r -= I_SQ;
        if (r < I_SQ) { transpose_item(p.w_mk, DM, DM, (r / 32) * 64, (r % 32) * 32, WMK, (r % 32) * 32, nullptr, 1.f, scr, lane); continue; } r -= I_SQ;
        if (r < I_SQ) { transpose_item(p.w_mv, DM, DM, (r / 32) * 64, (r % 32) * 32, WMV, (r % 32) * 32, nullptr, 1.f, scr, lane); continue; } r -= I_SQ;
        if (r < I_SQ) { transpose_item(p.w_mo, DM, DM, (r / 32) * 64, (r % 32) * 32, WMO, (r % 32) * 32, nullptr, 1.f, scr, lane); continue; } r -= I_SQ;
        if (r < 2 * I_G) { const int up = r >= I_G; if (up) r -= I_G; const int e = r / 256, q = r % 256, kb = q / 16, nb = q % 16, n0 = nb * 32;
            const float* W = (up ? p.w_up : p.w_gate) + (size_t)e * DM * DEXP; const int orow0 = 256 * (n0 / 128) + (up ? 128 : 0) + (n0 % 128);
            transpose_item(W, DM, DEXP, kb * 64, n0, WGU + (size_t)e * 1024 * 1024, orow0, p.ln2_g, 1.f, scr, lane); continue; } r -= 2 * I_G;
        { const int e = r / 256, q = r % 256, kb = q / 32, nb = q % 32; transpose_item(p.w_down + (size_t)e * DEXP * DM, DEXP, DM, kb * 64, nb * 32, WD + (size_t)e * 1024 * 512, nb * 32, nullptr, 1.f, scr, lane); }
    }
    { bf16_t* WRT = (bf16_t*)(ws + WS_WRT);
      for (int i = gt; i < 256 * DM; i += NGT) { const int n = i / DM, k = i % DM; float v = 0.f;
          if (n < 4) v = p.w_rg[k * 4 + n] * p.ln2_g[k]; else if (n < NLOG) v = p.w_re[k * 32 + (n - 4)] * p.ln2_g[k];
          WRT[i] = f2bf(v); } }
    { float* cs1 = (float*)(ws + WS_CS1); float* bs1 = cs1 + 1024; float* cs2 = (float*)(ws + WS_CS2); float* bs2 = cs2 + 64;
      float* csg = (float*)(ws + WS_CSGU); float* bsg = csg + NEXP * 1024;
      constexpr int NV = 1024 + 64 + NEXP * 1024;
      for (int i = gt; i < NV; i += NGT) {
          if (i < 1024) { const int n = i; float cs = 0.f, bs = 0.f;
              for (int k = 0; k < DM; ++k) { const float w = p.w_mq[(size_t)k * DM + n]; cs += bf2f(f2bf(w * p.ln1_g[k] * QS_X)); bs += p.ln1_b[k] * w; }
              cs1[n] = cs; bs1[n] = bs * QS_X; }
          else if (i < 1088) { const int n = i - 1024; float cs = 0.f, bs = 0.f;
              if (n < NLOG) { for (int k = 0; k < DM; ++k) { const float w = n < 4 ? p.w_rg[k * 4 + n] : p.w_re[k * 32 + (n - 4)]; cs += bf2f(f2bf(w * p.ln2_g[k])); bs += p.ln2_b[k] * w; }
                  bs += n < 4 ? p.b_rg[n] : p.b_re[n - 4]; }
              cs2[n] = cs; bs2[n] = bs; }
          else { const int j = i - 1088, e = j / 1024, row = j % 1024, pn = row / 256, rr = row % 256, up = rr >= 128, n = pn * 128 + (rr & 127);
              const float* W = (up ? p.w_up : p.w_gate) + (size_t)e * DM * DEXP; float cs = 0.f, bs = 0.f;
              for (int k = 0; k < DM; ++k) { const float w = W[(size_t)k * DEXP + n]; cs += bf2f(f2bf(w * p.ln2_g[k])); bs += p.ln2_b[k] * w; }
              csg[j] = cs; bsg[j] = bs; }
      } }
    { bf16_t* XB = (bf16_t*)(ws + WS_XB); bf16_t* MB = (bf16_t*)(ws + WS_MEMB);
      const f32x4* x4 = (const f32x4*)p.x; u32x2* xb2 = (u32x2*)XB;
      for (int i = gt; i < NTOK * DM / 4; i += NGT) { const f32x4 v = x4[i]; u32x2 o; o.x = pk2(v.x, v.y); o.y = pk2(v.z, v.w); xb2[i] = o; }
      const f32x4* m4 = (const f32x4*)p.mem; u32x2* mb2 = (u32x2*)MB;
      for (int i = gt; i < NMEM * DM / 4; i += NGT) { const f32x4 v = m4[i]; u32x2 o; o.x = pk2(v.x, v.y); o.y = pk2(v.z, v.w); mb2[i] = o; } }
    { float* s1 = (float*)(ws + WS_STATS1); float* s2 = (float*)(ws + WS_STATS2); unsigned* cnt = (unsigned*)(ws + WS_CNT);
      for (int i = gt; i < 2 * NTOK; i += NGT) { s1[i] = 0.f; s2[i] = 0.f; }
      if (gt < 64) cnt[gt] = 0u; }
}

__device__ void phase_proj_simple(const Params& p) {
    unsigned char* ws = p.ws; const int wave = threadIdx.x >> 6; const int gw = blockIdx.x * 8 + wave, NGW = gridDim.x * 8;
    const bf16_t* XB = (const bf16_t*)(ws + WS_XB); const bf16_t* WIN = (const bf16_t*)(ws + WS_WIN); const bf16_t* MB = (const bf16_t*)(ws + WS_MEMB);
    const bf16_t* WMK = (const bf16_t*)(ws + WS_WMK); const bf16_t* WMV = (const bf16_t*)(ws + WS_WMV);
    bf16_t* PROJ = (bf16_t*)(ws + WS_PROJ); bf16_t* VT = (bf16_t*)(ws + WS_VT); bf16_t* MK = (bf16_t*)(ws + WS_MEMK); bf16_t* MVT = (bf16_t*)(ws + WS_MEMVT);
    constexpr int TA = (NTOK / 64) * (NPROJ / 64), TB = (512 / 64) * (NTOK / 64), TC = (NMEM / 64) * (DM / 64), TD = (DM / 64) * (NMEM / 64);
    for (int t = gw; t < TA + TB + TC + TD; t += NGW) {
        const bf16_t *A, *Bt; bf16_t* O; int ldo, tm, tn, r = t;
        if (r < TA) { A = XB; Bt = WIN; O = PROJ; ldo = NPROJ; tm = r / (NPROJ / 64); tn = r % (NPROJ / 64); }
        else if ((r -= TA) < TB) { A = WIN + (size_t)C_V * DM; Bt = XB; O = VT; ldo = NTOK; tm = r / (NTOK / 64); tn = r % (NTOK / 64); }
        else if ((r -= TB) < TC) { A = MB; Bt = WMK; O = MK; ldo = DM; tm = r / (DM / 64); tn = r % (DM / 64); }
        else { r -= TC; A = WMV; Bt = MB; O = MVT; ldo = NMEM; tm = r / (NMEM / 64); tn = r % (NMEM / 64); }
        f32x16 c[2][2];
        wave_tile<1>(DM, [&](int i) { return A + (size_t)(tm * 64 + i) * DM; }, [&](int j) { return Bt + (size_t)(tn * 64 + j) * DM; }, c);
#pragma unroll
        for (int i = 0; i < 2; ++i)
#pragma unroll
            for (int j = 0; j < 2; ++j)
#pragma unroll
                for (int q = 0; q < 16; ++q) O[(size_t)(tm * 64 + TROW(i, q)) * ldo + tn * 64 + TCOL(j)] = f2bf(c[i][j][q]);
    }
}

__device__ void phase_conv_simple(const Params& p) {
    unsigned char* ws = p.ws; const int lane = threadIdx.x & 63, wave = threadIdx.x >> 6; const int gw = blockIdx.x * 8 + wave, NGW = gridDim.x * 8;
    const bf16_t* PROJ = (const bf16_t*)(ws + WS_PROJ); bf16_t* YMIX = (bf16_t*)(ws + WS_YMIX);
    for (int it = gw; it < NTOK * 8; it += NGW) {
        const int tok = it >> 3, g = it & 7, c = g * 64 + lane, t = tok % SEQ;
        float acc = 0.f;
#pragma unroll
        for (int k = 0; k < 3; ++k) { const int tt = t - 2 + k; if (tt >= 0) { const bf16_t* row = PROJ + (size_t)(tok - 2 + k) * NPROJ; acc += p.conv_w[k * 512 + c] * (bf2f(row[C_CC + c]) * bf2f(row[C_CH + c])); } }
        const float y = bf2f(PROJ[(size_t)tok * NPROJ + C_CB + c]) * acc;
        const float ms = wave_sum(y * y) * (1.f / 64.f);
        YMIX[(size_t)tok * DM + c] = f2bf(y * (1.0f / sqrtf(ms + RMS_EPS)) * p.gn_conv[c]);
    }
}
__device__ void phase_sb_simple(const Params& p) {
    unsigned char* ws = p.ws; const int lane = threadIdx.x & 63, wave = threadIdx.x >> 6; const int gw = blockIdx.x * 8 + wave, NGW = gridDim.x * 8;
    const bf16_t* PROJ = (const bf16_t*)(ws + WS_PROJ); const bf16_t* VT = (const bf16_t*)(ws + WS_VT); bf16_t* YMIX = (bf16_t*)(ws + WS_YMIX);
    for (int it = gw; it < NTOK * NHEAD; it += NGW) {
        const int tok = it / NHEAD, h = it % NHEAD, b = tok / SEQ, t = tok % SEQ;
        float q[64], o[64];
        { const bf16_t* qp = PROJ + (size_t)tok * NPROJ + C_Q + h * 64;
#pragma unroll
          for (int d = 0; d < 64; ++d) { q[d] = bf2f(qp[d]); o[d] = 0.f; } }
        float R = 0.f;
        for (int c0 = t - 1; c0 >= 0; c0 -= 64) {
            const int s = c0 - lane; const bool valid = s >= 0; const int sc = valid ? s : 0;
            const bf16_t* kp = PROJ + (size_t)(b * SEQ + sc) * NPROJ + C_K + h * 64;
            float dot = 0.f;
#pragma unroll
            for (int d8 = 0; d8 < 8; ++d8) { const bf16x8 kv = *(const bf16x8*)(kp + d8 * 8);
#pragma unroll
                for (int j = 0; j < 8; ++j) dot += q[d8 * 8 + j] * bf2f((bf16_t)kv[j]); }
            const float sp = fmaxf(dot, 0.f) + __log2f(1.0f + exp2f(-fabsf(dot)));
            const float L = valid ? -sp : 0.f;
            float incl = L;
#pragma unroll
            for (int off = 1; off < 64; off <<= 1) { const float n = __shfl_up(incl, off); if (lane >= off) incl += n; }
            const float w = valid ? exp2f(dot + L + (R + incl - L)) : 0.f;
            R += __shfl(incl, 63);
            const bf16_t* vp = VT + (size_t)(h * 64) * NTOK + b * SEQ + sc;
#pragma unroll
            for (int d = 0; d < 64; ++d) o[d] += w * bf2f(vp[(size_t)d * NTOK]);
        }
        float ss = 0.f, mine = 0.f;
#pragma unroll
        for (int d = 0; d < 64; ++d) { const float v = wave_sum(o[d]); ss += v * v; if (d == lane) mine = v; }
        YMIX[(size_t)tok * DM + 512 + h * 64 + lane] = f2bf(mine * (1.0f / sqrtf(ss * (1.f / 64.f) + RMS_EPS)) * p.gn_sb[h * 64 + lane]);
    }
}

template <bool STATS, class Epi>
__device__ __forceinline__ void gemm_simple(const bf16_t* A, const bf16_t* Bt, int M, int N, int K, float* st, Epi epi) {
    const int wave = threadIdx.x >> 6, lane = threadIdx.x & 63; const int gw = blockIdx.x * 8 + wave, NGW = gridDim.x * 8;
    const int tn_n = N / 64, nt = (M / 64) * tn_n;
    for (int t = gw; t < nt; t += NGW) {
        const int tm = t / tn_n, tn = t % tn_n;
        f32x16 c[2][2];
        wave_tile<1>(K, [&](int i) { return A + (size_t)(tm * 64 + i) * K; }, [&](int j) { return Bt + (size_t)(tn * 64 + j) * K; }, c);
#pragma unroll
        for (int i = 0; i < 2; ++i)
#pragma unroll
            for (int q = 0; q < 16; ++q) { const int row = tm * 64 + TROW(i, q); float s = 0.f, qq = 0.f;
#pragma unroll
                for (int j = 0; j < 2; ++j) { const float v = epi(row, tn * 64 + TCOL(j), c[i][j][q]); s += v; qq += v * v; }
                if (STATS) {
#pragma unroll
                    for (int o = 1; o < 32; o <<= 1) { s += __shfl_xor(s, o); qq += __shfl_xor(qq, o); }
                    if ((lane & 31) == 0) { atomicAdd(st + 2 * row, s); atomicAdd(st + 2 * row + 1, qq); } } }
    }
}
__device__ void phase_outproj_simple(const Params& p) {
    unsigned char* ws = p.ws; bf16_t* T1B = (bf16_t*)(ws + WS_T1B); const float* x = p.x;
    gemm_simple<true>((const bf16_t*)(ws + WS_YMIX), (const bf16_t*)(ws + WS_WOUT), NTOK, DM, DM, (float*)(ws + WS_STATS1),
        [=](int row, int col, float v) { const float t = ALPHA * x[(size_t)row * DM + col] + v; T1B[(size_t)row * DM + col] = f2bf(t); return t; });
}
__device__ void phase_mq_simple(const Params& p) {
    unsigned char* ws = p.ws; bf16_t* QM = (bf16_t*)(ws + WS_QM); const float* st = (const float*)(ws + WS_STATS1); const float* cs = (const float*)(ws + WS_CS1); const float* bs = cs + 1024;
    gemm_simple<false>((const bf16_t*)(ws + WS_T1B), (const bf16_t*)(ws + WS_WMQ), NTOK, DM, DM, nullptr,
        [=](int row, int col, float v) { const RowStat r = row_stat(st, row); QM[(size_t)row * DM + col] = f2bf(r.rstd * (v - r.mean * cs[col]) + bs[col]); return 0.f; });
}
__device__ void phase_xattn_simple(const Params& p, unsigned char* lds) {
    unsigned char* ws = p.ws; const int lane = threadIdx.x & 63, wave = threadIdx.x >> 6; const int gw = blockIdx.x * 8 + wave, NGW = gridDim.x * 8;
    const bf16_t* QM = (const bf16_t*)(ws + WS_QM); const bf16_t* MK = (const bf16_t*)(ws + WS_MEMK); const bf16_t* MVT = (const bf16_t*)(ws + WS_MEMVT); bf16_t* OB = (bf16_t*)(ws + WS_OB);
    float* qs = (float*)(lds + wave * 4096); float* ps = qs + 256;
    for (int it = gw; it < NTOK * MH; it += NGW) {
        const int tok = it / MH, h = it % MH, b = tok / SEQ;
        const bf16_t* qp = QM + (size_t)tok * DM + h * MHD;
#pragma unroll
        for (int j = 0; j < 4; ++j) qs[lane + 64 * j] = bf2f(qp[lane + 64 * j]);
        asm volatile("s_waitcnt lgkmcnt(0)" ::: "memory");
        float sc[4];
#pragma unroll
        for (int j = 0; j < 4; ++j) { const int key = lane + 64 * j; const bf16_t* kp = MK + (size_t)(b * MEML + key) * DM + h * MHD; float dot = 0.f;
#pragma unroll 2
            for (int d8 = 0; d8 < 32; ++d8) { const bf16x8 kv = *(const bf16x8*)(kp + d8 * 8);
#pragma unroll
                for (int e = 0; e < 8; ++e) dot += qs[d8 * 8 + e] * bf2f((bf16_t)kv[e]); }
            sc[j] = dot; }
        const float mx = wave_max(fmaxf(fmaxf(sc[0], sc[1]), fmaxf(sc[2], sc[3])));
        float sum = 0.f;
#pragma unroll
        for (int j = 0; j < 4; ++j) { sc[j] = exp2f(sc[j] - mx); sum += sc[j]; }
        sum = wave_sum(sum); const float inv = 1.0f / sum;
#pragma unroll
        for (int j = 0; j < 4; ++j) ps[lane + 64 * j] = sc[j] * inv;
        asm volatile("s_waitcnt lgkmcnt(0)" ::: "memory");
#pragma unroll
        for (int j = 0; j < 4; ++j) { const int d = lane + 64 * j; const bf16_t* vp = MVT + (size_t)(h * MHD + d) * NMEM + b * MEML; float acc = 0.f;
#pragma unroll 2
            for (int k8 = 0; k8 < 32; ++k8) { const bf16x8 vv = *(const bf16x8*)(vp + k8 * 8);
#pragma unroll
                for (int e = 0; e < 8; ++e) acc += ps[k8 * 8 + e] * bf2f((bf16_t)vv[e]); }
            OB[(size_t)tok * DM + h * MHD + d] = f2bf(acc); }
        asm volatile("s_waitcnt lgkmcnt(0)" ::: "memory");
    }
}
__device__ void phase_mo_simple(const Params& p) {
    unsigned char* ws = p.ws; bf16_t* T2B = (bf16_t*)(ws + WS_T2B); const bf16_t* T1B = (const bf16_t*)(ws + WS_T1B); const float* st1 = (const float*)(ws + WS_STATS1);
    const float* g1 = p.ln1_g; const float* b1 = p.ln1_b;
    gemm_simple<true>((const bf16_t*)(ws + WS_OB), (const bf16_t*)(ws + WS_WMO), NTOK, DM, DM, (float*)(ws + WS_STATS2),
        [=](int row, int col, float v) { const RowStat r = row_stat(st1, row); const float x1 = (bf2f(T1B[(size_t)row * DM + col]) - r.mean) * r.rstd * g1[col] + b1[col];
            const float t = ALPHA * x1 + v; T2B[(size_t)row * DM + col] = f2bf(t); return t; });
}
__device__ void phase_router_simple(const Params& p) {
    unsigned char* ws = p.ws; float* LG = (float*)(ws + WS_LOGIT); const float* st = (const float*)(ws + WS_STATS2); const float* cs = (const float*)(ws + WS_CS2); const float* bs = cs + 64;
    gemm_simple<false>((const bf16_t*)(ws + WS_T2B), (const bf16_t*)(ws + WS_WRT), NTOK, 64, DM, nullptr,
        [=](int row, int col, float v) { const RowStat r = row_stat(st, row); LG[(size_t)row * NLOGP + col] = r.rstd * (v - r.mean * cs[col]) + bs[col]; return 0.f; });
}
__device__ void phase_route(const Params& p) {
    unsigned char* ws = p.ws; const int gt = blockIdx.x * 512 + threadIdx.x, NGT = gridDim.x * 512;
    const float* LG = (const float*)(ws + WS_LOGIT); int* EID = (int*)(ws + WS_EID); float* GATE = (float*)(ws + WS_GATE); unsigned* CNT = (unsigned*)(ws + WS_CNT); int* ROWL = (int*)(ws + WS_ROWL);
    for (int tok = gt; tok < NTOK; tok += NGT) {
        const float* lg = LG + (size_t)tok * NLOGP;
        int grp = 0; float gm = lg[0];
#pragma unroll
        for (int g = 1; g < 4; ++g) if (lg[g] > gm) { gm = lg[g]; grp = g; }
        float gs = 0.f;
#pragma unroll
        for (int g = 0; g < 4; ++g) gs += __expf(lg[g] - gm);
        const float gprob = 1.0f / gs;
        const float* el = lg + 4 + grp * 8;
        int i1 = 0; float l1 = el[0];
#pragma unroll
        for (int j = 1; j < 8; ++j) if (el[j] > l1) { l1 = el[j]; i1 = j; }
        int i2 = -1; float l2 = 0.f;
#pragma unroll
        for (int j = 0; j < 8; ++j) if (j != i1 && (i2 < 0 || el[j] > l2)) { l2 = el[j]; i2 = j; }
        const float e2 = __expf(l2 - l1), w1 = 1.0f / (1.0f + e2), w2 = e2 * w1;
        const int ea = grp * 8 + i1, eb = grp * 8 + i2;
        EID[2 * tok] = ea; EID[2 * tok + 1] = eb; GATE[2 * tok] = gprob * w1; GATE[2 * tok + 1] = gprob * w2;
        const unsigned pa = atomicAdd(CNT + ea, 1u); ROWL[(size_t)ea * CAP + pa] = 2 * tok;
        const unsigned pb = atomicAdd(CNT + eb, 1u); ROWL[(size_t)eb * CAP + pb] = 2 * tok + 1;
    }
}
__device__ void phase_moe1_simple(const Params& p) {
    unsigned char* ws = p.ws; const int wave = threadIdx.x >> 6; const int gw = blockIdx.x * 8 + wave, NGW = gridDim.x * 8;
    const unsigned* CNT = (const unsigned*)(ws + WS_CNT); const int* ROWL = (const int*)(ws + WS_ROWL); const bf16_t* T2B = (const bf16_t*)(ws + WS_T2B); const bf16_t* WGU = (const bf16_t*)(ws + WS_WGU);
    const float* st = (const float*)(ws + WS_STATS2); const float* csg = (const float*)(ws + WS_CSGU); const float* bsg = csg + NEXP * 1024; bf16_t* H = (bf16_t*)(ws + WS_H);
    int tbase = 0, hoff = 0;
    for (int e = 0; e < NEXP; ++e) {
        const int cnt = (int)CNT[e], nrt = (cnt + 63) / 64, ntile = nrt * 8;
        for (int t = gw - tbase; t < ntile; t += NGW) { if (t < 0) continue;
            const int tm = t / 8, ct = t % 8, pn = ct >> 1, hf = ct & 1; const int* rl = ROWL + (size_t)e * CAP; const bf16_t* W = WGU + (size_t)e * 1024 * 1024;
            f32x16 c[2][4];
            wave_tile<2>(DM, [&](int i) { int r = tm * 64 + i; r = r < cnt ? r : cnt - 1; return T2B + (size_t)(rl[r] >> 1) * DM; },
                         [&](int j) { const int row = 256 * pn + (j >= 64 ? 128 : 0) + 64 * hf + (j & 63); return W + (size_t)row * DM; }, c);
#pragma unroll
            for (int i = 0; i < 2; ++i)
#pragma unroll
                for (int q = 0; q < 16; ++q) { const int r = tm * 64 + TROW(i, q); if (r < cnt) { const RowStat rs = row_stat(st, rl[r] >> 1);
#pragma unroll
                    for (int j = 0; j < 2; ++j) { const int cg_ = 256 * pn + 64 * hf + TCOL(j), cu_ = cg_ + 128;
                        const float g = rs.rstd * (c[i][j][q] - rs.mean * csg[e * 1024 + cg_]) + bsg[e * 1024 + cg_];
                        const float u = rs.rstd * (c[i][j + 2][q] - rs.mean * csg[e * 1024 + cu_]) + bsg[e * 1024 + cu_];
                        H[(size_t)(hoff + r) * DEXP + 128 * pn + 64 * hf + TCOL(j)] = f2bf(g / (1.0f + __expf(-g)) * u); } } }
        }
        tbase = (tbase + ntile) % NGW; hoff += (cnt + 255) / 256 * 256;
    }
}
__device__ void phase_moe2_simple(const Params& p) {
    unsigned char* ws = p.ws; const int wave = threadIdx.x >> 6; const int gw = blockIdx.x * 8 + wave, NGW = gridDim.x * 8;
    const unsigned* CNT = (const unsigned*)(ws + WS_CNT); const int* ROWL = (const int*)(ws + WS_ROWL); const bf16_t* H = (const bf16_t*)(ws + WS_H); const bf16_t* WD = (const bf16_t*)(ws + WS_WD);
    const float* GATE = (const float*)(ws + WS_GATE); bf16_t* Y = (bf16_t*)(ws + WS_Y);
    int tbase = 0, hoff = 0;
    for (int e = 0; e < NEXP; ++e) {
        const int cnt = (int)CNT[e], nrt = (cnt + 63) / 64, ntile = nrt * 16;
        for (int t = gw - tbase; t < ntile; t += NGW) { if (t < 0) continue;
            const int tm = t / 16, tn = t % 16; const int* rl = ROWL + (size_t)e * CAP; const bf16_t* W = WD + (size_t)e * 1024 * 512;
            f32x16 c[2][2];
            wave_tile<1>(DEXP, [&](int i) { int r = tm * 64 + i; r = r < cnt ? r : cnt - 1; return H + (size_t)(hoff + r) * DEXP; }, [&](int j) { return W + (size_t)(tn * 64 + j) * DEXP; }, c);
#pragma unroll
            for (int i = 0; i < 2; ++i)
#pragma unroll
                for (int q = 0; q < 16; ++q) { const int r = tm * 64 + TROW(i, q); if (r < cnt) { const int a = rl[r]; const float g = GATE[a];
#pragma unroll
                    for (int j = 0; j < 2; ++j) Y[(size_t)a * DM + tn * 64 + TCOL(j)] = f2bf(g * c[i][j][q]); } }
        }
        tbase = (tbase + ntile) % NGW; hoff += (cnt + 255) / 256 * 256;
    }
}
__device__ void phase_final(const Params& p) {
    unsigned char* ws = p.ws; const int lane = threadIdx.x & 63, wave = threadIdx.x >> 6; const int gw = blockIdx.x * 8 + wave, NGW = gridDim.x * 8;
    const bf16_t* T2B = (const bf16_t*)(ws + WS_T2B); const bf16_t* Y = (const bf16_t*)(ws + WS_Y); const float* st = (const float*)(ws + WS_STATS2);
    for (int tok = gw; tok < NTOK; tok += NGW) {
        const RowStat rs = row_stat(st, tok);
        float v[16]; float s = 0.f;
#pragma unroll
        for (int j = 0; j < 4; ++j) { const int c0 = 256 * j + 4 * lane;
            const u32x2 t2 = *(const u32x2*)(T2B + (size_t)tok * DM + c0), y0 = *(const u32x2*)(Y + (size_t)(2 * tok) * DM + c0), y1 = *(const u32x2*)(Y + (size_t)(2 * tok + 1) * DM + c0);
            const f32x4 g2 = *(const f32x4*)(p.ln2_g + c0), b2 = *(const f32x4*)(p.ln2_b + c0);
            const unsigned tw[2] = {t2.x, t2.y}, aw[2] = {y0.x, y0.y}, bw[2] = {y1.x, y1.y};
#pragma unroll
            for (int e = 0; e < 4; ++e) { const float tt = bf2f((bf16_t)(tw[e >> 1] >> (16 * (e & 1)))), ya = bf2f((bf16_t)(aw[e >> 1] >> (16 * (e & 1)))), yb = bf2f((bf16_t)(bw[e >> 1] >> (16 * (e & 1))));
                const float x2 = (tt - rs.mean) * rs.rstd * g2[e] + b2[e]; const float t3 = ALPHA * x2 + ya + yb; v[4 * j + e] = t3; s += t3; } }
        const float mean = wave_sum(s) * (1.f / DM); float qq = 0.f;
#pragma unroll
        for (int i = 0; i < 16; ++i) { v[i] -= mean; qq += v[i] * v[i]; }
        const float rstd = 1.0f / sqrtf(wave_sum(qq) * (1.f / DM) + LN_EPS);
#pragma unroll
        for (int j = 0; j < 4; ++j) { const int c0 = 256 * j + 4 * lane; const f32x4 g3 = *(const f32x4*)(p.ln3_g + c0), b3 = *(const f32x4*)(p.ln3_b + c0);
            f32x4 o; o.x = v[4 * j] * rstd * g3.x + b3.x; o.y = v[4 * j + 1] * rstd * g3.y + b3.y; o.z = v[4 * j + 2] * rstd * g3.z + b3.z; o.w = v[4 * j + 3] * rstd * g3.w + b3.w;
            *(f32x4*)(p.out + (size_t)tok * DM + c0) = o; }
    }
}

namespace mm {
#define LAS __attribute__((address_space(3)))
constexpr int BM = 256, BK = 64, HALF = 128, HTB = HALF * BK * 2, STAGE_BYTES = 8 * HTB, NXCD = 8, WGM = 8;
__device__ __forceinline__ int lds_byte(int r, int c) { const int st = (r >> 4) * 2 + (c >> 5), rr = r & 15, cc = c & 31, ob = rr * 64 + cc * 2; return st * 1024 + (ob ^ (((ob >> 9) & 1) << 5)); }
__device__ __forceinline__ void stage_rc(int b, int& R, int& C) { const int st = b / 1024, sb = b % 1024, swz = sb ^ (((sb >> 9) & 1) << 5); R = (st >> 1) * 16 + swz / 64; C = (st & 1) * 32 + (swz % 64) / 2; }
__device__ __forceinline__ int perm32(int rho) { const int n = rho >> 4, i = rho & 15; return 8 * (i >> 2) + 4 * n + (i & 3); }
__device__ __forceinline__ unsigned cvt_pk_bf16(float lo, float hi) { typedef float f2 __attribute__((ext_vector_type(2))); typedef __bf16 b2 __attribute__((ext_vector_type(2))); f2 v = {lo, hi}; b2 b = __builtin_convertvector(v, b2); return __builtin_bit_cast(unsigned, b); }

struct Unit { int pm, pn, aux, nvalid; const char* a; const char* b; const int* rows; };

__device__ __forceinline__ void order_map(int L, int nM, int nN, int& pm, int& pn) {
    const int nwg = nM * nN; int wgid = L; { const int q = nwg / NXCD, r = nwg % NXCD, xcd = wgid % NXCD, off = wgid / NXCD; wgid = (xcd < r ? xcd * (q + 1) : r * (q + 1) + (xcd - r) * q) + off; }
    const int nig = WGM * nN, gid = wgid / nig, fm = gid * WGM, gsz = (nM - fm) < WGM ? (nM - fm) : WGM;
    pm = fm + ((wgid % nig) % gsz); pn = (wgid % nig) / gsz;
}

template <class Epi, class Sched, bool GATHER>
__device__ __forceinline__ void gemm_phase(LAS unsigned char* lds, const int K, const Sched& S, const Epi& E) {
    const int tid = threadIdx.x, wid = __builtin_amdgcn_readfirstlane(tid >> 6), lane = tid & 63, wr = wid >> 2, wc = wid & 3, fr = lane & 15, fq = lane >> 4;
    const int nt = K / BK;
    unsigned voffB, voffA, rp[2];
    { int sR, sC; stage_rc(tid * 16, sR, sC); const int Rb = Epi::PERM ? ((sR & ~31) + perm32(sR & 31)) : sR;
      voffB = (unsigned)(Rb * K + sC) * 2u; voffA = GATHER ? (unsigned)sC * 2u : (unsigned)(sR * K + sC) * 2u; }
    const size_t kstep = (size_t)(BK * 2), hstep = (size_t)HALF * K * 2, r64 = (size_t)64 * K * 2;
    const unsigned ldsw = (unsigned)wid * 1024u;
    const int aoff = lds_byte(wr * 64 + fr, fq * 8), boff = lds_byte(wc * 32 + fr, fq * 8);
#define MM_SA(b, h) (((b) * 2 + (h)) * HTB)
#define MM_SB(b, h) ((4 + (b) * 2 + (h)) * HTB)
#define MM_GLDS(src, dst) __builtin_amdgcn_global_load_lds((const unsigned*)(src), (LAS unsigned*)(dst), 16, 0, 0)
#define MM_STAGE_B(bufoff, gbase) do { MM_GLDS((const char*)(gbase) + voffB, lds + (bufoff) + ldsw); MM_GLDS((const char*)(gbase) + r64 + voffB, lds + (bufoff) + ldsw + 8192); } while (0)
#define MM_STAGE_A(bufoff, gbase, h) do { if (GATHER) { \
        MM_GLDS((const char*)(gbase) + (unsigned)((rp[h] & 0xffffu) * (unsigned)(K * 2) + voffA), lds + (bufoff) + ldsw); MM_GLDS((const char*)(gbase) + (unsigned)((rp[h] >> 16) * (unsigned)(K * 2) + voffA), lds + (bufoff) + ldsw + 8192); } \
      else { MM_GLDS((const char*)(gbase) + (h) * hstep + voffA, lds + (bufoff) + ldsw); MM_GLDS((const char*)(gbase) + (h) * hstep + r64 + voffA, lds + (bufoff) + ldsw + 8192); } } while (0)
#define MM_LDA(dst, b, h) do { _Pragma("unroll") for (int m = 0; m < 4; ++m) _Pragma("unroll") for (int k = 0; k < 2; ++k) dst[m][k] = *(const LAS bf16x8*)(lds + MM_SA(b, h) + aoff + m * 2048 + k * 1024); } while (0)
#define MM_LDB(dst, b, h) do { _Pragma("unroll") for (int n = 0; n < 2; ++n) _Pragma("unroll") for (int k = 0; k < 2; ++k) dst[n][k] = *(const LAS bf16x8*)(lds + MM_SB(b, h) + boff + n * 2048 + k * 1024); } while (0)
#define MM_MMA(ai, bj, At, Bt) do { __builtin_amdgcn_s_setprio(1); _Pragma("unroll") for (int m = 0; m < 4; ++m) _Pragma("unroll") for (int n = 0; n < 2; ++n) _Pragma("unroll") for (int k = 0; k < 2; ++k) \
        acc[ai][bj][m][n] = __builtin_amdgcn_mfma_f32_16x16x32_bf16(Bt[n][k], At[m][k], acc[ai][bj][m][n], 0, 0, 0); __builtin_amdgcn_s_setprio(0); } while (0)
#define MM_WAIT_V(n) asm volatile("s_waitcnt vmcnt(" #n ")" ::: "memory")
#define MM_WAIT_L(n) asm volatile("s_waitcnt lgkmcnt(" #n ")" ::: "memory")
#define MM_BAR __builtin_amdgcn_s_barrier()
#define MM_SCHED __builtin_amdgcn_sched_barrier(0)
#define MM_ROWPAIRS(dst, u) do { int _t = tid; asm volatile("" : "+v"(_t)); int _sR, _sC; stage_rc(_t * 16, _sR, _sC); _Pragma("unroll") for (int _h = 0; _h < 2; ++_h) \
        dst[_h] = (unsigned)S.row(u, _h * HALF + _sR) | ((unsigned)S.row(u, _h * HALF + _sR + 64) << 16); } while (0)
#define MM_NVL() ((LAS unsigned*)(lds + 133120 + tid * 8))
    Unit cur, nxt, nx2; int ui = 0;
    if (!S.next(0, cur)) return;
    f32x4 acc[2][2][4][2];
#pragma unroll
    for (int a = 0; a < 2; ++a)
#pragma unroll
        for (int b = 0; b < 2; ++b)
#pragma unroll
            for (int m = 0; m < 4; ++m)
#pragma unroll
                for (int n = 0; n < 2; ++n) acc[a][b][m][n] = (f32x4){0.f, 0.f, 0.f, 0.f};
    bf16x8 At[4][2], B0[2][2], B1[2][2];
    rp[0] = rp[1] = 0u;
    if (GATHER) { unsigned nv[2]; MM_ROWPAIRS(rp, cur); if (S.next(1, nxt)) { MM_ROWPAIRS(nv, nxt); } else { nv[0] = rp[0]; nv[1] = rp[1]; }
        MM_NVL()[0] = nv[0]; MM_NVL()[1] = nv[1];
        asm volatile("s_waitcnt vmcnt(0) lgkmcnt(0)" ::: "memory");
        asm volatile("" : "+v"(rp[0]), "+v"(rp[1])); }
    const char* cA = cur.a; const char* cB = cur.b;
    MM_STAGE_B(MM_SB(0, 0), cB); MM_STAGE_B(MM_SB(0, 1), cB + hstep); MM_STAGE_A(MM_SA(0, 0), cA, 0); MM_STAGE_A(MM_SA(0, 1), cA, 1);
    if (wr == 1) MM_BAR;
    MM_WAIT_V(2); MM_BAR;
    MM_STAGE_B(MM_SB(1, 0), cB + kstep); MM_STAGE_A(MM_SA(1, 0), cA + kstep, 0); MM_STAGE_B(MM_SB(1, 1), cB + hstep + kstep);
    MM_WAIT_V(6); MM_BAR;
    for (;;) {
        const bool has_next = S.next(ui + 1, nxt);
        const char* nA = has_next ? nxt.a : cA; const char* nB = has_next ? nxt.b : cB;
        for (int t = 0; t < nt; t += 2) {
            const bool last = (t == nt - 2);
            const char* a1 = cA + (size_t)(t + 1) * kstep;
            const char* a2 = last ? nA : cA + (size_t)(t + 2) * kstep; const char* b2 = last ? nB : cB + (size_t)(t + 2) * kstep;
            const char* a3 = a2 + kstep; const char* b3 = b2 + kstep;
            MM_LDB(B0, 0, 0); MM_LDB(B1, 0, 1); MM_SCHED; MM_LDA(At, 0, 0); MM_STAGE_A(MM_SA(1, 1), a1, 1);
            MM_WAIT_V(8); MM_WAIT_L(0); MM_BAR; MM_MMA(0, 0, At, B0); MM_MMA(0, 1, At, B1); MM_BAR; MM_SCHED;
            if (GATHER) { if (last) { rp[0] = MM_NVL()[0]; rp[1] = MM_NVL()[1]; } }
            MM_LDA(At, 0, 1); MM_STAGE_B(MM_SB(0, 0), b2); MM_STAGE_B(MM_SB(0, 1), b2 + hstep); MM_STAGE_A(MM_SA(0, 0), a2, 0);
            MM_WAIT_V(8); MM_WAIT_L(0); MM_BAR; MM_MMA(1, 0, At, B0); MM_MMA(1, 1, At, B1); MM_BAR; MM_SCHED;
            MM_LDB(B0, 1, 0); MM_LDB(B1, 1, 1); MM_SCHED; MM_LDA(At, 1, 0); MM_STAGE_A(MM_SA(0, 1), a2, 1);
            MM_WAIT_V(8); MM_WAIT_L(0); MM_BAR; MM_MMA(0, 0, At, B0); MM_MMA(0, 1, At, B1); MM_BAR; MM_SCHED;
            MM_LDA(At, 1, 1); MM_STAGE_B(MM_SB(1, 0), b3); MM_STAGE_B(MM_SB(1, 1), b3 + hstep); MM_STAGE_A(MM_SA(1, 0), a3, 0);
            MM_WAIT_V(8); MM_WAIT_L(0); MM_BAR; MM_MMA(1, 0, At, B0); MM_MMA(1, 1, At, B1); MM_BAR; MM_SCHED;
        }
        if (wr == 0) MM_BAR;
        E(acc, cur, wr, wc, fr, fq);
        if (!has_next) break;
        if (GATHER) {
            if (S.next(ui + 2, nx2)) { unsigned nv[2]; MM_ROWPAIRS(nv, nx2); MM_NVL()[0] = nv[0]; MM_NVL()[1] = nv[1]; }
            asm volatile("s_waitcnt vmcnt(0) lgkmcnt(0)" ::: "memory"); }
#pragma unroll
        for (int a = 0; a < 2; ++a)
#pragma unroll
            for (int b = 0; b < 2; ++b)
#pragma unroll
                for (int m = 0; m < 4; ++m)
#pragma unroll
                    for (int n = 0; n < 2; ++n) acc[a][b][m][n] = (f32x4){0.f, 0.f, 0.f, 0.f};
        cur = nxt; cA = nA; cB = nB; ++ui;
        if (wr == 1) MM_BAR;
    }
    MM_WAIT_V(0);
    MM_BAR;
#undef MM_SA
#undef MM_SB
#undef MM_GLDS
#undef MM_STAGE_A
#undef MM_STAGE_B
#undef MM_LDA
#undef MM_LDB
#undef MM_MMA
#undef MM_WAIT_V
#undef MM_WAIT_L
#undef MM_BAR
#undef MM_SCHED
#undef MM_ROWPAIRS
#undef MM_NVL
}
}

typedef mm::Unit MUnit;
typedef f32x4 AccT[2][2][4][2];
__device__ __forceinline__ u32x4 pack8(const f32x4 a, const f32x4 b) { u32x4 w; w.x = mm::cvt_pk_bf16(a[0], a[1]); w.y = mm::cvt_pk_bf16(a[2], a[3]); w.z = mm::cvt_pk_bf16(b[0], b[1]); w.w = mm::cvt_pk_bf16(b[2], b[3]); return w; }
__device__ __forceinline__ f32x4 unpack_lo(const u32x4 w) { return (f32x4){__uint_as_float(w.x << 16), __uint_as_float(w.x & 0xffff0000u), __uint_as_float(w.y << 16), __uint_as_float(w.y & 0xffff0000u)}; }
__device__ __forceinline__ f32x4 unpack_hi(const u32x4 w) { return (f32x4){__uint_as_float(w.z << 16), __uint_as_float(w.z & 0xffff0000u), __uint_as_float(w.w << 16), __uint_as_float(w.w & 0xffff0000u)}; }

struct SchedProj {
    const char *xb, *win, *memb, *wmk, *wmv; int G, c;
    __device__ __forceinline__ bool next(int i, MUnit& u) const {
        int L = i * G + c; u.rows = nullptr; u.nvalid = 256;
        constexpr int U0 = 256 * 10, U1 = 512, U2 = 128, U3 = 128;
        if (L < U0) { int pm, pn; mm::order_map(L, 256, 10, pm, pn); u.pm = pm; u.pn = pn; u.aux = 0; u.a = xb + (size_t)pm * 256 * 2048; u.b = win + (size_t)pn * 256 * 2048; return true; }
        L -= U0;
        if (L < U1) { u.pm = L & 1; u.pn = L >> 1; u.aux = 1; u.a = win + (size_t)(C_V + 256 * u.pm) * 2048; u.b = xb + (size_t)u.pn * 256 * 2048; return true; }
        L -= U1;
        if (L < U2) { u.pm = L >> 2; u.pn = L & 3; u.aux = 2; u.a = memb + (size_t)u.pm * 256 * 2048; u.b = wmk + (size_t)u.pn * 256 * 2048; return true; }
        L -= U2;
        if (L < U3) { u.pm = L & 3; u.pn = L >> 2; u.aux = 3; u.a = wmv + (size_t)u.pm * 256 * 2048; u.b = memb + (size_t)u.pn * 256 * 2048; return true; }
        return false;
    }
    __device__ __forceinline__ int row(const MUnit&, int r) const { return r; }
};
struct EpiProj {
    static constexpr bool PERM = true;
    bf16_t *proj, *vt, *mk, *mvt;
    __device__ __forceinline__ void operator()(const AccT& acc, const MUnit& u, int wr, int wc, int fr, int fq) const {
        bf16_t* O = u.aux == 0 ? proj : u.aux == 1 ? vt : u.aux == 2 ? mk : mvt; const int ldc = u.aux == 0 ? NPROJ : u.aux == 1 ? NTOK : u.aux == 2 ? DM : NMEM;
        const int row0 = u.pm * 256 + wr * 64 + fr, col0 = u.pn * 256 + wc * 32 + 8 * fq;
#pragma unroll
        for (int ai = 0; ai < 2; ++ai)
#pragma unroll
            for (int m = 0; m < 4; ++m) { bf16_t* rowp = O + (size_t)(row0 + ai * 128 + m * 16) * ldc + col0;
#pragma unroll
                for (int bj = 0; bj < 2; ++bj) *(u32x4*)(rowp + bj * 128) = pack8(acc[ai][bj][m][0], acc[ai][bj][m][1]); }
    }
};
struct SchedDense {
    const char *A, *B; int nM, nN, G, c;
    __device__ __forceinline__ bool next(int i, MUnit& u) const {
        const int L = i * G + c; if (L >= nM * nN) return false;
        int pm, pn; mm::order_map(L, nM, nN, pm, pn); u.pm = pm; u.pn = pn; u.aux = 0; u.nvalid = 256; u.rows = nullptr; u.a = A + (size_t)pm * 256 * 2048; u.b = B + (size_t)pn * 256 * 2048; return true;
    }
    __device__ __forceinline__ int row(const MUnit&, int r) const { return r; }
};
__device__ __forceinline__ void row_stats_add(float* st, int row, float s, float q, int fq) {
    s += __shfl_xor(s, 16); s += __shfl_xor(s, 32); q += __shfl_xor(q, 16); q += __shfl_xor(q, 32);
    if (fq == 0) { atomicAdd(st + 2 * row, s); atomicAdd(st + 2 * row + 1, q); }
}
__device__ __forceinline__ float sum4(const f32x4 v) { return (v[0] + v[1]) + (v[2] + v[3]); }
__device__ __forceinline__ float sq4(const f32x4 v) { return (v[0] * v[0] + v[1] * v[1]) + (v[2] * v[2] + v[3] * v[3]); }
struct EpiOut {
    static constexpr bool PERM = true;
    const float* x; bf16_t* t1b; float* st;
    __device__ __forceinline__ void operator()(const AccT& acc, const MUnit& u, int wr, int wc, int fr, int fq) const {
#pragma unroll
        for (int ai = 0; ai < 2; ++ai)
#pragma unroll
            for (int m = 0; m < 4; ++m) { const int row = u.pm * 256 + ai * 128 + wr * 64 + m * 16 + fr; float s = 0.f, q = 0.f;
#pragma unroll
                for (int bj = 0; bj < 2; ++bj) { const size_t off = (size_t)row * DM + u.pn * 256 + bj * 128 + wc * 32 + 8 * fq;
                    const f32x4 t0 = ALPHA * *(const f32x4*)(x + off) + acc[ai][bj][m][0], t1 = ALPHA * *(const f32x4*)(x + off + 4) + acc[ai][bj][m][1];
                    *(u32x4*)(t1b + off) = pack8(t0, t1); s += sum4(t0) + sum4(t1); q += sq4(t0) + sq4(t1); }
                row_stats_add(st, row, s, q, fq); }
    }
};
struct EpiMq {
    static constexpr bool PERM = true;
    bf16_t* qm; const float *st, *cs, *bs;
    __device__ __forceinline__ void operator()(const AccT& acc, const MUnit& u, int wr, int wc, int fr, int fq) const {
#pragma unroll
        for (int bj = 0; bj < 2; ++bj) { const int col = u.pn * 256 + bj * 128 + wc * 32 + 8 * fq;
            const f32x4 c0 = *(const f32x4*)(cs + col), c1 = *(const f32x4*)(cs + col + 4), b0 = *(const f32x4*)(bs + col), b1 = *(const f32x4*)(bs + col + 4);
#pragma unroll
            for (int ai = 0; ai < 2; ++ai)
#pragma unroll
                for (int m = 0; m < 4; ++m) { const int row = u.pm * 256 + ai * 128 + wr * 64 + m * 16 + fr; const RowStat r = row_stat(st, row);
                    const f32x4 v0 = r.rstd * (acc[ai][bj][m][0] - r.mean * c0) + b0, v1 = r.rstd * (acc[ai][bj][m][1] - r.mean * c1) + b1;
                    *(u32x4*)(qm + (size_t)row * DM + col) = pack8(v0, v1); } }
    }
};
struct EpiMo {
    static constexpr bool PERM = true;
    const bf16_t* t1b; const float *st1, *g1, *b1; bf16_t* t2b; float* st2;
    __device__ __forceinline__ void operator()(const AccT& acc, const MUnit& u, int wr, int wc, int fr, int fq) const {
#pragma unroll
        for (int ai = 0; ai < 2; ++ai)
#pragma unroll
            for (int m = 0; m < 4; ++m) { const int row = u.pm * 256 + ai * 128 + wr * 64 + m * 16 + fr; const RowStat r = row_stat(st1, row); float s = 0.f, q = 0.f;
#pragma unroll
                for (int bj = 0; bj < 2; ++bj) { const int col = u.pn * 256 + bj * 128 + wc * 32 + 8 * fq; const size_t off = (size_t)row * DM + col;
                    const u32x4 tw = *(const u32x4*)(t1b + off);
                    const f32x4 x0 = (unpack_lo(tw) - r.mean) * r.rstd * *(const f32x4*)(g1 + col) + *(const f32x4*)(b1 + col), x1 = (unpack_hi(tw) - r.mean) * r.rstd * *(const f32x4*)(g1 + col + 4) + *(const f32x4*)(b1 + col + 4);
                    const f32x4 t0 = ALPHA * x0 + acc[ai][bj][m][0], t1 = ALPHA * x1 + acc[ai][bj][m][1];
                    *(u32x4*)(t2b + off) = pack8(t0, t1); s += sum4(t0) + sum4(t1); q += sq4(t0) + sq4(t1); }
                row_stats_add(st2, row, s, q, fq); }
    }
};
struct EpiRouter {
    static constexpr bool PERM = false;
    float* lg; const float *st, *cs, *bs;
    __device__ __forceinline__ void operator()(const AccT& acc, const MUnit& u, int wr, int wc, int fr, int fq) const {
        if (wc < 2) {
#pragma unroll
            for (int n = 0; n < 2; ++n) { const int col = wc * 32 + 16 * n + 4 * fq; const f32x4 c0 = *(const f32x4*)(cs + col), b0 = *(const f32x4*)(bs + col);
#pragma unroll
                for (int ai = 0; ai < 2; ++ai)
#pragma unroll
                    for (int m = 0; m < 4; ++m) { const int row = u.pm * 256 + ai * 128 + wr * 64 + m * 16 + fr; const RowStat r = row_stat(st, row);
                        *(f32x4*)(lg + (size_t)row * NLOGP + col) = r.rstd * (acc[ai][0][m][n] - r.mean * c0) + b0; } }
        }
    }
};
constexpr int MOE_TB_OFF = 131072;
__device__ __forceinline__ void moe_tables(const unsigned* CNT, LAS int* tb) {
    if (threadIdx.x == 0) { int ub = 0, ho = 0;
        for (int e = 0; e < NEXP; ++e) { const int c = (int)CNT[e]; tb[e] = ub; tb[64 + e] = ho; tb[128 + e] = c; const int nt = (c + 255) / 256; ub += nt * 4; ho += nt * 256; }
        tb[32] = ub; }
    __syncthreads();
}
__device__ __forceinline__ int uni(int v) { return __builtin_amdgcn_readfirstlane(v); }
template <class T> __device__ __forceinline__ T* uni_ptr(T* q) { const unsigned long long v = (unsigned long long)q; const unsigned lo = __builtin_amdgcn_readfirstlane((unsigned)v), hi = __builtin_amdgcn_readfirstlane((unsigned)(v >> 32)); return (T*)(((unsigned long long)hi << 32) | lo); }
template <int WHICH> struct SchedMoe {
    const char *A, *B; const int* rowl; LAS int* tb; int G, c;
    __device__ __forceinline__ bool next(int i, MUnit& u) const {
        const int L = i * G + c; if (L >= uni(tb[32])) return false;
        int e = 0; while (uni(tb[e + 1]) <= L) ++e;
        const int l = L - uni(tb[e]), tm = l >> 2, pn = l & 3, cnt = uni(tb[128 + e]), rem = cnt - tm * 256, ho = uni(tb[64 + e]);
        u.pm = tm; u.pn = pn; u.aux = e; u.nvalid = rem < 256 ? rem : 256; u.rows = rowl + (size_t)e * CAP + tm * 256;
        if (WHICH == 1) { u.a = A; u.b = B + ((size_t)e * 1024 + pn * 256) * 2048; }
        else { u.a = A + (size_t)(ho + tm * 256) * 1024; u.b = B + ((size_t)e * 1024 + pn * 256) * 1024; }
        return true;
    }
    __device__ __forceinline__ int row(const MUnit& u, int r) const { return WHICH == 1 ? (u.rows[r < u.nvalid ? r : u.nvalid - 1] >> 1) : r; }
};
struct EpiMoe1 {
    static constexpr bool PERM = true;
    bf16_t* H; const float *st, *csg, *bsg; LAS int* tb;
    __device__ __forceinline__ void operator()(const AccT& acc, const MUnit& u, int wr, int wc, int fr, int fq) const {
        const int e = u.aux, hrow0 = uni(tb[64 + e]) + u.pm * 256, c8 = wc * 32 + 8 * fq, wrow = e * 1024 + u.pn * 256 + c8;
#pragma unroll
        for (int ai = 0; ai < 2; ++ai)
#pragma unroll
            for (int m = 0; m < 4; ++m) { const int rl = ai * 128 + wr * 64 + m * 16 + fr; const int tok = u.rows[rl < u.nvalid ? rl : u.nvalid - 1] >> 1; const RowStat r = row_stat(st, tok);
                f32x4 hv[2];
#pragma unroll
                for (int n = 0; n < 2; ++n) { const f32x4 cg = *(const f32x4*)(csg + wrow + 4 * n), bg = *(const f32x4*)(bsg + wrow + 4 * n), cu = *(const f32x4*)(csg + wrow + 128 + 4 * n), bu = *(const f32x4*)(bsg + wrow + 128 + 4 * n);
                    const f32x4 g = r.rstd * (acc[ai][0][m][n] - r.mean * cg) + bg, uu = r.rstd * (acc[ai][1][m][n] - r.mean * cu) + bu;
#pragma unroll
                    for (int j = 0; j < 4; ++j) hv[n][j] = g[j] / (1.0f + __expf(-g[j])) * uu[j]; }
                *(u32x4*)(H + (size_t)(hrow0 + rl) * DEXP + u.pn * 128 + c8) = pack8(hv[0], hv[1]);
                asm volatile("" ::: "memory"); }
    }
};
struct EpiMoe2 {
    static constexpr bool PERM = true;
    bf16_t* Y; const float* gate;
    __device__ __forceinline__ void operator()(const AccT& acc, const MUnit& u, int wr, int wc, int fr, int fq) const {
#pragma unroll
        for (int ai = 0; ai < 2; ++ai)
#pragma unroll
            for (int m = 0; m < 4; ++m) { const int rl = ai * 128 + wr * 64 + m * 16 + fr;
                if (rl < u.nvalid) { const int a = u.rows[rl]; const float g = gate[a];
#pragma unroll
                    for (int bj = 0; bj < 2; ++bj) *(u32x4*)(Y + (size_t)a * DM + u.pn * 256 + bj * 128 + wc * 32 + 8 * fq) = pack8(g * acc[ai][bj][m][0], g * acc[ai][bj][m][1]); } }
    }
};
__device__ __forceinline__ void phase_proj_fast(const Params& p, LAS unsigned char* lds) {
    unsigned char* ws = p.ws;
    SchedProj S{(const char*)(ws + WS_XB), (const char*)(ws + WS_WIN), (const char*)(ws + WS_MEMB), (const char*)(ws + WS_WMK), (const char*)(ws + WS_WMV), (int)gridDim.x, (int)blockIdx.x};
    EpiProj E{(bf16_t*)(ws + WS_PROJ), (bf16_t*)(ws + WS_VT), (bf16_t*)(ws + WS_MEMK), (bf16_t*)(ws + WS_MEMVT)};
    mm::gemm_phase<EpiProj, SchedProj, false>(lds, DM, S, E);
}
__device__ __forceinline__ void phase_outproj_fast(const Params& p, LAS unsigned char* lds) {
    unsigned char* ws = p.ws;
    SchedDense S{(const char*)(ws + WS_YMIX), (const char*)(ws + WS_WOUT), NTOK / 256, DM / 256, (int)gridDim.x, (int)blockIdx.x};
    EpiOut E{p.x, (bf16_t*)(ws + WS_T1B), (float*)(ws + WS_STATS1)};
    mm::gemm_phase<EpiOut, SchedDense, false>(lds, DM, S, E);
}
__device__ __forceinline__ void phase_mq_fast(const Params& p, LAS unsigned char* lds) {
    unsigned char* ws = p.ws;
    SchedDense S{(const char*)(ws + WS_T1B), (const char*)(ws + WS_WMQ), NTOK / 256, DM / 256, (int)gridDim.x, (int)blockIdx.x};
    EpiMq E{(bf16_t*)(ws + WS_QM), (const float*)(ws + WS_STATS1), (const float*)(ws + WS_CS1), (const float*)(ws + WS_CS1) + 1024};
    mm::gemm_phase<EpiMq, SchedDense, false>(lds, DM, S, E);
}
__device__ __forceinline__ void phase_mo_fast(const Params& p, LAS unsigned char* lds) {
    unsigned char* ws = p.ws;
    SchedDense S{(const char*)(ws + WS_OB), (const char*)(ws + WS_WMO), NTOK / 256, DM / 256, (int)gridDim.x, (int)blockIdx.x};
    EpiMo E{(const bf16_t*)(ws + WS_T1B), (const float*)(ws + WS_STATS1), p.ln1_g, p.ln1_b, (bf16_t*)(ws + WS_T2B), (float*)(ws + WS_STATS2)};
    mm::gemm_phase<EpiMo, SchedDense, false>(lds, DM, S, E);
}
__device__ __forceinline__ void phase_router_fast(const Params& p, LAS unsigned char* lds) {
    unsigned char* ws = p.ws;
    SchedDense S{(const char*)(ws + WS_T2B), (const char*)(ws + WS_WRT), NTOK / 256, 1, (int)gridDim.x, (int)blockIdx.x};
    EpiRouter E{(float*)(ws + WS_LOGIT), (const float*)(ws + WS_STATS2), (const float*)(ws + WS_CS2), (const float*)(ws + WS_CS2) + 64};
    mm::gemm_phase<EpiRouter, SchedDense, false>(lds, DM, S, E);
}
__device__ __forceinline__ void phase_moe1_fast(const Params& p, LAS unsigned char* lds) {
    unsigned char* ws = p.ws; LAS int* tb = (LAS int*)(lds + MOE_TB_OFF);
    moe_tables((const unsigned*)(ws + WS_CNT), tb);
    SchedMoe<1> S{(const char*)(ws + WS_T2B), (const char*)(ws + WS_WGU), (const int*)(ws + WS_ROWL), tb, (int)gridDim.x, (int)blockIdx.x};
    EpiMoe1 E{(bf16_t*)(ws + WS_H), (const float*)(ws + WS_STATS2), (const float*)(ws + WS_CSGU), (const float*)(ws + WS_CSGU) + NEXP * 1024, tb};
    mm::gemm_phase<EpiMoe1, SchedMoe<1>, true>(lds, DM, S, E);
}
__device__ __forceinline__ void phase_moe2_fast(const Params& p, LAS unsigned char* lds) {
    unsigned char* ws = p.ws; LAS int* tb = (LAS int*)(lds + MOE_TB_OFF);
    moe_tables((const unsigned*)(ws + WS_CNT), tb);
    SchedMoe<2> S{(const char*)(ws + WS_H), (const char*)(ws + WS_WD), (const int*)(ws + WS_ROWL), tb, (int)gridDim.x, (int)blockIdx.x};
    EpiMoe2 E{(bf16_t*)(ws + WS_Y), (const float*)(ws + WS_GATE)};
    mm::gemm_phase<EpiMoe2, SchedMoe<2>, false>(lds, DEXP, S, E);
}

__global__ void __launch_bounds__(512, 2) fwd_kernel(Params p) {
    extern __shared__ __attribute__((aligned(16))) unsigned char lds[];
    cg::grid_group grid = cg::this_grid();
#ifndef ONLY
#define ONLY -1
#endif
#ifdef PMASK
#define RUNP(k) ((PMASK >> (k)) & 1)
#else
#define RUNP(k) (ONLY < 0 || ONLY == (k))
#endif
    const int lo = p.ph_lo, hi = p.ph_hi;
    LAS unsigned char* l3 = (LAS unsigned char*)lds;
#ifndef FASTMASK
#define FASTMASK 0x6DA
#endif
#define FAST(k) ((FASTMASK >> (k)) & 1)
#define IN(k) (RUNP(k) && lo <= (k) && (k) < hi)
#define SEAM(k) do { if (lo <= (k) && (k) + 1 < hi) grid.sync(); } while (0)
    if (IN(0)) { phase_prep(p, lds); } SEAM(0);
    if (IN(1)) { if (FAST(1)) phase_proj_fast(p, l3); else phase_proj_simple(p); } SEAM(1);
    if (IN(2)) { phase_conv_simple(p); phase_sb_simple(p); } SEAM(2);
    if (IN(3)) { if (FAST(3)) phase_outproj_fast(p, l3); else phase_outproj_simple(p); } SEAM(3);
    if (IN(4)) { if (FAST(4)) phase_mq_fast(p, l3); else phase_mq_simple(p); } SEAM(4);
    if (IN(5)) { phase_xattn_simple(p, lds); } SEAM(5);
    if (IN(6)) { if (FAST(6)) phase_mo_fast(p, l3); else phase_mo_simple(p); } SEAM(6);
    if (IN(7)) { if (FAST(7)) phase_router_fast(p, l3); else phase_router_simple(p); } SEAM(7);
    if (IN(8)) { phase_route(p); } SEAM(8);
    if (IN(9)) { if (FAST(9)) phase_moe1_fast(p, l3); else phase_moe1_simple(p); } SEAM(9);
    if (IN(10)) { if (FAST(10)) phase_moe2_fast(p, l3); else phase_moe2_simple(p); } SEAM(10);
    if (IN(11)) { phase_final(p); }
}

extern "C" void kernel_launch(void* const* d_in, const int* in_sizes, int n_in, void* d_out, int out_size, void* d_ws, size_t ws_size, hipStream_t stream) {
    static int grid = 0;
    if (grid == 0) {
        if (n_in != 24 || out_size != NTOK * DM || ws_size < WS_END) { fprintf(stderr, "kernel_launch: unexpected problem: n_in %d out %d ws %zu\n", n_in, out_size, ws_size); grid = -1; return; }
        int dev = 0, cus = 0, per_cu = 0;
        (void)hipGetDevice(&dev); (void)hipDeviceGetAttribute(&cus, hipDeviceAttributeMultiprocessorCount, dev);
        (void)hipFuncSetAttribute((const void*)fwd_kernel, hipFuncAttributeMaxDynamicSharedMemorySize, LDS_BYTES);
        (void)hipOccupancyMaxActiveBlocksPerMultiprocessor(&per_cu, (const void*)fwd_kernel, 512, LDS_BYTES);
        if (per_cu < 1) { fprintf(stderr, "kernel_launch: occupancy query reports %d blocks per CU\n", per_cu); }
        grid = cus;
    }
    if (grid < 0) return;
    Params p{};
    const float** f = (const float**)&p;
    for (int i = 0; i < 24; ++i) f[i] = (const float*)d_in[i];
    p.out = (float*)d_out; p.ws = (unsigned char*)d_ws;
#if MK_ONE_LAUNCH
    p.ph_lo = 0; p.ph_hi = NPHASE;
    void* args[] = {&p};
    hipError_t e = hipLaunchCooperativeKernel((void*)fwd_kernel, dim3(grid), dim3(512), args, LDS_BYTES, stream);
    if (e != hipSuccess) fprintf(stderr, "cooperative launch failed: %s\n", hipGetErrorString(e));
#else
    for (int ph = 0; ph < NPHASE; ++ph) {
        p.ph_lo = ph; p.ph_hi = ph + 1;
        void* args[] = {&p};
        hipError_t e = hipLaunchCooperativeKernel((void*)fwd_kernel, dim3(grid), dim3(512), args, LDS_BYTES, stream);
        if (e != hipSuccess) { fprintf(stderr, "launch %d failed: %s\n", ph, hipGetErrorString(e)); break; }
    }
#endif
}
```

```cpp
#include <hip/hip_runtime.h>
#include <hip/hip_cooperative_groups.h>
#include <cstdio>
#include <cstdint>
namespace cg = cooperative_groups;

#ifndef MK_ONE_LAUNCH
#define MK_ONE_LAUNCH 1
#endif

typedef unsigned short bf16_t;
typedef short bf16x8 __attribute__((ext_vector_type(8)));
typedef float f32x4 __attribute__((ext_vector_type(4)));
typedef float f32x16 __attribute__((ext_vector_type(16)));
typedef unsigned u32x4 __attribute__((ext_vector_type(4)));
typedef unsigned u32x2 __attribute__((ext_vector_type(2)));

constexpr int NB = 32, SEQ = 2048, DM = 1024, NTOK = NB * SEQ;
constexpr int MEML = 256, NMEM = NB * MEML;
constexpr int NPROJ = 2560;
constexpr int PW = 3072;
constexpr int C_CB = 0, C_CC = 512, C_CH = 1024, C_Q = 1536, C_K = 2048, C_V = 2560;
constexpr int NHEAD = 8, HD = 64;
constexpr int MH = 4, MHD = 256;
constexpr int NEXP = 32, DEXP = 512, NLOG = 36, NLOGP = 64;
constexpr int CAP = 2 * NTOK;
constexpr float ALPHA = 1.189207115002721f;
constexpr float LN_EPS = 1e-5f, RMS_EPS = 1e-6f;
constexpr float LOG2E = 1.4426950408889634f;
constexpr float QS_SB = 0.125f * LOG2E;
constexpr float QS_X = 0.0625f * LOG2E;

constexpr size_t MiB = 1u << 20;
constexpr size_t WS_STATS1 = 0;
constexpr size_t WS_STATS2 = 1 * MiB;
constexpr size_t WS_CNT = 2 * MiB;
constexpr size_t WS_CS1 = 2 * MiB + 4096;
constexpr size_t WS_CS2 = WS_CS1 + 8192;
constexpr size_t WS_CSGU = 3 * MiB;
constexpr size_t WS_EID = 4 * MiB;
constexpr size_t WS_GATE = 5 * MiB;
constexpr size_t WS_LOGIT = 8 * MiB;
constexpr size_t WS_ROWL = 24 * MiB;
constexpr size_t WS_WRT = 40 * MiB;
constexpr size_t WS_WIN = 64 * MiB;
constexpr size_t WS_WOUT = 70 * MiB;
constexpr size_t WS_WMQ = 72 * MiB, WS_WMK = 74 * MiB, WS_WMV = 76 * MiB, WS_WMO = 78 * MiB;
constexpr size_t WS_WGU = 80 * MiB;
constexpr size_t WS_WD = 144 * MiB;
constexpr size_t WS_XB = 192 * MiB;
constexpr size_t WS_T1B = 192 * MiB;
constexpr size_t WS_MEMB = 320 * MiB;
constexpr size_t WS_MEMK = 336 * MiB;
constexpr size_t WS_MEMVT = 352 * MiB;
constexpr size_t WS_PROJ = 368 * MiB;
constexpr size_t WS_QM = 368 * MiB;
constexpr size_t WS_OB = 496 * MiB;
constexpr size_t WS_Y = 368 * MiB;
constexpr size_t WS_VT = 688 * MiB;
constexpr size_t WS_YMIX = 752 * MiB;
constexpr size_t WS_T2B = 752 * MiB;
constexpr size_t WS_H = 880 * MiB;
constexpr size_t WS_END = 1016 * MiB;

constexpr int LDS_BYTES = 147456;
constexpr int NPHASE = 12;

struct Params {
    const float *x, *mem, *w_in, *conv_w, *gn_conv, *gn_sb, *w_out, *ln1_g, *ln1_b, *w_mq, *w_mk, *w_mv, *w_mo, *ln2_g, *ln2_b,
        *w_rg, *b_rg, *w_re, *b_re, *w_gate, *w_up, *w_down, *ln3_g, *ln3_b;
    float* out; unsigned char* ws; int ph_lo, ph_hi;
};

__device__ __forceinline__ float bf2f(bf16_t v) { return __uint_as_float((unsigned)v << 16); }
__device__ __forceinline__ bf16_t f2bf(float f) { unsigned u = __float_as_uint(f); return (bf16_t)((u + 0x7fffu + ((u >> 16) & 1u)) >> 16); }
__device__ __forceinline__ unsigned pk2(float lo, float hi) { return (unsigned)f2bf(lo) | ((unsigned)f2bf(hi) << 16); }
__device__ __forceinline__ float wave_sum(float v) {
#pragma unroll
    for (int o = 1; o < 64; o <<= 1) v += __shfl_xor(v, o);
    return v;
}
__device__ __forceinline__ float wave_max(float v) {
#pragma unroll
    for (int o = 1; o < 64; o <<= 1) v = fmaxf(v, __shfl_xor(v, o));
    return v;
}
#define MFMA32(a, b, c) __builtin_amdgcn_mfma_f32_32x32x16_bf16((a), (b), (c), 0, 0, 0)

template <int NBLK, class AR, class BR>
__device__ __forceinline__ void wave_tile(int K, AR arow, BR brow, f32x16 (&c)[2][2 * NBLK]) {
    const int lane = threadIdx.x & 63, r = lane & 31, h = lane >> 5;
    const bf16_t* ap[2]; const bf16_t* bp[2 * NBLK];
#pragma unroll
    for (int i = 0; i < 2; ++i) ap[i] = arow(32 * i + r) + 8 * h;
#pragma unroll
    for (int j = 0; j < 2 * NBLK; ++j) bp[j] = brow(32 * j + r) + 8 * h;
#pragma unroll
    for (int i = 0; i < 2; ++i)
#pragma unroll
        for (int j = 0; j < 2 * NBLK; ++j)
#pragma unroll
            for (int q = 0; q < 16; ++q) c[i][j][q] = 0.f;
#pragma unroll 2
    for (int k = 0; k < K; k += 16) {
        bf16x8 fa[2], fb[2 * NBLK];
#pragma unroll
        for (int i = 0; i < 2; ++i) fa[i] = *(const bf16x8*)(ap[i] + k);
#pragma unroll
        for (int j = 0; j < 2 * NBLK; ++j) fb[j] = *(const bf16x8*)(bp[j] + k);
#pragma unroll
        for (int i = 0; i < 2; ++i)
#pragma unroll
            for (int j = 0; j < 2 * NBLK; ++j) c[i][j] = MFMA32(fa[i], fb[j], c[i][j]);
    }
}
#define TROW(i, q) (32 * (i) + ((q) & 3) + 8 * ((q) >> 2) + 4 * ((int)(threadIdx.x & 63) >> 5))
#define TCOL(j) (32 * (j) + (int)(threadIdx.x & 31))

struct RowStat { float mean, rstd; };
__device__ __forceinline__ RowStat row_stat(const float* st, int row) {
    const float s = st[2 * row], q = st[2 * row + 1];
    RowStat r; r.mean = s * (1.f / DM); const float var = fmaxf(q * (1.f / DM) - r.mean * r.mean, 0.f); r.rstd = 1.0f / sqrtf(var + LN_EPS); return r;
}

__device__ __forceinline__ void transpose_item(const float* W, int K, int N, int k0, int n0, bf16_t* WT, int orow0, const float* ks, float ns, float* scr, int lane) {
#pragma unroll 8
    for (int i = 0; i < 32; ++i) { const int kk = 2 * i + (lane >> 5); float v = W[(size_t)(k0 + kk) * N + n0 + (lane & 31)]; if (ks) v *= ks[k0 + kk]; scr[kk * 33 + (lane & 31)] = v * ns; }
    asm volatile("s_waitcnt vmcnt(0) lgkmcnt(0)" ::: "memory");
    const int c = lane & 7;
#pragma unroll
    for (int j = 0; j < 4; ++j) { const int n = (lane >> 3) + 8 * j; const float* s = scr + (8 * c) * 33 + n;
        u32x4 o; o.x = pk2(s[0 * 33], s[1 * 33]); o.y = pk2(s[2 * 33], s[3 * 33]); o.z = pk2(s[4 * 33], s[5 * 33]); o.w = pk2(s[6 * 33], s[7 * 33]);
        *(u32x4*)(WT + (size_t)(orow0 + n) * K + k0 + 8 * c) = o; }
    asm volatile("s_waitcnt lgkmcnt(0)" ::: "memory");
}
__device__ void phase_prep(const Params& p, unsigned char* lds) {
    unsigned char* ws = p.ws;
    const int tid = threadIdx.x, lane = tid & 63, wave = tid >> 6;
    const int gw = blockIdx.x * 8 + wave, NGW = gridDim.x * 8;
    const int gt = blockIdx.x * 512 + tid, NGT = gridDim.x * 512;
    float* scr = (float*)(lds + wave * 16384);
    bf16_t* WIN = (bf16_t*)(ws + WS_WIN); bf16_t* WOUT = (bf16_t*)(ws + WS_WOUT); bf16_t* WMQ = (bf16_t*)(ws + WS_WMQ); bf16_t* WMK = (bf16_t*)(ws + WS_WMK);
    bf16_t* WMV = (bf16_t*)(ws + WS_WMV); bf16_t* WMO = (bf16_t*)(ws + WS_WMO); bf16_t* WGU = (bf16_t*)(ws + WS_WGU); bf16_t* WD = (bf16_t*)(ws + WS_WD);
    constexpr int I_IN = 16 * 96, I_SQ = 16 * 32, I_G = 32 * 16 * 16, I_D = 32 * 8 * 32;
    constexpr int NITEMS = I_IN + 5 * I_SQ + 2 * I_G + I_D;
    for (int it = gw; it < NITEMS; it += NGW) {
        int r = it;
        if (r < I_IN) { const int kb = r / 96, nb = r % 96, n0 = nb * 32; transpose_item(p.w_in, DM, PW, kb * 64, n0, WIN, n0, nullptr, (n0 >= C_Q && n0 < C_K) ? QS_SB : 1.f, scr, lane); continue; } r -= I_IN;
        if (r < I_SQ) { transpose_item(p.w_out, DM, DM, (r / 32) * 64, (r % 32) * 32, WOUT, (r % 32) * 32, nullptr, 1.f, scr, lane); continue; } r -= I_SQ;
        if (r < I_SQ) { transpose_item(p.w_mq, DM, DM, (r / 32) * 64, (r % 32) * 32, WMQ, (r % 32) * 32, p.ln1_g, QS_X, scr, lane); continue; } r -= I_SQ;
        if (r < I_SQ) { transpose_item(p.w_mk, DM, DM, (r / 32) * 64, (r % 32) * 32, WMK, (r % 32) * 32, nullptr, 1.f, scr, lane); continue; } r -= I_SQ;
        if (r < I_SQ) { transpose_item(p.w_mv, DM, DM, (r / 32) * 64, (r % 32) * 32, WMV, (r % 32) * 32, nullptr, 1.f, scr, lane); continue; } r -= I_SQ;
        if (r < I_SQ) { transpose_item(p.w_mo, DM, DM, (r / 32) * 64, (r % 32) * 32, WMO, (r % 32) * 32, nullptr, 1.f, scr, lane); continue; } r -= I_SQ;
        if (r < 2 * I_G) { const int up = r >= I_G; if (up) r -= I_G; const int e = r / 256, q = r % 256, kb = q / 16, nb = q % 16, n0 = nb * 32;
            const float* W = (up ? p.w_up : p.w_gate) + (size_t)e * DM * DEXP; const int orow0 = 256 * (n0 / 128) + (up ? 128 : 0) + (n0 % 128);
            transpose_item(W, DM, DEXP, kb * 64, n0, WGU + (size_t)e * 1024 * 1024, orow0, p.ln2_g, 1.f, scr, lane); continue; } r -= 2 * I_G;
        { const int e = r / 256, q = r % 256, kb = q / 32, nb = q % 32; transpose_item(p.w_down + (size_t)e * DEXP * DM, DEXP, DM, kb * 64, nb * 32, WD + (size_t)e * 1024 * 512, nb * 32, nullptr, 1.f, scr, lane); }
    }
    { bf16_t* WRT = (bf16_t*)(ws + WS_WRT);
      for (int i = gt; i < 256 * DM; i += NGT) { const int n = i / DM, k = i % DM; float v = 0.f;
          if (n < 4) v = p.w_rg[k * 4 + n] * p.ln2_g[k]; else if (n < NLOG) v = p.w_re[k * 32 + (n - 4)] * p.ln2_g[k];
          WRT[i] = f2bf(v); } }
    { float* cs1 = (float*)(ws + WS_CS1); float* bs1 = cs1 + 1024; float* cs2 = (float*)(ws + WS_CS2); float* bs2 = cs2 + 64;
      float* csg = (float*)(ws + WS_CSGU); float* bsg = csg + NEXP * 1024;
      constexpr int NV = 1024 + 64 + NEXP * 1024;
      for (int i = gt; i < NV; i += NGT) {
          if (i < 1024) { const int n = i; float cs = 0.f, bs = 0.f;
              for (int k = 0; k < DM; ++k) { const float w = p.w_mq[(size_t)k * DM + n]; cs += bf2f(f2bf(w * p.ln1_g[k] * QS_X)); bs += p.ln1_b[k] * w; }
              cs1[n] = cs; bs1[n] = bs * QS_X; }
          else if (i < 1088) { const int n = i - 1024; float cs = 0.f, bs = 0.f;
              if (n < NLOG) { for (int k = 0; k < DM; ++k) { const float w = n < 4 ? p.w_rg[k * 4 + n] : p.w_re[k * 32 + (n - 4)]; cs += bf2f(f2bf(w * p.ln2_g[k])); bs += p.ln2_b[k] * w; }
                  bs += n < 4 ? p.b_rg[n] : p.b_re[n - 4]; }
              cs2[n] = cs; bs2[n] = bs; }
          else { const int j = i - 1088, e = j / 1024, row = j % 1024, pn = row / 256, rr = row % 256, up = rr >= 128, n = pn * 128 + (rr & 127);
              const float* W = (up ? p.w_up : p.w_gate) + (size_t)e * DM * DEXP; float cs = 0.f, bs = 0.f;
              for (int k = 0; k < DM; ++k) { const float w = W[(size_t)k * DEXP + n]; cs += bf2f(f2bf(w * p.ln2_g[k])); bs += p.ln2_b[k] * w; }
              csg[j] = cs; bsg[j] = bs; }
      } }
    { bf16_t* XB = (bf16_t*)(ws + WS_XB); bf16_t* MB = (bf16_t*)(ws + WS_MEMB);
      const f32x4* x4 = (const f32x4*)p.x; u32x2* xb2 = (u32x2*)XB;
      for (int i = gt; i < NTOK * DM / 4; i += NGT) { const f32x4 v = x4[i]; u32x2 o; o.x = pk2(v.x, v.y); o.y = pk2(v.z, v.w); xb2[i] = o; }
      const f32x4* m4 = (const f32x4*)p.mem; u32x2* mb2 = (u32x2*)MB;
      for (int i = gt; i < NMEM * DM / 4; i += NGT) { const f32x4 v = m4[i]; u32x2 o; o.x = pk2(v.x, v.y); o.y = pk2(v.z, v.w); mb2[i] = o; } }
    { float* s1 = (float*)(ws + WS_STATS1); float* s2 = (float*)(ws + WS_STATS2); unsigned* cnt = (unsigned*)(ws + WS_CNT);
      for (int i = gt; i < 2 * NTOK; i += NGT) { s1[i] = 0.f; s2[i] = 0.f; }
      if (gt < 64) cnt[gt] = 0u; }
}

__device__ void phase_proj_simple(const Params& p) {
    unsigned char* ws = p.ws; const int wave = threadIdx.x >> 6; const int gw = blockIdx.x * 8 + wave, NGW = gridDim.x * 8;
    const bf16_t* XB = (const bf16_t*)(ws + WS_XB); const bf16_t* WIN = (const bf16_t*)(ws + WS_WIN); const bf16_t* MB = (const bf16_t*)(ws + WS_MEMB);
    const bf16_t* WMK = (const bf16_t*)(ws + WS_WMK); const bf16_t* WMV = (const bf16_t*)(ws + WS_WMV);
    bf16_t* PROJ = (bf16_t*)(ws + WS_PROJ); bf16_t* VT = (bf16_t*)(ws + WS_VT); bf16_t* MK = (bf16_t*)(ws + WS_MEMK); bf16_t* MVT = (bf16_t*)(ws + WS_MEMVT);
    constexpr int TA = (NTOK / 64) * (NPROJ / 64), TB = (512 / 64) * (NTOK / 64), TC = (NMEM / 64) * (DM / 64), TD = (DM / 64) * (NMEM / 64);
    for (int t = gw; t < TA + TB + TC + TD; t += NGW) {
        const bf16_t *A, *Bt; bf16_t* O; int ldo, tm, tn, r = t;
        if (r < TA) { A = XB; Bt = WIN; O = PROJ; ldo = NPROJ; tm = r / (NPROJ / 64); tn = r % (NPROJ / 64); }
        else if ((r -= TA) < TB) { A = WIN + (size_t)C_V * DM; Bt = XB; O = VT; ldo = NTOK; tm = r / (NTOK / 64); tn = r % (NTOK / 64); }
        else if ((r -= TB) < TC) { A = MB; Bt = WMK; O = MK; ldo = DM; tm = r / (DM / 64); tn = r % (DM / 64); }
        else { r -= TC; A = WMV; Bt = MB; O = MVT; ldo = NMEM; tm = r / (NMEM / 64); tn = r % (NMEM / 64); }
        f32x16 c[2][2];
        wave_tile<1>(DM, [&](int i) { return A + (size_t)(tm * 64 + i) * DM; }, [&](int j) { return Bt + (size_t)(tn * 64 + j) * DM; }, c);
#pragma unroll
        for (int i = 0; i < 2; ++i)
#pragma unroll
            for (int j = 0; j < 2; ++j)
#pragma unroll
                for (int q = 0; q < 16; ++q) O[(size_t)(tm * 64 + TROW(i, q)) * ldo + tn * 64 + TCOL(j)] = f2bf(c[i][j][q]);
    }
}

__device__ void phase_conv_simple(const Params& p) {
    unsigned char* ws = p.ws; const int lane = threadIdx.x & 63, wave = threadIdx.x >> 6; const int gw = blockIdx.x * 8 + wave, NGW = gridDim.x * 8;
    const bf16_t* PROJ = (const bf16_t*)(ws + WS_PROJ); bf16_t* YMIX = (bf16_t*)(ws + WS_YMIX);
    for (int it = gw; it < NTOK * 8; it += NGW) {
        const int tok = it >> 3, g = it & 7, c = g * 64 + lane, t = tok % SEQ;
        float acc = 0.f;
#pragma unroll
        for (int k = 0; k < 3; ++k) { const int tt = t - 2 + k; if (tt >= 0) { const bf16_t* row = PROJ + (size_t)(tok - 2 + k) * NPROJ; acc += p.conv_w[k * 512 + c] * (bf2f(row[C_CC + c]) * bf2f(row[C_CH + c])); } }
        const float y = bf2f(PROJ[(size_t)tok * NPROJ + C_CB + c]) * acc;
        const float ms = wave_sum(y * y) * (1.f / 64.f);
        YMIX[(size_t)tok * DM + c] = f2bf(y * (1.0f / sqrtf(ms + RMS_EPS)) * p.gn_conv[c]);
    }
}
__device__ void phase_sb_simple(const Params& p) {
    unsigned char* ws = p.ws; const int lane = threadIdx.x & 63, wave = threadIdx.x >> 6; const int gw = blockIdx.x * 8 + wave, NGW = gridDim.x * 8;
    const bf16_t* PROJ = (const bf16_t*)(ws + WS_PROJ); const bf16_t* VT = (const bf16_t*)(ws + WS_VT); bf16_t* YMIX = (bf16_t*)(ws + WS_YMIX);
    for (int it = gw; it < NTOK * NHEAD; it += NGW) {
        const int tok = it / NHEAD, h = it % NHEAD, b = tok / SEQ, t = tok % SEQ;
        float q[64], o[64];
        { const bf16_t* qp = PROJ + (size_t)tok * NPROJ + C_Q + h * 64;
#pragma unroll
          for (int d = 0; d < 64; ++d) { q[d] = bf2f(qp[d]); o[d] = 0.f; } }
        float R = 0.f;
        for (int c0 = t - 1; c0 >= 0; c0 -= 64) {
            const int s = c0 - lane; const bool valid = s >= 0; const int sc = valid ? s : 0;
            const bf16_t* kp = PROJ + (size_t)(b * SEQ + sc) * NPROJ + C_K + h * 64;
            float dot = 0.f;
#pragma unroll
            for (int d8 = 0; d8 < 8; ++d8) { const bf16x8 kv = *(const bf16x8*)(kp + d8 * 8);
#pragma unroll
                for (int j = 0; j < 8; ++j) dot += q[d8 * 8 + j] * bf2f((bf16_t)kv[j]); }
            const float sp = fmaxf(dot, 0.f) + __log2f(1.0f + exp2f(-fabsf(dot)));
            const float L = valid ? -sp : 0.f;
            float incl = L;
#pragma unroll
            for (int off = 1; off < 64; off <<= 1) { const float n = __shfl_up(incl, off); if (lane >= off) incl += n; }
            const float w = valid ? exp2f(dot + L + (R + incl - L)) : 0.f;
            R += __shfl(incl, 63);
            const bf16_t* vp = VT + (size_t)(h * 64) * NTOK + b * SEQ + sc;
#pragma unroll
            for (int d = 0; d < 64; ++d) o[d] += w * bf2f(vp[(size_t)d * NTOK]);
        }
        float ss = 0.f, mine = 0.f;
#pragma unroll
        for (int d = 0; d < 64; ++d) { const float v = wave_sum(o[d]); ss += v * v; if (d == lane) mine = v; }
        YMIX[(size_t)tok * DM + 512 + h * 64 + lane] = f2bf(mine * (1.0f / sqrtf(ss * (1.f / 64.f) + RMS_EPS)) * p.gn_sb[h * 64 + lane]);
    }
}

template <bool STATS, class Epi>
__device__ __forceinline__ void gemm_simple(const bf16_t* A, const bf16_t* Bt, int M, int N, int K, float* st, Epi epi) {
    const int wave = threadIdx.x >> 6, lane = threadIdx.x & 63; const int gw = blockIdx.x * 8 + wave, NGW = gridDim.x * 8;
    const int tn_n = N / 64, nt = (M / 64) * tn_n;
    for (int t = gw; t < nt; t += NGW) {
        const int tm = t / tn_n, tn = t % tn_n;
        f32x16 c[2][2];
        wave_tile<1>(K, [&](int i) { return A + (size_t)(tm * 64 + i) * K; }, [&](int j) { return Bt + (size_t)(tn * 64 + j) * K; }, c);
#pragma unroll
        for (int i = 0; i < 2; ++i)
#pragma unroll
            for (int q = 0; q < 16; ++q) { const int row = tm * 64 + TROW(i, q); float s = 0.f, qq = 0.f;
#pragma unroll
                for (int j = 0; j < 2; ++j) { const float v = epi(row, tn * 64 + TCOL(j), c[i][j][q]); s += v; qq += v * v; }
                if (STATS) {
#pragma unroll
                    for (int o = 1; o < 32; o <<= 1) { s += __shfl_xor(s, o); qq += __shfl_xor(qq, o); }
                    if ((lane & 31) == 0) { atomicAdd(st + 2 * row, s); atomicAdd(st + 2 * row + 1, qq); } } }
    }
}
__device__ void phase_outproj_simple(const Params& p) {
    unsigned char* ws = p.ws; bf16_t* T1B = (bf16_t*)(ws + WS_T1B); const float* x = p.x;
    gemm_simple<true>((const bf16_t*)(ws + WS_YMIX), (const bf16_t*)(ws + WS_WOUT), NTOK, DM, DM, (float*)(ws + WS_STATS1),
        [=](int row, int col, float v) { const float t = ALPHA * x[(size_t)row * DM + col] + v; T1B[(size_t)row * DM + col] = f2bf(t); return t; });
}
__device__ void phase_mq_simple(const Params& p) {
    unsigned char* ws = p.ws; bf16_t* QM = (bf16_t*)(ws + WS_QM); const float* st = (const float*)(ws + WS_STATS1); const float* cs = (const float*)(ws + WS_CS1); const float* bs = cs + 1024;
    gemm_simple<false>((const bf16_t*)(ws + WS_T1B), (const bf16_t*)(ws + WS_WMQ), NTOK, DM, DM, nullptr,
        [=](int row, int col, float v) { const RowStat r = row_stat(st, row); QM[(size_t)row * DM + col] = f2bf(r.rstd * (v - r.mean * cs[col]) + bs[col]); return 0.f; });
}
__device__ void phase_xattn_simple(const Params& p, unsigned char* lds) {
    unsigned char* ws = p.ws; const int lane = threadIdx.x & 63, wave = threadIdx.x >> 6; const int gw = blockIdx.x * 8 + wave, NGW = gridDim.x * 8;
    const bf16_t* QM = (const bf16_t*)(ws + WS_QM); const bf16_t* MK = (const bf16_t*)(ws + WS_MEMK); const bf16_t* MVT = (const bf16_t*)(ws + WS_MEMVT); bf16_t* OB = (bf16_t*)(ws + WS_OB);
    float* qs = (float*)(lds + wave * 4096); float* ps = qs + 256;
    for (int it = gw; it < NTOK * MH; it += NGW) {
        const int tok = it / MH, h = it % MH, b = tok / SEQ;
        const bf16_t* qp = QM + (size_t)tok * DM + h * MHD;
#pragma unroll
        for (int j = 0; j < 4; ++j) qs[lane + 64 * j] = bf2f(qp[lane + 64 * j]);
        asm volatile("s_waitcnt lgkmcnt(0)" ::: "memory");
        float sc[4];
#pragma unroll
        for (int j = 0; j < 4; ++j) { const int key = lane + 64 * j; const bf16_t* kp = MK + (size_t)(b * MEML + key) * DM + h * MHD; float dot = 0.f;
#pragma unroll 2
            for (int d8 = 0; d8 < 32; ++d8) { const bf16x8 kv = *(const bf16x8*)(kp + d8 * 8);
#pragma unroll
                for (int e = 0; e < 8; ++e) dot += qs[d8 * 8 + e] * bf2f((bf16_t)kv[e]); }
            sc[j] = dot; }
        const float mx = wave_max(fmaxf(fmaxf(sc[0], sc[1]), fmaxf(sc[2], sc[3])));
        float sum = 0.f;
#pragma unroll
        for (int j = 0; j < 4; ++j) { sc[j] = exp2f(sc[j] - mx); sum += sc[j]; }
        sum = wave_sum(sum); const float inv = 1.0f / sum;
#pragma unroll
        for (int j = 0; j < 4; ++j) ps[lane + 64 * j] = sc[j] * inv;
        asm volatile("s_waitcnt lgkmcnt(0)" ::: "memory");
#pragma unroll
        for (int j = 0; j < 4; ++j) { const int d = lane + 64 * j; const bf16_t* vp = MVT + (size_t)(h * MHD + d) * NMEM + b * MEML; float acc = 0.f;
#pragma unroll 2
            for (int k8 = 0; k8 < 32; ++k8) { const bf16x8 vv = *(const bf16x8*)(vp + k8 * 8);
#pragma unroll
                for (int e = 0; e < 8; ++e) acc += ps[k8 * 8 + e] * bf2f((bf16_t)vv[e]); }
            OB[(size_t)tok * DM + h * MHD + d] = f2bf(acc); }
        asm volatile("s_waitcnt lgkmcnt(0)" ::: "memory");
    }
}
__device__ void phase_mo_simple(const Params& p) {
    unsigned char* ws = p.ws; bf16_t* T2B = (bf16_t*)(ws + WS_T2B); const bf16_t* T1B = (const bf16_t*)(ws + WS_T1B); const float* st1 = (const float*)(ws + WS_STATS1);
    const float* g1 = p.ln1_g; const float* b1 = p.ln1_b;
    gemm_simple<true>((const bf16_t*)(ws + WS_OB), (const bf16_t*)(ws + WS_WMO), NTOK, DM, DM, (float*)(ws + WS_STATS2),
        [=](int row, int col, float v) { const RowStat r = row_stat(st1, row); const float x1 = (bf2f(T1B[(size_t)row * DM + col]) - r.mean) * r.rstd * g1[col] + b1[col];
            const float t = ALPHA * x1 + v; T2B[(size_t)row * DM + col] = f2bf(t); return t; });
}
__device__ void phase_router_simple(const Params& p) {
    unsigned char* ws = p.ws; float* LG = (float*)(ws + WS_LOGIT); const float* st = (const float*)(ws + WS_STATS2); const float* cs = (const float*)(ws + WS_CS2); const float* bs = cs + 64;
    gemm_simple<false>((const bf16_t*)(ws + WS_T2B), (const bf16_t*)(ws + WS_WRT), NTOK, 64, DM, nullptr,
        [=](int row, int col, float v) { const RowStat r = row_stat(st, row); LG[(size_t)row * NLOGP + col] = r.rstd * (v - r.mean * cs[col]) + bs[col]; return 0.f; });
}
__device__ void phase_route(const Params& p) {
    unsigned char* ws = p.ws; const int gt = blockIdx.x * 512 + threadIdx.x, NGT = gridDim.x * 512;
    const float* LG = (const float*)(ws + WS_LOGIT); int* EID = (int*)(ws + WS_EID); float* GATE = (float*)(ws + WS_GATE); unsigned* CNT = (unsigned*)(ws + WS_CNT); int* ROWL = (int*)(ws + WS_ROWL);
    for (int tok = gt; tok < NTOK; tok += NGT) {
        const float* lg = LG + (size_t)tok * NLOGP;
        int grp = 0; float gm = lg[0];
#pragma unroll
        for (int g = 1; g < 4; ++g) if (lg[g] > gm) { gm = lg[g]; grp = g; }
        float gs = 0.f;
#pragma unroll
        for (int g = 0; g < 4; ++g) gs += __expf(lg[g] - gm);
        const float gprob = 1.0f / gs;
        const float* el = lg + 4 + grp * 8;
        int i1 = 0; float l1 = el[0];
#pragma unroll
        for (int j = 1; j < 8; ++j) if (el[j] > l1) { l1 = el[j]; i1 = j; }
        int i2 = -1; float l2 = 0.f;
#pragma unroll
        for (int j = 0; j < 8; ++j) if (j != i1 && (i2 < 0 || el[j] > l2)) { l2 = el[j]; i2 = j; }
        const float e2 = __expf(l2 - l1), w1 = 1.0f / (1.0f + e2), w2 = e2 * w1;
        const int ea = grp * 8 + i1, eb = grp * 8 + i2;
        EID[2 * tok] = ea; EID[2 * tok + 1] = eb; GATE[2 * tok] = gprob * w1; GATE[2 * tok + 1] = gprob * w2;
        const unsigned pa = atomicAdd(CNT + ea, 1u); ROWL[(size_t)ea * CAP + pa] = 2 * tok;
        const unsigned pb = atomicAdd(CNT + eb, 1u); ROWL[(size_t)eb * CAP + pb] = 2 * tok + 1;
    }
}
__device__ void phase_moe1_simple(const Params& p) {
    unsigned char* ws = p.ws; const int wave = threadIdx.x >> 6; const int gw = blockIdx.x * 8 + wave, NGW = gridDim.x * 8;
    const unsigned* CNT = (const unsigned*)(ws + WS_CNT); const int* ROWL = (const int*)(ws + WS_ROWL); const bf16_t* T2B = (const bf16_t*)(ws + WS_T2B); const bf16_t* WGU = (const bf16_t*)(ws + WS_WGU);
    const float* st = (const float*)(ws + WS_STATS2); const float* csg = (const float*)(ws + WS_CSGU); const float* bsg = csg + NEXP * 1024; bf16_t* H = (bf16_t*)(ws + WS_H);
    int tbase = 0, hoff = 0;
    for (int e = 0; e < NEXP; ++e) {
        const int cnt = (int)CNT[e], nrt = (cnt + 63) / 64, ntile = nrt * 8;
        for (int t = gw - tbase; t < ntile; t += NGW) { if (t < 0) continue;
            const int tm = t / 8, ct = t % 8, pn = ct >> 1, hf = ct & 1; const int* rl = ROWL + (size_t)e * CAP; const bf16_t* W = WGU + (size_t)e * 1024 * 1024;
            f32x16 c[2][4];
            wave_tile<2>(DM, [&](int i) { int r = tm * 64 + i; r = r < cnt ? r : cnt - 1; return T2B + (size_t)(rl[r] >> 1) * DM; },
                         [&](int j) { const int row = 256 * pn + (j >= 64 ? 128 : 0) + 64 * hf + (j & 63); return W + (size_t)row * DM; }, c);
#pragma unroll
            for (int i = 0; i < 2; ++i)
#pragma unroll
                for (int q = 0; q < 16; ++q) { const int r = tm * 64 + TROW(i, q); if (r < cnt) { const RowStat rs = row_stat(st, rl[r] >> 1);
#pragma unroll
                    for (int j = 0; j < 2; ++j) { const int cg_ = 256 * pn + 64 * hf + TCOL(j), cu_ = cg_ + 128;
                        const float g = rs.rstd * (c[i][j][q] - rs.mean * csg[e * 1024 + cg_]) + bsg[e * 1024 + cg_];
                        const float u = rs.rstd * (c[i][j + 2][q] - rs.mean * csg[e * 1024 + cu_]) + bsg[e * 1024 + cu_];
                        H[(size_t)(hoff + r) * DEXP + 128 * pn + 64 * hf + TCOL(j)] = f2bf(g / (1.0f + __expf(-g)) * u); } } }
        }
        tbase = (tbase + ntile) % NGW; hoff += (cnt + 255) / 256 * 256;
    }
}
__device__ void phase_moe2_simple(const Params& p) {
    unsigned char* ws = p.ws; const int wave = threadIdx.x >> 6; const int gw = blockIdx.x * 8 + wave, NGW = gridDim.x * 8;
    const unsigned* CNT = (const unsigned*)(ws + WS_CNT); const int* ROWL = (const int*)(ws + WS_ROWL); const bf16_t* H = (const bf16_t*)(ws + WS_H); const bf16_t* WD = (const bf16_t*)(ws + WS_WD);
    const float* GATE = (const float*)(ws + WS_GATE); bf16_t* Y = (bf16_t*)(ws + WS_Y);
    int tbase = 0, hoff = 0;
    for (int e = 0; e < NEXP; ++e) {
        const int cnt = (int)CNT[e], nrt = (cnt + 63) / 64, ntile = nrt * 16;
        for (int t = gw - tbase; t < ntile; t += NGW) { if (t < 0) continue;
            const int tm = t / 16, tn = t % 16; const int* rl = ROWL + (size_t)e * CAP; const bf16_t* W = WD + (size_t)e * 1024 * 512;
            f32x16 c[2][2];
            wave_tile<1>(DEXP, [&](int i) { int r = tm * 64 + i; r = r < cnt ? r : cnt - 1; return H + (size_t)(hoff + r) * DEXP; }, [&](int j) { return W + (size_t)(tn * 64 + j) * DEXP; }, c);
#pragma unroll
            for (int i = 0; i < 2; ++i)
#pragma unroll
                for (int q = 0; q < 16; ++q) { const int r = tm * 64 + TROW(i, q); if (r < cnt) { const int a = rl[r]; const float g = GATE[a];
#pragma unroll
                    for (int j = 0; j < 2; ++j) Y[(size_t)a * DM + tn * 64 + TCOL(j)] = f2bf(g * c[i][j][q]); } }
        }
        tbase = (tbase + ntile) % NGW; hoff += (cnt + 255) / 256 * 256;
    }
}
__device__ void phase_final(const Params& p) {
    unsigned char* ws = p.ws; const int lane = threadIdx.x & 63, wave = threadIdx.x >> 6; const int gw = blockIdx.x * 8 + wave, NGW = gridDim.x * 8;
    const bf16_t* T2B = (const bf16_t*)(ws + WS_T2B); const bf16_t* Y = (const bf16_t*)(ws + WS_Y); const float* st = (const float*)(ws + WS_STATS2);
    for (int tok = gw; tok < NTOK; tok += NGW) {
        const RowStat rs = row_stat(st, tok);
        float v[16]; float s = 0.f;
#pragma unroll
        for (int j = 0; j < 4; ++j) { const int c0 = 256 * j + 4 * lane;
            const u32x2 t2 = *(const u32x2*)(T2B + (size_t)tok * DM + c0), y0 = *(const u32x2*)(Y + (size_t)(2 * tok) * DM + c0), y1 = *(const u32x2*)(Y + (size_t)(2 * tok + 1) * DM + c0);
            const f32x4 g2 = *(const f32x4*)(p.ln2_g + c0), b2 = *(const f32x4*)(p.ln2_b + c0);
            const unsigned tw[2] = {t2.x, t2.y}, aw[2] = {y0.x, y0.y}, bw[2] = {y1.x, y1.y};
#pragma unroll
            for (int e = 0; e < 4; ++e) { const float tt = bf2f((bf16_t)(tw[e >> 1] >> (16 * (e & 1)))), ya = bf2f((bf16_t)(aw[e >> 1] >> (16 * (e & 1)))), yb = bf2f((bf16_t)(bw[e >> 1] >> (16 * (e & 1))));
                const float x2 = (tt - rs.mean) * rs.rstd * g2[e] + b2[e]; const float t3 = ALPHA * x2 + ya + yb; v[4 * j + e] = t3; s += t3; } }
        const float mean = wave_sum(s) * (1.f / DM); float qq = 0.f;
#pragma unroll
        for (int i = 0; i < 16; ++i) { v[i] -= mean; qq += v[i] * v[i]; }
        const float rstd = 1.0f / sqrtf(wave_sum(qq) * (1.f / DM) + LN_EPS);
#pragma unroll
        for (int j = 0; j < 4; ++j) { const int c0 = 256 * j + 4 * lane; const f32x4 g3 = *(const f32x4*)(p.ln3_g + c0), b3 = *(const f32x4*)(p.ln3_b + c0);
            f32x4 o; o.x = v[4 * j] * rstd * g3.x + b3.x; o.y = v[4 * j + 1] * rstd * g3.y + b3.y; o.z = v[4 * j + 2] * rstd * g3.z + b3.z; o.w = v[4 * j + 3] * rstd * g3.w + b3.w;
            *(f32x4*)(p.out + (size_t)tok * DM + c0) = o; }
    }
}

namespace mm {
#define LAS __attribute__((address_space(3)))
constexpr int BM = 256, BK = 64, HALF = 128, HTB = HALF * BK * 2, STAGE_BYTES = 8 * HTB, NXCD = 8, WGM = 8;
__device__ __forceinline__ int lds_byte(int r, int c) { const int st = (r >> 4) * 2 + (c >> 5), rr = r & 15, cc = c & 31, ob = rr * 64 + cc * 2; return st * 1024 + (ob ^ (((ob >> 9) & 1) << 5)); }
__device__ __forceinline__ void stage_rc(int b, int& R, int& C) { const int st = b / 1024, sb = b % 1024, swz = sb ^ (((sb >> 9) & 1) << 5); R = (st >> 1) * 16 + swz / 64; C = (st & 1) * 32 + (swz % 64) / 2; }
__device__ __forceinline__ int perm32(int rho) { const int n = rho >> 4, i = rho & 15; return 8 * (i >> 2) + 4 * n + (i & 3); }
__device__ __forceinline__ unsigned cvt_pk_bf16(float lo, float hi) { typedef float f2 __attribute__((ext_vector_type(2))); typedef __bf16 b2 __attribute__((ext_vector_type(2))); f2 v = {lo, hi}; b2 b = __builtin_convertvector(v, b2); return __builtin_bit_cast(unsigned, b); }

struct Unit { int pm, pn, aux, nvalid; const char* a; const char* b; const int* rows; };

__device__ __forceinline__ void order_map(int L, int nM, int nN, int& pm, int& pn) {
    const int nwg = nM * nN; int wgid = L; { const int q = nwg / NXCD, r = nwg % NXCD, xcd = wgid % NXCD, off = wgid / NXCD; wgid = (xcd < r ? xcd * (q + 1) : r * (q + 1) + (xcd - r) * q) + off; }
    const int nig = WGM * nN, gid = wgid / nig, fm = gid * WGM, gsz = (nM - fm) < WGM ? (nM - fm) : WGM;
    pm = fm + ((wgid % nig) % gsz); pn = (wgid % nig) / gsz;
}

template <class Epi, class Sched, bool GATHER>
__device__ __forceinline__ void gemm_phase(LAS unsigned char* lds, const int K, const Sched& S, const Epi& E) {
    const int tid = threadIdx.x, wid = __builtin_amdgcn_readfirstlane(tid >> 6), lane = tid & 63, wr = wid >> 2, wc = wid & 3, fr = lane & 15, fq = lane >> 4;
    const int nt = K / BK;
    unsigned voffB, voffA, rp[2];
    { int sR, sC; stage_rc(tid * 16, sR, sC); const int Rb = Epi::PERM ? ((sR & ~31) + perm32(sR & 31)) : sR;
      voffB = (unsigned)(Rb * K + sC) * 2u; voffA = GATHER ? (unsigned)sC * 2u : (unsigned)(sR * K + sC) * 2u; }
    const size_t kstep = (size_t)(BK * 2), hstep = (size_t)HALF * K * 2, r64 = (size_t)64 * K * 2;
    const unsigned ldsw = (unsigned)wid * 1024u;
    const int aoff = lds_byte(wr * 64 + fr, fq * 8), boff = lds_byte(wc * 32 + fr, fq * 8);
#define MM_SA(b, h) (((b) * 2 + (h)) * HTB)
#define MM_SB(b, h) ((4 + (b) * 2 + (h)) * HTB)
#define MM_GLDS(src, dst) __builtin_amdgcn_global_load_lds((const unsigned*)(src), (LAS unsigned*)(dst), 16, 0, 0)
#define MM_STAGE_B(bufoff, gbase) do { MM_GLDS((const char*)(gbase) + voffB, lds + (bufoff) + ldsw); MM_GLDS((const char*)(gbase) + r64 + voffB, lds + (bufoff) + ldsw + 8192); } while (0)
#define MM_STAGE_A(bufoff, gbase, h) do { if (GATHER) { \
        MM_GLDS((const char*)(gbase) + (unsigned)((rp[h] & 0xffffu) * (unsigned)(K * 2) + voffA), lds + (bufoff) + ldsw); MM_GLDS((const char*)(gbase) + (unsigned)((rp[h] >> 16) * (unsigned)(K * 2) + voffA), lds + (bufoff) + ldsw + 8192); } \
      else { MM_GLDS((const char*)(gbase) + (h) * hstep + voffA, lds + (bufoff) + ldsw); MM_GLDS((const char*)(gbase) + (h) * hstep + r64 + voffA, lds + (bufoff) + ldsw + 8192); } } while (0)
#define MM_LDA(dst, b, h) do { _Pragma("unroll") for (int m = 0; m < 4; ++m) _Pragma("unroll") for (int k = 0; k < 2; ++k) dst[m][k] = *(const LAS bf16x8*)(lds + MM_SA(b, h) + aoff + m * 2048 + k * 1024); } while (0)
#define MM_LDB(dst, b, h) do { _Pragma("unroll") for (int n = 0; n < 2; ++n) _Pragma("unroll") for (int k = 0; k < 2; ++k) dst[n][k] = *(const LAS bf16x8*)(lds + MM_SB(b, h) + boff + n * 2048 + k * 1024); } while (0)
#define MM_MMA(ai, bj, At, Bt) do { __builtin_amdgcn_s_setprio(1); _Pragma("unroll") for (int m = 0; m < 4; ++m) _Pragma("unroll") for (int n = 0; n < 2; ++n) _Pragma("unroll") for (int k = 0; k < 2; ++k) \
        acc[ai][bj][m][n] = __builtin_amdgcn_mfma_f32_16x16x32_bf16(Bt[n][k], At[m][k], acc[ai][bj][m][n], 0, 0, 0); __builtin_amdgcn_s_setprio(0); } while (0)
#define MM_WAIT_V(n) asm volatile("s_waitcnt vmcnt(" #n ")" ::: "memory")
#define MM_WAIT_L(n) asm volatile("s_waitcnt lgkmcnt(" #n ")" ::: "memory")
#define MM_BAR __builtin_amdgcn_s_barrier()
#define MM_SCHED __builtin_amdgcn_sched_barrier(0)
#define MM_ROWPAIRS(dst, u) do { int _t = tid; asm volatile("" : "+v"(_t)); int _sR, _sC; stage_rc(_t * 16, _sR, _sC); _Pragma("unroll") for (int _h = 0; _h < 2; ++_h) \
        dst[_h] = (unsigned)S.row(u, _h * HALF + _sR) | ((unsigned)S.row(u, _h * HALF + _sR + 64) << 16); } while (0)
#define MM_NVL() ((LAS unsigned*)(lds + 133120 + tid * 8))
    Unit cur, nxt, nx2; int ui = 0;
    if (!S.next(0, cur)) return;
    f32x4 acc[2][2][4][2];
#pragma unroll
    for (int a = 0; a < 2; ++a)
#pragma unroll
        for (int b = 0; b < 2; ++b)
#pragma unroll
            for (int m = 0; m < 4; ++m)
#pragma unroll
                for (int n = 0; n < 2; ++n) acc[a][b][m][n] = (f32x4){0.f, 0.f, 0.f, 0.f};
    bf16x8 At[4][2], B0[2][2], B1[2][2];
    rp[0] = rp[1] = 0u;
    if (GATHER) { unsigned nv[2]; MM_ROWPAIRS(rp, cur); if (S.next(1, nxt)) { MM_ROWPAIRS(nv, nxt); } else { nv[0] = rp[0]; nv[1] = rp[1]; }
        MM_NVL()[0] = nv[0]; MM_NVL()[1] = nv[1];
        asm volatile("s_waitcnt vmcnt(0) lgkmcnt(0)" ::: "memory");
        asm volatile("" : "+v"(rp[0]), "+v"(rp[1])); }
    const char* cA = cur.a; const char* cB = cur.b;
    MM_STAGE_B(MM_SB(0, 0), cB); MM_STAGE_B(MM_SB(0, 1), cB + hstep); MM_STAGE_A(MM_SA(0, 0), cA, 0); MM_STAGE_A(MM_SA(0, 1), cA, 1);
    if (wr == 1) MM_BAR;
    MM_WAIT_V(2); MM_BAR;
    MM_STAGE_B(MM_SB(1, 0), cB + kstep); MM_STAGE_A(MM_SA(1, 0), cA + kstep, 0); MM_STAGE_B(MM_SB(1, 1), cB + hstep + kstep);
    MM_WAIT_V(6); MM_BAR;
    for (;;) {
        const bool has_next = S.next(ui + 1, nxt);
        const char* nA = has_next ? nxt.a : cA; const char* nB = has_next ? nxt.b : cB;
        for (int t = 0; t < nt; t += 2) {
            const bool last = (t == nt - 2);
            const char* a1 = cA + (size_t)(t + 1) * kstep;
            const char* a2 = last ? nA : cA + (size_t)(t + 2) * kstep; const char* b2 = last ? nB : cB + (size_t)(t + 2) * kstep;
            const char* a3 = a2 + kstep; const char* b3 = b2 + kstep;
            MM_LDB(B0, 0, 0); MM_LDB(B1, 0, 1); MM_SCHED; MM_LDA(At, 0, 0); MM_STAGE_A(MM_SA(1, 1), a1, 1);
            MM_WAIT_V(8); MM_WAIT_L(0); MM_BAR; MM_MMA(0, 0, At, B0); MM_MMA(0, 1, At, B1); MM_BAR; MM_SCHED;
            if (GATHER) { if (last) { rp[0] = MM_NVL()[0]; rp[1] = MM_NVL()[1]; } }
            MM_LDA(At, 0, 1); MM_STAGE_B(MM_SB(0, 0), b2); MM_STAGE_B(MM_SB(0, 1), b2 + hstep); MM_STAGE_A(MM_SA(0, 0), a2, 0);
            MM_WAIT_V(8); MM_WAIT_L(0); MM_BAR; MM_MMA(1, 0, At, B0); MM_MMA(1, 1, At, B1); MM_BAR; MM_SCHED;
            MM_LDB(B0, 1, 0); MM_LDB(B1, 1, 1); MM_SCHED; MM_LDA(At, 1, 0); MM_STAGE_A(MM_SA(0, 1), a2, 1);
            MM_WAIT_V(8); MM_WAIT_L(0); MM_BAR; MM_MMA(0, 0, At, B0); MM_MMA(0, 1, At, B1); MM_BAR; MM_SCHED;
            MM_LDA(At, 1, 1); MM_STAGE_B(MM_SB(1, 0), b3); MM_STAGE_B(MM_SB(1, 1), b3 + hstep); MM_STAGE_A(MM_SA(1, 0), a3, 0);
            MM_WAIT_V(8); MM_WAIT_L(0); MM_BAR; MM_MMA(1, 0, At, B0); MM_MMA(1, 1, At, B1); MM_BAR; MM_SCHED;
        }
        if (wr == 0) MM_BAR;
        E(acc, cur, wr, wc, fr, fq);
        if (!has_next) break;
        if (GATHER) {
            if (S.next(ui + 2, nx2)) { unsigned nv[2]; MM_ROWPAIRS(nv, nx2); MM_NVL()[0] = nv[0]; MM_NVL()[1] = nv[1]; }
            asm volatile("s_waitcnt vmcnt(0) lgkmcnt(0)" ::: "memory"); }
#pragma unroll
        for (int a = 0; a < 2; ++a)
#pragma unroll
            for (int b = 0; b < 2; ++b)
#pragma unroll
                for (int m = 0; m < 4; ++m)
#pragma unroll
                    for (int n = 0; n < 2; ++n) acc[a][b][m][n] = (f32x4){0.f, 0.f, 0.f, 0.f};
        cur = nxt; cA = nA; cB = nB; ++ui;
        if (wr == 1) MM_BAR;
    }
    MM_WAIT_V(0);
    MM_BAR;
#undef MM_SA
#undef MM_SB
#undef MM_GLDS
#undef MM_STAGE_A
#undef MM_STAGE_B
#undef MM_LDA
#undef MM_LDB
#undef MM_MMA
#undef MM_WAIT_V
#undef MM_WAIT_L
#undef MM_BAR
#undef MM_SCHED
#undef MM_ROWPAIRS
#undef MM_NVL
}
}

typedef mm::Unit MUnit;
typedef f32x4 AccT[2][2][4][2];
__device__ __forceinline__ u32x4 pack8(const f32x4 a, const f32x4 b) { u32x4 w; w.x = mm::cvt_pk_bf16(a[0], a[1]); w.y = mm::cvt_pk_bf16(a[2], a[3]); w.z = mm::cvt_pk_bf16(b[0], b[1]); w.w = mm::cvt_pk_bf16(b[2], b[3]); return w; }
__device__ __forceinline__ f32x4 unpack_lo(const u32x4 w) { return (f32x4){__uint_as_float(w.x << 16), __uint_as_float(w.x & 0xffff0000u), __uint_as_float(w.y << 16), __uint_as_float(w.y & 0xffff0000u)}; }
__device__ __forceinline__ f32x4 unpack_hi(const u32x4 w) { return (f32x4){__uint_as_float(w.z << 16), __uint_as_float(w.z & 0xffff0000u), __uint_as_float(w.w << 16), __uint_as_float(w.w & 0xffff0000u)}; }

struct SchedProj {
    const char *xb, *win, *memb, *wmk, *wmv; int G, c;
    __device__ __forceinline__ bool next(int i, MUnit& u) const {
        int L = i * G + c; u.rows = nullptr; u.nvalid = 256;
        constexpr int U0 = 256 * 10, U1 = 512, U2 = 128, U3 = 128;
        if (L < U0) { int pm, pn; mm::order_map(L, 256, 10, pm, pn); u.pm = pm; u.pn = pn; u.aux = 0; u.a = xb + (size_t)pm * 256 * 2048; u.b = win + (size_t)pn * 256 * 2048; return true; }
        L -= U0;
        if (L < U1) { u.pm = L & 1; u.pn = L >> 1; u.aux = 1; u.a = win + (size_t)(C_V + 256 * u.pm) * 2048; u.b = xb + (size_t)u.pn * 256 * 2048; return true; }
        L -= U1;
        if (L < U2) { u.pm = L >> 2; u.pn = L & 3; u.aux = 2; u.a = memb + (size_t)u.pm * 256 * 2048; u.b = wmk + (size_t)u.pn * 256 * 2048; return true; }
        L -= U2;
        if (L < U3) { u.pm = L & 3; u.pn = L >> 2; u.aux = 3; u.a = wmv + (size_t)u.pm * 256 * 2048; u.b = memb + (size_t)u.pn * 256 * 2048; return true; }
        return false;
    }
    __device__ __forceinline__ int row(const MUnit&, int r) const { return r; }
};
struct EpiProj {
    static constexpr bool PERM = true;
    bf16_t *proj, *vt, *mk, *mvt;
    __device__ __forceinline__ void operator()(const AccT& acc, const MUnit& u, int wr, int wc, int fr, int fq) const {
        bf16_t* O = u.aux == 0 ? proj : u.aux == 1 ? vt : u.aux == 2 ? mk : mvt; const int ldc = u.aux == 0 ? NPROJ : u.aux == 1 ? NTOK : u.aux == 2 ? DM : NMEM;
        const int row0 = u.pm * 256 + wr * 64 + fr, col0 = u.pn * 256 + wc * 32 + 8 * fq;
#pragma unroll
        for (int ai = 0; ai < 2; ++ai)
#pragma unroll
            for (int m = 0; m < 4; ++m) { bf16_t* rowp = O + (size_t)(row0 + ai * 128 + m * 16) * ldc + col0;
#pragma unroll
                for (int bj = 0; bj < 2; ++bj) *(u32x4*)(rowp + bj * 128) = pack8(acc[ai][bj][m][0], acc[ai][bj][m][1]); }
    }
};
struct SchedDense {
    const char *A, *B; int nM, nN, G, c;
    __device__ __forceinline__ bool next(int i, MUnit& u) const {
        const int L = i * G + c; if (L >= nM * nN) return false;
        int pm, pn; mm::order_map(L, nM, nN, pm, pn); u.pm = pm; u.pn = pn; u.aux = 0; u.nvalid = 256; u.rows = nullptr; u.a = A + (size_t)pm * 256 * 2048; u.b = B + (size_t)pn * 256 * 2048; return true;
    }
    __device__ __forceinline__ int row(const MUnit&, int r) const { return r; }
};
__device__ __forceinline__ void row_stats_add(float* st, int row, float s, float q, int fq) {
    s += __shfl_xor(s, 16); s += __shfl_xor(s, 32); q += __shfl_xor(q, 16); q += __shfl_xor(q, 32);
    if (fq == 0) { atomicAdd(st + 2 * row, s); atomicAdd(st + 2 * row + 1, q); }
}
__device__ __forceinline__ float sum4(const f32x4 v) { return (v[0] + v[1]) + (v[2] + v[3]); }
__device__ __forceinline__ float sq4(const f32x4 v) { return (v[0] * v[0] + v[1] * v[1]) + (v[2] * v[2] + v[3] * v[3]); }
struct EpiOut {
    static constexpr bool PERM = true;
    const float* x; bf16_t* t1b; float* st;
    __device__ __forceinline__ void operator()(const AccT& acc, const MUnit& u, int wr, int wc, int fr, int fq) const {
#pragma unroll
        for (int ai = 0; ai < 2; ++ai)
#pragma unroll
            for (int m = 0; m < 4; ++m) { const int row = u.pm * 256 + ai * 128 + wr * 64 + m * 16 + fr; float s = 0.f, q = 0.f;
#pragma unroll
                for (int bj = 0; bj < 2; ++bj) { const size_t off = (size_t)row * DM + u.pn * 256 + bj * 128 + wc * 32 + 8 * fq;
                    const f32x4 t0 = ALPHA * *(const f32x4*)(x + off) + acc[ai][bj][m][0], t1 = ALPHA * *(const f32x4*)(x + off + 4) + acc[ai][bj][m][1];
                    *(u32x4*)(t1b + off) = pack8(t0, t1); s += sum4(t0) + sum4(t1); q += sq4(t0) + sq4(t1); }
                row_stats_add(st, row, s, q, fq); }
    }
};
struct EpiMq {
    static constexpr bool PERM = true;
    bf16_t* qm; const float *st, *cs, *bs;
    __device__ __forceinline__ void operator()(const AccT& acc, const MUnit& u, int wr, int wc, int fr, int fq) const {
#pragma unroll
        for (int bj = 0; bj < 2; ++bj) { const int col = u.pn * 256 + bj * 128 + wc * 32 + 8 * fq;
            const f32x4 c0 = *(const f32x4*)(cs + col), c1 = *(const f32x4*)(cs + col + 4), b0 = *(const f32x4*)(bs + col), b1 = *(const f32x4*)(bs + col + 4);
#pragma unroll
            for (int ai = 0; ai < 2; ++ai)
#pragma unroll
                for (int m = 0; m < 4; ++m) { const int row = u.pm * 256 + ai * 128 + wr * 64 + m * 16 + fr; const RowStat r = row_stat(st, row);
                    const f32x4 v0 = r.rstd * (acc[ai][bj][m][0] - r.mean * c0) + b0, v1 = r.rstd * (acc[ai][bj][m][1] - r.mean * c1) + b1;
                    *(u32x4*)(qm + (size_t)row * DM + col) = pack8(v0, v1); } }
    }
};
struct EpiMo {
    static constexpr bool PERM = true;
    const bf16_t* t1b; const float *st1, *g1, *b1; bf16_t* t2b; float* st2;
    __device__ __forceinline__ void operator()(const AccT& acc, const MUnit& u, int wr, int wc, int fr, int fq) const {
#pragma unroll
        for (int ai = 0; ai < 2; ++ai)
#pragma unroll
            for (int m = 0; m < 4; ++m) { const int row = u.pm * 256 + ai * 128 + wr * 64 + m * 16 + fr; const RowStat r = row_stat(st1, row); float s = 0.f, q = 0.f;
#pragma unroll
                for (int bj = 0; bj < 2; ++bj) { const int col = u.pn * 256 + bj * 128 + wc * 32 + 8 * fq; const size_t off = (size_t)row * DM + col;
                    const u32x4 tw = *(const u32x4*)(t1b + off);
                    const f32x4 x0 = (unpack_lo(tw) - r.mean) * r.rstd * *(const f32x4*)(g1 + col) + *(const f32x4*)(b1 + col), x1 = (unpack_hi(tw) - r.mean) * r.rstd * *(const f32x4*)(g1 + col + 4) + *(const f32x4*)(b1 + col + 4);
                    const f32x4 t0 = ALPHA * x0 + acc[ai][bj][m][0], t1 = ALPHA * x1 + acc[ai][bj][m][1];
                    *(u32x4*)(t2b + off) = pack8(t0, t1); s += sum4(t0) + sum4(t1); q += sq4(t0) + sq4(t1); }
                row_stats_add(st2, row, s, q, fq); }
    }
};
struct EpiRouter {
    static constexpr bool PERM = false;
    float* lg; const float *st, *cs, *bs;
    __device__ __forceinline__ void operator()(const AccT& acc, const MUnit& u, int wr, int wc, int fr, int fq) const {
        if (wc < 2) {
#pragma unroll
            for (int n = 0; n < 2; ++n) { const int col = wc * 32 + 16 * n + 4 * fq; const f32x4 c0 = *(const f32x4*)(cs + col), b0 = *(const f32x4*)(bs + col);
#pragma unroll
                for (int ai = 0; ai < 2; ++ai)
#pragma unroll
                    for (int m = 0; m < 4; ++m) { const int row = u.pm * 256 + ai * 128 + wr * 64 + m * 16 + fr; const RowStat r = row_stat(st, row);
                        *(f32x4*)(lg + (size_t)row * NLOGP + col) = r.rstd * (acc[ai][0][m][n] - r.mean * c0) + b0; } }
        }
    }
};
constexpr int MOE_TB_OFF = 131072;
__device__ __forceinline__ void moe_tables(const unsigned* CNT, LAS int* tb) {
    if (threadIdx.x == 0) { int ub = 0, ho = 0;
        for (int e = 0; e < NEXP; ++e) { const int c = (int)CNT[e]; tb[e] = ub; tb[64 + e] = ho; tb[128 + e] = c; const int nt = (c + 255) / 256; ub += nt * 4; ho += nt * 256; }
        tb[32] = ub; }
    __syncthreads();
}
__device__ __forceinline__ int uni(int v) { return __builtin_amdgcn_readfirstlane(v); }
template <class T> __device__ __forceinline__ T* uni_ptr(T* q) { const unsigned long long v = (unsigned long long)q; const unsigned lo = __builtin_amdgcn_readfirstlane((unsigned)v), hi = __builtin_amdgcn_readfirstlane((unsigned)(v >> 32)); return (T*)(((unsigned long long)hi << 32) | lo); }
template <int WHICH> struct SchedMoe {
    const char *A, *B; const int* rowl; LAS int* tb; int G, c;
    __device__ __forceinline__ bool next(int i, MUnit& u) const {
        const int L = i * G + c; if (L >= uni(tb[32])) return false;
        int e = 0; while (uni(tb[e + 1]) <= L) ++e;
        const int l = L - uni(tb[e]), tm = l >> 2, pn = l & 3, cnt = uni(tb[128 + e]), rem = cnt - tm * 256, ho = uni(tb[64 + e]);
        u.pm = tm; u.pn = pn; u.aux = e; u.nvalid = rem < 256 ? rem : 256; u.rows = rowl + (size_t)e * CAP + tm * 256;
        if (WHICH == 1) { u.a = A; u.b = B + ((size_t)e * 1024 + pn * 256) * 2048; }
        else { u.a = A + (size_t)(ho + tm * 256) * 1024; u.b = B + ((size_t)e * 1024 + pn * 256) * 1024; }
        return true;
    }
    __device__ __forceinline__ int row(const MUnit& u, int r) const { return WHICH == 1 ? (u.rows[r < u.nvalid ? r : u.nvalid - 1] >> 1) : r; }
};
struct EpiMoe1 {
    static constexpr bool PERM = true;
    bf16_t* H; const float *st, *csg, *bsg; LAS int* tb;
    __device__ __forceinline__ void operator()(const AccT& acc, const MUnit& u, int wr, int wc, int fr, int fq) const {
        const int e = u.aux, hrow0 = uni(tb[64 + e]) + u.pm * 256, c8 = wc * 32 + 8 * fq, wrow = e * 1024 + u.pn * 256 + c8;
#pragma unroll
        for (int ai = 0; ai < 2; ++ai)
#pragma unroll
            for (int m = 0; m < 4; ++m) { const int rl = ai * 128 + wr * 64 + m * 16 + fr; const int tok = u.rows[rl < u.nvalid ? rl : u.nvalid - 1] >> 1; const RowStat r = row_stat(st, tok);
                f32x4 hv[2];
#pragma unroll
                for (int n = 0; n < 2; ++n) { const f32x4 cg = *(const f32x4*)(csg + wrow + 4 * n), bg = *(const f32x4*)(bsg + wrow + 4 * n), cu = *(const f32x4*)(csg + wrow + 128 + 4 * n), bu = *(const f32x4*)(bsg + wrow + 128 + 4 * n);
                    const f32x4 g = r.rstd * (acc[ai][0][m][n] - r.mean * cg) + bg, uu = r.rstd * (acc[ai][1][m][n] - r.mean * cu) + bu;
#pragma unroll
                    for (int j = 0; j < 4; ++j) hv[n][j] = g[j] / (1.0f + __expf(-g[j])) * uu[j]; }
                *(u32x4*)(H + (size_t)(hrow0 + rl) * DEXP + u.pn * 128 + c8) = pack8(hv[0], hv[1]);
                asm volatile("" ::: "memory"); }
    }
};
struct EpiMoe2 {
    static constexpr bool PERM = true;
    bf16_t* Y; const float* gate;
    __device__ __forceinline__ void operator()(const AccT& acc, const MUnit& u, int wr, int wc, int fr, int fq) const {
#pragma unroll
        for (int ai = 0; ai < 2; ++ai)
#pragma unroll
            for (int m = 0; m < 4; ++m) { const int rl = ai * 128 + wr * 64 + m * 16 + fr;
                if (rl < u.nvalid) { const int a = u.rows[rl]; const float g = gate[a];
#pragma unroll
                    for (int bj = 0; bj < 2; ++bj) *(u32x4*)(Y + (size_t)a * DM + u.pn * 256 + bj * 128 + wc * 32 + 8 * fq) = pack8(g * acc[ai][bj][m][0], g * acc[ai][bj][m][1]); } }
    }
};
__device__ __forceinline__ void phase_proj_fast(const Params& p, LAS unsigned char* lds) {
    unsigned char* ws = p.ws;
    SchedProj S{(const char*)(ws + WS_XB), (const char*)(ws + WS_WIN), (const char*)(ws + WS_MEMB), (const char*)(ws + WS_WMK), (const char*)(ws + WS_WMV), (int)gridDim.x, (int)blockIdx.x};
    EpiProj E{(bf16_t*)(ws + WS_PROJ), (bf16_t*)(ws + WS_VT), (bf16_t*)(ws + WS_MEMK), (bf16_t*)(ws + WS_MEMVT)};
    mm::gemm_phase<EpiProj, SchedProj, false>(lds, DM, S, E);
}
__device__ __forceinline__ void phase_outproj_fast(const Params& p, LAS unsigned char* lds) {
    unsigned char* ws = p.ws;
    SchedDense S{(const char*)(ws + WS_YMIX), (const char*)(ws + WS_WOUT), NTOK / 256, DM / 256, (int)gridDim.x, (int)blockIdx.x};
    EpiOut E{p.x, (bf16_t*)(ws + WS_T1B), (float*)(ws + WS_STATS1)};
    mm::gemm_phase<EpiOut, SchedDense, false>(lds, DM, S, E);
}
__device__ __forceinline__ void phase_mq_fast(const Params& p, LAS unsigned char* lds) {
    unsigned char* ws = p.ws;
    SchedDense S{(const char*)(ws + WS_T1B), (const char*)(ws + WS_WMQ), NTOK / 256, DM / 256, (int)gridDim.x, (int)blockIdx.x};
    EpiMq E{(bf16_t*)(ws + WS_QM), (const float*)(ws + WS_STATS1), (const float*)(ws + WS_CS1), (const float*)(ws + WS_CS1) + 1024};
    mm::gemm_phase<EpiMq, SchedDense, false>(lds, DM, S, E);
}
__device__ __forceinline__ void phase_mo_fast(const Params& p, LAS unsigned char* lds) {
    unsigned char* ws = p.ws;
    SchedDense S{(const char*)(ws + WS_OB), (const char*)(ws + WS_WMO), NTOK / 256, DM / 256, (int)gridDim.x, (int)blockIdx.x};
    EpiMo E{(const bf16_t*)(ws + WS_T1B), (const float*)(ws + WS_STATS1), p.ln1_g, p.ln1_b, (bf16_t*)(ws + WS_T2B), (float*)(ws + WS_STATS2)};
    mm::gemm_phase<EpiMo, SchedDense, false>(lds, DM, S, E);
}
__device__ __forceinline__ void phase_router_fast(const Params& p, LAS unsigned char* lds) {
    unsigned char* ws = p.ws;
    SchedDense S{(const char*)(ws + WS_T2B), (const char*)(ws + WS_WRT), NTOK / 256, 1, (int)gridDim.x, (int)blockIdx.x};
    EpiRouter E{(float*)(ws + WS_LOGIT), (const float*)(ws + WS_STATS2), (const float*)(ws + WS_CS2), (const float*)(ws + WS_CS2) + 64};
    mm::gemm_phase<EpiRouter, SchedDense, false>(lds, DM, S, E);
}
__device__ __forceinline__ void phase_moe1_fast(const Params& p, LAS unsigned char* lds) {
    unsigned char* ws = p.ws; LAS int* tb = (LAS int*)(lds + MOE_TB_OFF);
    moe_tables((const unsigned*)(ws + WS_CNT), tb);
    SchedMoe<1> S{(const char*)(ws + WS_T2B), (const char*)(ws + WS_WGU), (const int*)(ws + WS_ROWL), tb, (int)gridDim.x, (int)blockIdx.x};
    EpiMoe1 E{(bf16_t*)(ws + WS_H), (const float*)(ws + WS_STATS2), (const float*)(ws + WS_CSGU), (const float*)(ws + WS_CSGU) + NEXP * 1024, tb};
    mm::gemm_phase<EpiMoe1, SchedMoe<1>, true>(lds, DM, S, E);
}
__device__ __forceinline__ void phase_moe2_fast(const Params& p, LAS unsigned char* lds) {
    unsigned char* ws = p.ws; LAS int* tb = (LAS int*)(lds + MOE_TB_OFF);
    moe_tables((const unsigned*)(ws + WS_CNT), tb);
    SchedMoe<2> S{(const char*)(ws + WS_H), (const char*)(ws + WS_WD), (const int*)(ws + WS_ROWL), tb, (int)gridDim.x, (int)blockIdx.x};
    EpiMoe2 E{(bf16_t*)(ws + WS_Y), (const float*)(ws + WS_GATE)};
    mm::gemm_phase<EpiMoe2, SchedMoe<2>, false>(lds, DEXP, S, E);
}

constexpr float SB_EXIT = -160.0f;
constexpr int SB_LDS_WAVE = 18432, SB_KROW = 144, SB_VROW = 136;
__device__ __forceinline__ float fexp2(float x) { return __builtin_amdgcn_exp2f(x); }
__device__ __forceinline__ float flog2(float x) { return __builtin_amdgcn_logf(x); }

template <bool MASK>
__device__ __forceinline__ void sb_scan(f32x16 (&pp)[2], float& R, const int kb, const int lim, const int hi) {
    float gs[8];
#pragma unroll
    for (int a = 0; a < 8; ++a) {
        float L[4], s[4];
#pragma unroll
        for (int i = 0; i < 4; ++i) { s[i] = pp[a >> 2][4 * (a & 3) + i];
            const float sp = fmaxf(s[i], 0.f) + flog2(1.0f + fexp2(-fabsf(s[i])));
            L[i] = -sp;
            if (MASK) { const int kv = kb + 8 * a + 4 * hi + i; if (!(kv < lim)) { L[i] = 0.f; s[i] = -INFINITY; } } }
        const float l23 = L[2] + L[3], l123 = L[1] + l23;
        pp[a >> 2][4 * (a & 3) + 3] = s[3] + L[3];
        pp[a >> 2][4 * (a & 3) + 2] = s[2] + l23;
        pp[a >> 2][4 * (a & 3) + 1] = s[1] + l123;
        pp[a >> 2][4 * (a & 3) + 0] = s[0] + (L[0] + l123);
        gs[a] = L[0] + l123;
        if (a & 1) __builtin_amdgcn_sched_barrier(0);
    }
    float base[8];
    {
        float ev[8], od[8];
#pragma unroll
        for (int a = 0; a < 8; ++a) { const unsigned own = __float_as_uint(gs[a]); auto rr = __builtin_amdgcn_permlane32_swap(own, own, false, false);
            const float other = __uint_as_float(rr[0] == own ? rr[1] : rr[0]);
            ev[a] = hi ? other : gs[a]; od[a] = hi ? gs[a] : other; }
        float run = R;
#pragma unroll
        for (int a = 7; a >= 0; --a) { const float b_od = run; run += od[a]; const float b_ev = run; run += ev[a]; base[a] = hi ? b_od : b_ev; }
        R = run;
    }
#pragma unroll
    for (int a = 0; a < 8; ++a)
#pragma unroll
        for (int i = 0; i < 4; ++i) pp[a >> 2][4 * (a & 3) + i] = fexp2(pp[a >> 2][4 * (a & 3) + i] + base[a]);
}

__device__ __forceinline__ void phase_sb_fast(const Params& p, LAS unsigned char* lds) {
    unsigned char* ws = p.ws; const int lane = threadIdx.x & 63, wave = __builtin_amdgcn_readfirstlane(threadIdx.x >> 6), r32 = lane & 31, hi = lane >> 5;
    const int gw = blockIdx.x * 8 + wave, NGW = gridDim.x * 8;
    const bf16_t* PROJ = (const bf16_t*)(ws + WS_PROJ); const bf16_t* VT = (const bf16_t*)(ws + WS_VT); bf16_t* YMIX = (bf16_t*)(ws + WS_YMIX);
    LAS unsigned char* kl = lds + wave * SB_LDS_WAVE; LAS unsigned char* vl = kl + 64 * SB_KROW;
    const int srow = lane >> 3, sch = lane & 7;
    for (int it = gw; it < NB * NHEAD * (SEQ / 32); it += NGW) {
        const int bh = it >> 6, qb = it & 63, b = bh >> 3, h = bh & 7, r0 = qb * 32;
        const bf16_t* Kg = PROJ + (size_t)(b * SEQ) * NPROJ + C_K + h * 64;
        const bf16_t* Vg = VT + (size_t)(h * 64) * NTOK + b * SEQ;
        bf16x8 qf[4];
        { const bf16_t* qp = PROJ + (size_t)(b * SEQ + r0 + r32) * NPROJ + C_Q + h * 64 + 8 * hi;
#pragma unroll
          for (int d0 = 0; d0 < 4; ++d0) qf[d0] = *(const bf16x8*)(qp + 16 * d0); }
        f32x16 o[2];
#pragma unroll
        for (int r = 0; r < 16; ++r) { o[0][r] = 0.f; o[1][r] = 0.f; }
        float R = 0.f;
        int kb = r0 - 32, upper = 0x7fffffff;
        if (kb < 0) kb = 0;
        u32x4 kst[8], vst[8];
        const unsigned koff = (unsigned)(srow * NPROJ + 8 * sch) * 2u, voff = (unsigned)(srow * NTOK + 8 * sch) * 2u;
#define SB_LOADT(kbx) do { const char* kt_ = (const char*)(Kg + (size_t)(kbx) * NPROJ); const char* vt_ = (const char*)(Vg + (kbx)); \
            _Pragma("unroll") for (int i = 0; i < 8; ++i) { kst[i] = *(const u32x4*)(kt_ + (size_t)i * (8 * NPROJ * 2) + koff); vst[i] = *(const u32x4*)(vt_ + (size_t)i * (8 * NTOK * 2) + voff); } } while (0)
#define SB_WRITET() do { _Pragma("unroll") for (int i = 0; i < 8; ++i) { *(LAS u32x4*)(kl + (srow + 8 * i) * SB_KROW + 16 * sch) = kst[i]; \
            *(LAS u32x2*)(vl + (srow + 8 * i) * SB_VROW + 16 * sch) = (u32x2){vst[i].x, vst[i].y}; *(LAS u32x2*)(vl + (srow + 8 * i) * SB_VROW + 16 * sch + 8) = (u32x2){vst[i].z, vst[i].w}; } } while (0)
        SB_LOADT(kb); SB_WRITET();
        for (int j = 0;; ++j) {
            const bool more = kb > 0; const int kbn = kb >= 64 ? kb - 64 : 0;
            f32x16 pp[2];
#pragma unroll
            for (int r = 0; r < 16; ++r) { pp[0][r] = 0.f; pp[1][r] = 0.f; }
#pragma unroll
            for (int half = 0; half < 2; ++half)
#pragma unroll
                for (int d0 = 0; d0 < 4; ++d0) { const bf16x8 kf = *(const LAS bf16x8*)(kl + (32 * half + r32) * SB_KROW + 32 * d0 + 16 * hi); pp[half] = MFMA32(kf, qf[d0], pp[half]); }
            __builtin_amdgcn_sched_barrier(0);
            { const int trow = r0 + r32, lim = trow < upper ? trow : upper;
              if (j == 0 || kb + 64 > upper) sb_scan<true>(pp, R, kb, lim, hi); else sb_scan<false>(pp, R, kb, lim, hi); }
            __builtin_amdgcn_sched_barrier(0);
#pragma unroll
            for (int ks = 0; ks < 4; ++ks) { u32x4 pw;
                pw.x = mm::cvt_pk_bf16(pp[ks >> 1][8 * (ks & 1) + 0], pp[ks >> 1][8 * (ks & 1) + 1]); pw.y = mm::cvt_pk_bf16(pp[ks >> 1][8 * (ks & 1) + 2], pp[ks >> 1][8 * (ks & 1) + 3]);
                pw.z = mm::cvt_pk_bf16(pp[ks >> 1][8 * (ks & 1) + 4], pp[ks >> 1][8 * (ks & 1) + 5]); pw.w = mm::cvt_pk_bf16(pp[ks >> 1][8 * (ks & 1) + 6], pp[ks >> 1][8 * (ks & 1) + 7]);
#pragma unroll
                for (int dh = 0; dh < 2; ++dh) { const LAS unsigned char* vp = vl + (32 * dh + r32) * SB_VROW + 32 * ks + 8 * hi;
                    const u32x2 lo = *(const LAS u32x2*)vp, hh = *(const LAS u32x2*)(vp + 16); const u32x4 vf = {lo.x, lo.y, hh.x, hh.y};
                    o[dh] = MFMA32(__builtin_bit_cast(bf16x8, pw), __builtin_bit_cast(bf16x8, vf), o[dh]); } }
            if (!more || __all(R < SB_EXIT)) break;
            SB_LOADT(kbn); SB_WRITET(); upper = kb; kb = kbn;
        }
#undef SB_LOADT
#undef SB_WRITET
        const float g0 = p.gn_sb[h * 64 + r32], g1 = p.gn_sb[h * 64 + 32 + r32];
        bf16_t* yp = YMIX + (size_t)(b * SEQ + r0) * DM + 512 + h * 64 + r32;
#pragma unroll
        for (int r = 0; r < 16; ++r) { float ss = o[0][r] * o[0][r] + o[1][r] * o[1][r];
#pragma unroll
            for (int off = 1; off < 32; off <<= 1) ss += __shfl_xor(ss, off);
            const float rn = 1.0f / sqrtf(ss * (1.f / 64.f) + RMS_EPS); const int q = (r & 3) + 8 * (r >> 2) + 4 * hi;
            yp[(size_t)q * DM] = f2bf(o[0][r] * rn * g0); yp[(size_t)q * DM + 32] = f2bf(o[1][r] * rn * g1); }
    }
}
__device__ __forceinline__ void phase_conv_fast(const Params& p) {
    unsigned char* ws = p.ws; const int lane = threadIdx.x & 63, wave = threadIdx.x >> 6; const int gw = blockIdx.x * 8 + wave, NGW = gridDim.x * 8;
    const bf16_t* PROJ = (const bf16_t*)(ws + WS_PROJ); bf16_t* YMIX = (bf16_t*)(ws + WS_YMIX);
    const int c0 = 8 * lane;
    float w0[8], w1[8], w2[8], gn[8];
#pragma unroll
    for (int e = 0; e < 8; ++e) { w0[e] = p.conv_w[c0 + e]; w1[e] = p.conv_w[512 + c0 + e]; w2[e] = p.conv_w[1024 + c0 + e]; gn[e] = p.gn_conv[c0 + e]; }
    constexpr int TCH = 16;
    for (int it = gw; it < NTOK / TCH; it += NGW) {
        const int tok0 = it * TCH, t0 = tok0 % SEQ;
        float um2[8], um1[8];
#pragma unroll
        for (int e = 0; e < 8; ++e) { um2[e] = 0.f; um1[e] = 0.f; }
        if (t0 >= 2) {
            const u32x4 a2 = *(const u32x4*)(PROJ + (size_t)(tok0 - 2) * NPROJ + C_CC + c0), h2 = *(const u32x4*)(PROJ + (size_t)(tok0 - 2) * NPROJ + C_CH + c0);
            const u32x4 a1 = *(const u32x4*)(PROJ + (size_t)(tok0 - 1) * NPROJ + C_CC + c0), h1 = *(const u32x4*)(PROJ + (size_t)(tok0 - 1) * NPROJ + C_CH + c0);
            const f32x4 a2l = unpack_lo(a2), a2h = unpack_hi(a2), h2l = unpack_lo(h2), h2h = unpack_hi(h2), a1l = unpack_lo(a1), a1h = unpack_hi(a1), h1l = unpack_lo(h1), h1h = unpack_hi(h1);
#pragma unroll
            for (int e = 0; e < 4; ++e) { um2[e] = a2l[e] * h2l[e]; um2[4 + e] = a2h[e] * h2h[e]; um1[e] = a1l[e] * h1l[e]; um1[4 + e] = a1h[e] * h1h[e]; }
        }
#pragma unroll 4
        for (int i = 0; i < TCH; ++i) {
            const bf16_t* row = PROJ + (size_t)(tok0 + i) * NPROJ + c0;
            const u32x4 bw = *(const u32x4*)(row + C_CB), cw = *(const u32x4*)(row + C_CC), hw = *(const u32x4*)(row + C_CH);
            const f32x4 bl = unpack_lo(bw), bh_ = unpack_hi(bw), cl = unpack_lo(cw), ch_ = unpack_hi(cw), hl = unpack_lo(hw), hh = unpack_hi(hw);
            float y[8], ss = 0.f;
#pragma unroll
            for (int e = 0; e < 8; ++e) { const float u = (e < 4 ? cl[e & 3] * hl[e & 3] : ch_[e & 3] * hh[e & 3]); const float bb = e < 4 ? bl[e & 3] : bh_[e & 3];
                y[e] = bb * (w0[e] * um2[e] + w1[e] * um1[e] + w2[e] * u); um2[e] = um1[e]; um1[e] = u; ss += y[e] * y[e]; }
            ss += __shfl_xor(ss, 1); ss += __shfl_xor(ss, 2); ss += __shfl_xor(ss, 4);
            const float rn = 1.0f / sqrtf(ss * (1.f / 64.f) + RMS_EPS);
            f32x4 ol, oh;
#pragma unroll
            for (int e = 0; e < 4; ++e) { ol[e] = y[e] * rn * gn[e]; oh[e] = y[4 + e] * rn * gn[4 + e]; }
            *(u32x4*)(YMIX + (size_t)(tok0 + i) * DM + c0) = pack8(ol, oh);
        }
    }
}

constexpr int XA_KROW = 80, XA_VROW = 520, XA_KBUF = 256 * XA_KROW  , XA_VBUF = 32 * XA_VROW  ;
__device__ __forceinline__ void phase_xattn_fast(const Params& p, LAS unsigned char* lds) {
    unsigned char* ws = p.ws; const int tid = threadIdx.x, lane = tid & 63, wave = __builtin_amdgcn_readfirstlane(tid >> 6), r32 = lane & 31, hi = lane >> 5;
    const bf16_t* QM = (const bf16_t*)(ws + WS_QM); const bf16_t* MK = (const bf16_t*)(ws + WS_MEMK); const bf16_t* MVT = (const bf16_t*)(ws + WS_MEMVT); bf16_t* OB = (bf16_t*)(ws + WS_OB);
    const int G = gridDim.x, vcu = (G % 8 == 0) ? ((int)blockIdx.x % 8) * (G / 8) + (int)blockIdx.x / 8 : (int)blockIdx.x;
    for (int U = vcu; U < NB * MH * 8; U += G) {
        const int bm = U >> 3, qblk = U & 7, b = bm >> 2, mh = bm & 3, q0 = qblk * 256 + wave * 32;
        const bf16_t* Kg = MK + (size_t)(b * MEML) * DM + mh * MHD;
        const bf16_t* Vg = MVT + (size_t)(mh * MHD) * NMEM + b * MEML;
        const bf16_t* qp = QM + (size_t)(b * SEQ + q0 + r32) * DM + mh * MHD + 8 * hi;
        u32x4 st[2];
        f32x16 s[8];
#pragma unroll
        for (int kt = 0; kt < 8; ++kt)
#pragma unroll
            for (int r = 0; r < 16; ++r) s[kt][r] = 0.f;
#define XA_LOADK(sig) do { _Pragma("unroll") for (int i = 0; i < 2; ++i) { const int c = tid + 512 * i; st[i] = *(const u32x4*)(Kg + (size_t)(c >> 2) * DM + 32 * (sig) + 8 * (c & 3)); } } while (0)
#define XA_WRITEK(buf) do { _Pragma("unroll") for (int i = 0; i < 2; ++i) { const int c = tid + 512 * i; *(LAS u32x4*)(lds + (buf) * XA_KBUF + (c >> 2) * XA_KROW + 16 * (c & 3)) = st[i]; } } while (0)
#define XA_LOADV(dt) do { _Pragma("unroll") for (int i = 0; i < 2; ++i) { const int c = tid + 512 * i; st[i] = *(const u32x4*)(Vg + (size_t)(32 * (dt) + (c >> 5)) * NMEM + 8 * (c & 31)); } } while (0)
#define XA_WRITEV(buf) do { _Pragma("unroll") for (int i = 0; i < 2; ++i) { const int c = tid + 512 * i; LAS unsigned char* d_ = lds + (buf) * XA_KBUF + (c >> 5) * XA_VROW + 16 * (c & 31); \
            *(LAS u32x2*)d_ = (u32x2){st[i].x, st[i].y}; *(LAS u32x2*)(d_ + 8) = (u32x2){st[i].z, st[i].w}; } } while (0)
        XA_LOADK(0); XA_WRITEK(0);
        __syncthreads();
#pragma unroll 1
        for (int sig = 0; sig < 8; ++sig) {
            if (sig < 7) XA_LOADK(sig + 1);
            bf16x8 qf[2];
#pragma unroll
            for (int sk = 0; sk < 2; ++sk) qf[sk] = *(const bf16x8*)(qp + 32 * sig + 16 * sk);
            const LAS unsigned char* kb_ = lds + (sig & 1) * XA_KBUF + r32 * XA_KROW + 16 * hi;
#pragma unroll
            for (int kt = 0; kt < 8; ++kt)
#pragma unroll
                for (int sk = 0; sk < 2; ++sk) { const bf16x8 kf = *(const LAS bf16x8*)(kb_ + kt * 32 * XA_KROW + 32 * sk); s[kt] = MFMA32(kf, qf[sk], s[kt]); }
            if (sig < 7) XA_WRITEK((sig + 1) & 1);
            __syncthreads();
        }
        XA_LOADV(0);
        float mx = s[0][0];
#pragma unroll
        for (int kt = 0; kt < 8; ++kt)
#pragma unroll
            for (int r = 0; r < 16; ++r) mx = fmaxf(mx, s[kt][r]);
        mx = fmaxf(mx, __shfl_xor(mx, 32));
        float sum = 0.f;
#pragma unroll
        for (int kt = 0; kt < 8; ++kt)
#pragma unroll
            for (int r = 0; r < 16; ++r) { s[kt][r] = __builtin_amdgcn_exp2f(s[kt][r] - mx); sum += s[kt][r]; }
        sum += __shfl_xor(sum, 32);
        const float inv = 1.0f / sum;
        u32x4 pw[16];
#pragma unroll
        for (int ks = 0; ks < 16; ++ks) { const int kt = ks >> 1, r0_ = 8 * (ks & 1);
            pw[ks].x = mm::cvt_pk_bf16(s[kt][r0_ + 0] * inv, s[kt][r0_ + 1] * inv); pw[ks].y = mm::cvt_pk_bf16(s[kt][r0_ + 2] * inv, s[kt][r0_ + 3] * inv);
            pw[ks].z = mm::cvt_pk_bf16(s[kt][r0_ + 4] * inv, s[kt][r0_ + 5] * inv); pw[ks].w = mm::cvt_pk_bf16(s[kt][r0_ + 6] * inv, s[kt][r0_ + 7] * inv); }
        XA_WRITEV(0);
        __syncthreads();
        bf16_t* op = OB + (size_t)(b * SEQ + q0) * DM + mh * MHD + r32;
#pragma unroll 1
        for (int dt = 0; dt < 8; ++dt) {
            if (dt < 7) XA_LOADV(dt + 1);
            f32x16 o;
#pragma unroll
            for (int r = 0; r < 16; ++r) o[r] = 0.f;
            const LAS unsigned char* vb_ = lds + (dt & 1) * XA_KBUF + r32 * XA_VROW + 8 * hi;
#pragma unroll
            for (int ks = 0; ks < 16; ++ks) { const u32x2 lo = *(const LAS u32x2*)(vb_ + 32 * ks), hh = *(const LAS u32x2*)(vb_ + 32 * ks + 16); const u32x4 vf = {lo.x, lo.y, hh.x, hh.y};
                o = MFMA32(__builtin_bit_cast(bf16x8, pw[ks]), __builtin_bit_cast(bf16x8, vf), o); }
#pragma unroll
            for (int r = 0; r < 16; ++r) { const int q = (r & 3) + 8 * (r >> 2) + 4 * hi; op[(size_t)q * DM + 32 * dt] = f2bf(o[r]); }
            if (dt < 7) XA_WRITEV((dt + 1) & 1);
            __syncthreads();
        }
#undef XA_LOADK
#undef XA_WRITEK
#undef XA_LOADV
#undef XA_WRITEV
    }
}

__global__ void __launch_bounds__(512, 2) fwd_kernel(Params p) {
    extern __shared__ __attribute__((aligned(16))) unsigned char lds[];
    cg::grid_group grid = cg::this_grid();
#ifndef ONLY
#define ONLY -1
#endif
#ifdef PMASK
#define RUNP(k) ((PMASK >> (k)) & 1)
#else
#define RUNP(k) (ONLY < 0 || ONLY == (k))
#endif
    const int lo = p.ph_lo, hi = p.ph_hi;
    LAS unsigned char* l3 = (LAS unsigned char*)lds;
#ifndef FASTMASK
#define FASTMASK 0x6FE
#endif
#define FAST(k) ((FASTMASK >> (k)) & 1)
#define IN(k) (RUNP(k) && lo <= (k) && (k) < hi)
#define SEAM(k) do { if (lo <= (k) && (k) + 1 < hi) grid.sync(); } while (0)
    if (IN(0)) { phase_prep(p, lds); } SEAM(0);
    if (IN(1)) { if (FAST(1)) phase_proj_fast(p, l3); else phase_proj_simple(p); } SEAM(1);
    if (IN(2)) { if (FAST(2)) { phase_conv_fast(p); phase_sb_fast(p, l3); } else { phase_conv_simple(p); phase_sb_simple(p); } } SEAM(2);
    if (IN(3)) { if (FAST(3)) phase_outproj_fast(p, l3); else phase_outproj_simple(p); } SEAM(3);
    if (IN(4)) { if (FAST(4)) phase_mq_fast(p, l3); else phase_mq_simple(p); } SEAM(4);
    if (IN(5)) { if (FAST(5)) phase_xattn_fast(p, l3); else phase_xattn_simple(p, lds); } SEAM(5);
    if (IN(6)) { if (FAST(6)) phase_mo_fast(p, l3); else phase_mo_simple(p); } SEAM(6);
    if (IN(7)) { if (FAST(7)) phase_router_fast(p, l3); else phase_router_simple(p); } SEAM(7);
    if (IN(8)) { phase_route(p); } SEAM(8);
    if (IN(9)) { if (FAST(9)) phase_moe1_fast(p, l3); else phase_moe1_simple(p); } SEAM(9);
    if (IN(10)) { if (FAST(10)) phase_moe2_fast(p, l3); else phase_moe2_simple(p); } SEAM(10);
    if (IN(11)) { phase_final(p); }
}

extern "C" void kernel_launch(void* const* d_in, const int* in_sizes, int n_in, void* d_out, int out_size, void* d_ws, size_t ws_size, hipStream_t stream) {
    static int grid = 0;
    if (grid == 0) {
        if (n_in != 24 || out_size != NTOK * DM || ws_size < WS_END) { fprintf(stderr, "kernel_launch: unexpected problem: n_in %d out %d ws %zu\n", n_in, out_size, ws_size); grid = -1; return; }
        int dev = 0, cus = 0, per_cu = 0;
        (void)hipGetDevice(&dev); (void)hipDeviceGetAttribute(&cus, hipDeviceAttributeMultiprocessorCount, dev);
        (void)hipFuncSetAttribute((const void*)fwd_kernel, hipFuncAttributeMaxDynamicSharedMemorySize, LDS_BYTES);
        (void)hipOccupancyMaxActiveBlocksPerMultiprocessor(&per_cu, (const void*)fwd_kernel, 512, LDS_BYTES);
        if (per_cu < 1) { fprintf(stderr, "kernel_launch: occupancy query reports %d blocks per CU\n", per_cu); }
        grid = cus;
    }
    if (grid < 0) return;
    Params p{};
    const float** f = (const float**)&p;
    for (int i = 0; i < 24; ++i) f[i] = (const float*)d_in[i];
    p.out = (float*)d_out; p.ws = (unsigned char*)d_ws;
#if MK_ONE_LAUNCH
    p.ph_lo = 0; p.ph_hi = NPHASE;
    void* args[] = {&p};
    hipError_t e = hipLaunchCooperativeKernel((void*)fwd_kernel, dim3(grid), dim3(512), args, LDS_BYTES, stream);
    if (e != hipSuccess) fprintf(stderr, "cooperative launch failed: %s\n", hipGetErrorString(e));
#else
    for (int ph = 0; ph < NPHASE; ++ph) {
        p.ph_lo = ph; p.ph_hi = ph + 1;
        void* args[] = {&p};
        hipError_t e = hipLaunchCooperativeKernel((void*)fwd_kernel, dim3(grid), dim3(512), args, LDS_BYTES, stream);
        if (e != hipSuccess) { fprintf(stderr, "launch %d failed: %s\n", ph, hipGetErrorString(e)); break; }
    }
#endif
}
```

```cpp
#include <hip/hip_runtime.h>
#include <hip/hip_cooperative_groups.h>
#include <cstdio>
#include <cstdint>
namespace cg = cooperative_groups;

#ifndef MK_ONE_LAUNCH
#define MK_ONE_LAUNCH 1
#endif

typedef unsigned short bf16_t;
typedef short bf16x8 __attribute__((ext_vector_type(8)));
typedef float f32x4 __attribute__((ext_vector_type(4)));
typedef float f32x16 __attribute__((ext_vector_type(16)));
typedef unsigned u32x4 __attribute__((ext_vector_type(4)));
typedef unsigned u32x2 __attribute__((ext_vector_type(2)));

constexpr int NB = 32, SEQ = 2048, DM = 1024, NTOK = NB * SEQ;
constexpr int MEML = 256, NMEM = NB * MEML;
constexpr int NPROJ = 2560;
constexpr int PW = 3072;
constexpr int C_CB = 0, C_CC = 512, C_CH = 1024, C_Q = 1536, C_K = 2048, C_V = 2560;
constexpr int NHEAD = 8, HD = 64;
constexpr int MH = 4, MHD = 256;
constexpr int NEXP = 32, DEXP = 512, NLOG = 36, NLOGP = 64;
constexpr int CAP = 2 * NTOK;
constexpr float ALPHA = 1.189207115002721f;
constexpr float LN_EPS = 1e-5f, RMS_EPS = 1e-6f;
constexpr float LOG2E = 1.4426950408889634f;
constexpr float QS_SB = 0.125f * LOG2E;
constexpr float QS_X = 0.0625f * LOG2E;

constexpr size_t MiB = 1u << 20;
constexpr size_t WS_STATS1 = 0;
constexpr size_t WS_STATS2 = 1 * MiB;
constexpr size_t WS_CNT = 2 * MiB;
constexpr size_t WS_CS1 = 2 * MiB + 4096;
constexpr size_t WS_CS2 = WS_CS1 + 8192;
constexpr size_t WS_CSGU = 3 * MiB;
constexpr size_t WS_EID = 4 * MiB;
constexpr size_t WS_POSI = 4 * MiB + 512 * 1024;
constexpr size_t WS_GATE = 5 * MiB;
constexpr size_t WS_CSI = 6 * MiB;
constexpr size_t WS_ZERO_BYTES = 8 * MiB;
constexpr size_t WS_LOGIT = 8 * MiB;
constexpr size_t WS_ROWL = 24 * MiB;
constexpr size_t WS_WRT = 40 * MiB;
constexpr size_t WS_WIN = 64 * MiB;
constexpr size_t WS_WOUT = 70 * MiB;
constexpr size_t WS_WMQ = 72 * MiB, WS_WMK = 74 * MiB, WS_WMV = 76 * MiB, WS_WMO = 78 * MiB;
constexpr size_t WS_WGU = 80 * MiB;
constexpr size_t WS_WD = 144 * MiB;
constexpr size_t WS_XB = 192 * MiB;
constexpr size_t WS_T1B = 192 * MiB;
constexpr size_t WS_MEMB = 320 * MiB;
constexpr size_t WS_MEMK = 336 * MiB;
constexpr size_t WS_MEMVT = 352 * MiB;
constexpr size_t WS_PROJ = 370 * MiB;
constexpr size_t WS_QM = 370 * MiB;
constexpr size_t WS_OB = 498 * MiB;
constexpr size_t WS_Y = 370 * MiB;
constexpr size_t WS_VT = 690 * MiB;
constexpr size_t WS_YMIX = 755 * MiB;
constexpr size_t WS_T2B = 755 * MiB;
constexpr size_t WS_H = 883 * MiB;
constexpr size_t WS_END = 1019 * MiB;
constexpr int VT_LD = NTOK + 64, MVT_LD = NMEM + 64;

constexpr int LDS_BYTES = 147456;
constexpr int NPHASE = 12;

struct Params {
    const float *x, *mem, *w_in, *conv_w, *gn_conv, *gn_sb, *w_out, *ln1_g, *ln1_b, *w_mq, *w_mk, *w_mv, *w_mo, *ln2_g, *ln2_b,
        *w_rg, *b_rg, *w_re, *b_re, *w_gate, *w_up, *w_down, *ln3_g, *ln3_b;
    float* out; unsigned char* ws; int ph_lo, ph_hi;
};

#define LAS __attribute__((address_space(3)))
__device__ __forceinline__ float bf2f(bf16_t v) { return __uint_as_float((unsigned)v << 16); }
__device__ __forceinline__ bf16_t f2bf(float f) { unsigned u = __float_as_uint(f); return (bf16_t)((u + 0x7fffu + ((u >> 16) & 1u)) >> 16); }
__device__ __forceinline__ unsigned pk2(float lo, float hi) { return (unsigned)f2bf(lo) | ((unsigned)f2bf(hi) << 16); }
__device__ __forceinline__ float wave_sum(float v) {
#pragma unroll
    for (int o = 1; o < 64; o <<= 1) v += __shfl_xor(v, o);
    return v;
}
__device__ __forceinline__ float wave_max(float v) {
#pragma unroll
    for (int o = 1; o < 64; o <<= 1) v = fmaxf(v, __shfl_xor(v, o));
    return v;
}
__device__ __forceinline__ f32x4 unpack_lo(const u32x4 w) { return (f32x4){__uint_as_float(w.x << 16), __uint_as_float(w.x & 0xffff0000u), __uint_as_float(w.y << 16), __uint_as_float(w.y & 0xffff0000u)}; }
__device__ __forceinline__ f32x4 unpack_hi(const u32x4 w) { return (f32x4){__uint_as_float(w.z << 16), __uint_as_float(w.z & 0xffff0000u), __uint_as_float(w.w << 16), __uint_as_float(w.w & 0xffff0000u)}; }
__device__ __forceinline__ float sum4(const f32x4 v) { return (v[0] + v[1]) + (v[2] + v[3]); }
__device__ __forceinline__ float sq4(const f32x4 v) { return (v[0] * v[0] + v[1] * v[1]) + (v[2] * v[2] + v[3] * v[3]); }
#define MFMA32(a, b, c) __builtin_amdgcn_mfma_f32_32x32x16_bf16((a), (b), (c), 0, 0, 0)

template <int NBLK, class AR, class BR>
__device__ __forceinline__ void wave_tile(int K, AR arow, BR brow, f32x16 (&c)[2][2 * NBLK]) {
    const int lane = threadIdx.x & 63, r = lane & 31, h = lane >> 5;
    const bf16_t* ap[2]; const bf16_t* bp[2 * NBLK];
#pragma unroll
    for (int i = 0; i < 2; ++i) ap[i] = arow(32 * i + r) + 8 * h;
#pragma unroll
    for (int j = 0; j < 2 * NBLK; ++j) bp[j] = brow(32 * j + r) + 8 * h;
#pragma unroll
    for (int i = 0; i < 2; ++i)
#pragma unroll
        for (int j = 0; j < 2 * NBLK; ++j)
#pragma unroll
            for (int q = 0; q < 16; ++q) c[i][j][q] = 0.f;
#pragma unroll 2
    for (int k = 0; k < K; k += 16) {
        bf16x8 fa[2], fb[2 * NBLK];
#pragma unroll
        for (int i = 0; i < 2; ++i) fa[i] = *(const bf16x8*)(ap[i] + k);
#pragma unroll
        for (int j = 0; j < 2 * NBLK; ++j) fb[j] = *(const bf16x8*)(bp[j] + k);
#pragma unroll
        for (int i = 0; i < 2; ++i)
#pragma unroll
            for (int j = 0; j < 2 * NBLK; ++j) c[i][j] = MFMA32(fa[i], fb[j], c[i][j]);
    }
}
#define TROW(i, q) (32 * (i) + ((q) & 3) + 8 * ((q) >> 2) + 4 * ((int)(threadIdx.x & 63) >> 5))
#define TCOL(j) (32 * (j) + (int)(threadIdx.x & 31))

struct RowStat { float mean, rstd; };
typedef long long stat_t;
constexpr float STAT_SCALE = 16777216.0f, STAT_INV = 1.0f / 16777216.0f;
__device__ __forceinline__ void stat_add(stat_t* st, int row, float s, float q) {
    atomicAdd((unsigned long long*)st + 2 * row, (unsigned long long)__float2ll_rn(s * STAT_SCALE)); atomicAdd((unsigned long long*)st + 2 * row + 1, (unsigned long long)__float2ll_rn(q * STAT_SCALE)); }
__device__ __forceinline__ RowStat row_stat(const stat_t* st, int row) {
    const float s = (float)st[2 * row] * STAT_INV, q = (float)st[2 * row + 1] * STAT_INV;
    RowStat r; r.mean = s * (1.f / DM); const float var = fmaxf(q * (1.f / DM) - r.mean * r.mean, 0.f); r.rstd = __builtin_amdgcn_rsqf(var + LN_EPS); return r;
}

constexpr float CS_SCALE = 4294967296.0f, CS_INV = 1.0f / 4294967296.0f;
__device__ __forceinline__ void transpose_item(const float* W, int K, int N, int k0, int n0, bf16_t* WT, int orow0, const float* ks, float ns, const float* bvec, stat_t* csum, stat_t* bsum, int oidx0,
                                               LAS float* scr, int lane) {
    const int rq = lane >> 4, c4 = (lane & 15) * 4;
    f32x4 cs = {0.f, 0.f, 0.f, 0.f}, bs = {0.f, 0.f, 0.f, 0.f};
    f32x4 wv[16];
#pragma unroll
    for (int i = 0; i < 16; ++i) wv[i] = __builtin_nontemporal_load((const f32x4*)(W + (size_t)(k0 + 4 * i + rq) * N + n0 + c4));
#pragma unroll
    for (int i = 0; i < 16; ++i) { const int kk = 4 * i + rq; f32x4 v = wv[i];
        if (csum) { const float bk = bvec[k0 + kk] * ns; bs += v * bk; }
        if (ks) v = v * ks[k0 + kk];
        v = v * ns;
        if (csum) { cs[0] += bf2f(f2bf(v[0])); cs[1] += bf2f(f2bf(v[1])); cs[2] += bf2f(f2bf(v[2])); cs[3] += bf2f(f2bf(v[3])); }
        LAS float* d = scr + kk * 65 + c4; d[0] = v[0]; d[1] = v[1]; d[2] = v[2]; d[3] = v[3]; }
    if (csum) {
#pragma unroll
        for (int e = 0; e < 4; ++e) { cs[e] += __shfl_xor(cs[e], 16); cs[e] += __shfl_xor(cs[e], 32); bs[e] += __shfl_xor(bs[e], 16); bs[e] += __shfl_xor(bs[e], 32); }
        if (rq == 0) {
#pragma unroll
            for (int e = 0; e < 4; ++e) { atomicAdd((unsigned long long*)csum + oidx0 + c4 + e, (unsigned long long)__float2ll_rn(cs[e] * CS_SCALE)); atomicAdd((unsigned long long*)bsum + oidx0 + c4 + e, (unsigned long long)__float2ll_rn(bs[e] * CS_SCALE)); } }
    }
    asm volatile("s_waitcnt lgkmcnt(0)" ::: "memory");
    const int c = lane & 7;
#pragma unroll
    for (int j = 0; j < 8; ++j) { const int n = (lane >> 3) + 8 * j; const LAS float* sp = scr + (8 * c) * 65 + n;
        u32x4 o; o.x = pk2(sp[0 * 65], sp[1 * 65]); o.y = pk2(sp[2 * 65], sp[3 * 65]); o.z = pk2(sp[4 * 65], sp[5 * 65]); o.w = pk2(sp[6 * 65], sp[7 * 65]);
        *(u32x4*)(WT + (size_t)(orow0 + n) * K + k0 + 8 * c) = o; }
    asm volatile("s_waitcnt lgkmcnt(0)" ::: "memory");
}
__device__ void phase_prep(const Params& p, unsigned char* lds) {
    unsigned char* ws = p.ws;
    const int tid = threadIdx.x, lane = tid & 63, wave = tid >> 6;
    const int gw = blockIdx.x * 8 + wave, NGW = gridDim.x * 8;
    const int gt = blockIdx.x * 512 + tid, NGT = gridDim.x * 512;
    LAS float* scr = (LAS float*)((LAS unsigned char*)lds + wave * 16640);
    bf16_t* WIN = (bf16_t*)(ws + WS_WIN); bf16_t* WOUT = (bf16_t*)(ws + WS_WOUT); bf16_t* WMQ = (bf16_t*)(ws + WS_WMQ); bf16_t* WMK = (bf16_t*)(ws + WS_WMK);
    bf16_t* WMV = (bf16_t*)(ws + WS_WMV); bf16_t* WMO = (bf16_t*)(ws + WS_WMO); bf16_t* WGU = (bf16_t*)(ws + WS_WGU); bf16_t* WD = (bf16_t*)(ws + WS_WD);
    stat_t* ci = (stat_t*)(ws + WS_CSI);
    { const f32x4* x4 = (const f32x4*)p.x; u32x4* xb4 = (u32x4*)(ws + WS_XB);
      constexpr int NX = NTOK * DM / 8;
      for (int i = gt; i < NX; i += 4 * NGT) { f32x4 v[8];
#pragma unroll
          for (int u = 0; u < 4; ++u) { const int j = i + u * NGT; if (j < NX) { v[2 * u] = __builtin_nontemporal_load(x4 + 2 * j); v[2 * u + 1] = __builtin_nontemporal_load(x4 + 2 * j + 1); } }
#pragma unroll
          for (int u = 0; u < 4; ++u) { const int j = i + u * NGT; if (j < NX) { u32x4 o; o.x = pk2(v[2 * u].x, v[2 * u].y); o.y = pk2(v[2 * u].z, v[2 * u].w); o.z = pk2(v[2 * u + 1].x, v[2 * u + 1].y); o.w = pk2(v[2 * u + 1].z, v[2 * u + 1].w); xb4[j] = o; } } }
      const f32x4* m4 = (const f32x4*)p.mem; u32x4* mb4 = (u32x4*)(ws + WS_MEMB);
      constexpr int NM = NMEM * DM / 8;
      for (int i = gt; i < NM; i += 4 * NGT) { f32x4 v[8];
#pragma unroll
          for (int u = 0; u < 4; ++u) { const int j = i + u * NGT; if (j < NM) { v[2 * u] = __builtin_nontemporal_load(m4 + 2 * j); v[2 * u + 1] = __builtin_nontemporal_load(m4 + 2 * j + 1); } }
#pragma unroll
          for (int u = 0; u < 4; ++u) { const int j = i + u * NGT; if (j < NM) { u32x4 o; o.x = pk2(v[2 * u].x, v[2 * u].y); o.y = pk2(v[2 * u].z, v[2 * u].w); o.z = pk2(v[2 * u + 1].x, v[2 * u + 1].y); o.w = pk2(v[2 * u + 1].z, v[2 * u + 1].w); mb4[j] = o; } } } }
    constexpr int I_IN = 16 * 48, I_SQ = 16 * 16, I_G = 32 * 16 * 8, I_D = 32 * 8 * 16;
    constexpr int NITEMS = I_IN + 5 * I_SQ + 2 * I_G + I_D;
    for (int it = gw; it < NITEMS; it += NGW) {
        int r = it;
        if (r < I_IN) { const int kb = r / 48, n0 = (r % 48) * 64; transpose_item(p.w_in, DM, PW, kb * 64, n0, WIN, n0, nullptr, (n0 >= C_Q && n0 < C_K) ? QS_SB : 1.f, nullptr, nullptr, nullptr, 0, scr, lane); continue; } r -= I_IN;
        if (r < I_SQ) { transpose_item(p.w_out, DM, DM, (r / 16) * 64, (r % 16) * 64, WOUT, (r % 16) * 64, nullptr, 1.f, nullptr, nullptr, nullptr, 0, scr, lane); continue; } r -= I_SQ;
        if (r < I_SQ) { transpose_item(p.w_mq, DM, DM, (r / 16) * 64, (r % 16) * 64, WMQ, (r % 16) * 64, p.ln1_g, QS_X, p.ln1_b, ci, ci + 1024, (r % 16) * 64, scr, lane); continue; } r -= I_SQ;
        if (r < I_SQ) { transpose_item(p.w_mk, DM, DM, (r / 16) * 64, (r % 16) * 64, WMK, (r % 16) * 64, nullptr, 1.f, nullptr, nullptr, nullptr, 0, scr, lane); continue; } r -= I_SQ;
        if (r < I_SQ) { transpose_item(p.w_mv, DM, DM, (r / 16) * 64, (r % 16) * 64, WMV, (r % 16) * 64, nullptr, 1.f, nullptr, nullptr, nullptr, 0, scr, lane); continue; } r -= I_SQ;
        if (r < I_SQ) { transpose_item(p.w_mo, DM, DM, (r / 16) * 64, (r % 16) * 64, WMO, (r % 16) * 64, nullptr, 1.f, nullptr, nullptr, nullptr, 0, scr, lane); continue; } r -= I_SQ;
        if (r < 2 * I_G) { const int up = r >= I_G; if (up) r -= I_G; const int e = r / 128, q = r % 128, kb = q / 8, n0 = (q % 8) * 64;
            const float* W = (up ? p.w_up : p.w_gate) + (size_t)e * DM * DEXP; const int orow0 = 256 * (n0 / 128) + (up ? 128 : 0) + (n0 % 128);
            transpose_item(W, DM, DEXP, kb * 64, n0, WGU + (size_t)e * 1024 * 1024, orow0, p.ln2_g, 1.f, p.ln2_b, ci + 2048, ci + 2048 + NEXP * 1024, e * 1024 + orow0 - (0), scr, lane); continue; } r -= 2 * I_G;
        { const int e = r / 128, q = r % 128, kb = q / 16, n0 = (q % 16) * 64; transpose_item(p.w_down + (size_t)e * DEXP * DM, DEXP, DM, kb * 64, n0, WD + (size_t)e * 1024 * 512, n0, nullptr, 1.f, nullptr, nullptr, nullptr, 0, scr, lane); }
    }
    { bf16_t* WRT = (bf16_t*)(ws + WS_WRT);
      for (int i = gt; i < 256 * DM; i += NGT) { const int n = i / DM, k = i % DM; float v = 0.f;
          if (n < 4) v = p.w_rg[k * 4 + n] * p.ln2_g[k]; else if (n < NLOG) v = p.w_re[k * 32 + (n - 4)] * p.ln2_g[k];
          WRT[i] = f2bf(v); }
      float* cs2 = (float*)(ws + WS_CS2); float* bs2 = cs2 + 64;
      for (int n = gw; n < 64; n += NGW) { float cs = 0.f, bs = 0.f;
          if (n < NLOG) { float wv[16];
#pragma unroll
              for (int i = 0; i < 16; ++i) { const int k = lane + 64 * i; wv[i] = n < 4 ? p.w_rg[k * 4 + n] : p.w_re[k * 32 + (n - 4)]; }
#pragma unroll
              for (int i = 0; i < 16; ++i) { const int k = lane + 64 * i; cs += bf2f(f2bf(wv[i] * p.ln2_g[k])); bs += p.ln2_b[k] * wv[i]; }
              cs = wave_sum(cs); bs = wave_sum(bs); bs += n < 4 ? p.b_rg[n] : p.b_re[n - 4]; }
          if (lane == 0) { cs2[n] = cs; bs2[n] = bs; } } }
}
__device__ __forceinline__ void finalize_colsums(const Params& p) {
    unsigned char* ws = p.ws; const int gt = blockIdx.x * 512 + threadIdx.x, NGT = gridDim.x * 512;
    const stat_t* ci = (const stat_t*)(ws + WS_CSI); float* cs1 = (float*)(ws + WS_CS1); float* csg = (float*)(ws + WS_CSGU);
    for (int i = gt; i < 2048 + 2 * NEXP * 1024; i += NGT) { const float v = (float)ci[i] * CS_INV; if (i < 2048) cs1[i] = v; else csg[i - 2048] = v; }
}

__device__ void phase_proj_simple(const Params& p) {
    unsigned char* ws = p.ws; const int wave = threadIdx.x >> 6; const int gw = blockIdx.x * 8 + wave, NGW = gridDim.x * 8;
    const bf16_t* XB = (const bf16_t*)(ws + WS_XB); const bf16_t* WIN = (const bf16_t*)(ws + WS_WIN); const bf16_t* MB = (const bf16_t*)(ws + WS_MEMB);
    const bf16_t* WMK = (const bf16_t*)(ws + WS_WMK); const bf16_t* WMV = (const bf16_t*)(ws + WS_WMV);
    bf16_t* PROJ = (bf16_t*)(ws + WS_PROJ); bf16_t* VT = (bf16_t*)(ws + WS_VT); bf16_t* MK = (bf16_t*)(ws + WS_MEMK); bf16_t* MVT = (bf16_t*)(ws + WS_MEMVT);
    constexpr int TA = (NTOK / 64) * (NPROJ / 64), TB = (512 / 64) * (NTOK / 64), TC = (NMEM / 64) * (DM / 64), TD = (DM / 64) * (NMEM / 64);
    for (int t = gw; t < TA + TB + TC + TD; t += NGW) {
        const bf16_t *A, *Bt; bf16_t* O; int ldo, tm, tn, r = t;
        if (r < TA) { A = XB; Bt = WIN; O = PROJ; ldo = NPROJ; tm = r / (NPROJ / 64); tn = r % (NPROJ / 64); }
        else if ((r -= TA) < TB) { A = WIN + (size_t)C_V * DM; Bt = XB; O = VT; ldo = VT_LD; tm = r / (NTOK / 64); tn = r % (NTOK / 64); }
        else if ((r -= TB) < TC) { A = MB; Bt = WMK; O = MK; ldo = DM; tm = r / (DM / 64); tn = r % (DM / 64); }
        else { r -= TC; A = WMV; Bt = MB; O = MVT; ldo = MVT_LD; tm = r / (NMEM / 64); tn = r % (NMEM / 64); }
        f32x16 c[2][2];
        wave_tile<1>(DM, [&](int i) { return A + (size_t)(tm * 64 + i) * DM; }, [&](int j) { return Bt + (size_t)(tn * 64 + j) * DM; }, c);
#pragma unroll
        for (int i = 0; i < 2; ++i)
#pragma unroll
            for (int j = 0; j < 2; ++j)
#pragma unroll
                for (int q = 0; q < 16; ++q) O[(size_t)(tm * 64 + TROW(i, q)) * ldo + tn * 64 + TCOL(j)] = f2bf(c[i][j][q]);
    }
}

__device__ void phase_conv_simple(const Params& p) {
    unsigned char* ws = p.ws; const int lane = threadIdx.x & 63, wave = threadIdx.x >> 6; const int gw = blockIdx.x * 8 + wave, NGW = gridDim.x * 8;
    const bf16_t* PROJ = (const bf16_t*)(ws + WS_PROJ); bf16_t* YMIX = (bf16_t*)(ws + WS_YMIX);
    for (int it = gw; it < NTOK * 8; it += NGW) {
        const int tok = it >> 3, g = it & 7, c = g * 64 + lane, t = tok % SEQ;
        float acc = 0.f;
#pragma unroll
        for (int k = 0; k < 3; ++k) { const int tt = t - 2 + k; if (tt >= 0) { const bf16_t* row = PROJ + (size_t)(tok - 2 + k) * NPROJ; acc += p.conv_w[k * 512 + c] * (bf2f(row[C_CC + c]) * bf2f(row[C_CH + c])); } }
        const float y = bf2f(PROJ[(size_t)tok * NPROJ + C_CB + c]) * acc;
        const float ms = wave_sum(y * y) * (1.f / 64.f);
        YMIX[(size_t)tok * DM + c] = f2bf(y * (1.0f / sqrtf(ms + RMS_EPS)) * p.gn_conv[c]);
    }
}
__device__ void phase_sb_simple(const Params& p) {
    unsigned char* ws = p.ws; const int lane = threadIdx.x & 63, wave = threadIdx.x >> 6; const int gw = blockIdx.x * 8 + wave, NGW = gridDim.x * 8;
    const bf16_t* PROJ = (const bf16_t*)(ws + WS_PROJ); const bf16_t* VT = (const bf16_t*)(ws + WS_VT); bf16_t* YMIX = (bf16_t*)(ws + WS_YMIX);
    for (int it = gw; it < NTOK * NHEAD; it += NGW) {
        const int tok = it / NHEAD, h = it % NHEAD, b = tok / SEQ, t = tok % SEQ;
        float q[64], o[64];
        { const bf16_t* qp = PROJ + (size_t)tok * NPROJ + C_Q + h * 64;
#pragma unroll
          for (int d = 0; d < 64; ++d) { q[d] = bf2f(qp[d]); o[d] = 0.f; } }
        float R = 0.f;
        for (int c0 = t - 1; c0 >= 0; c0 -= 64) {
            const int s = c0 - lane; const bool valid = s >= 0; const int sc = valid ? s : 0;
            const bf16_t* kp = PROJ + (size_t)(b * SEQ + sc) * NPROJ + C_K + h * 64;
            float dot = 0.f;
#pragma unroll
            for (int d8 = 0; d8 < 8; ++d8) { const bf16x8 kv = *(const bf16x8*)(kp + d8 * 8);
#pragma unroll
                for (int j = 0; j < 8; ++j) dot += q[d8 * 8 + j] * bf2f((bf16_t)kv[j]); }
            const float sp = fmaxf(dot, 0.f) + __log2f(1.0f + exp2f(-fabsf(dot)));
            const float L = valid ? -sp : 0.f;
            float incl = L;
#pragma unroll
            for (int off = 1; off < 64; off <<= 1) { const float n = __shfl_up(incl, off); if (lane >= off) incl += n; }
            const float w = valid ? exp2f(dot + L + (R + incl - L)) : 0.f;
            R += __shfl(incl, 63);
            const bf16_t* vp = VT + (size_t)(h * 64) * VT_LD + b * SEQ + sc;
#pragma unroll
            for (int d = 0; d < 64; ++d) o[d] += w * bf2f(vp[(size_t)d * VT_LD]);
        }
        float ss = 0.f, mine = 0.f;
#pragma unroll
        for (int d = 0; d < 64; ++d) { const float v = wave_sum(o[d]); ss += v * v; if (d == lane) mine = v; }
        YMIX[(size_t)tok * DM + 512 + h * 64 + lane] = f2bf(mine * (1.0f / sqrtf(ss * (1.f / 64.f) + RMS_EPS)) * p.gn_sb[h * 64 + lane]);
    }
}

template <bool STATS, class Epi>
__device__ __forceinline__ void gemm_simple(const bf16_t* A, const bf16_t* Bt, int M, int N, int K, stat_t* st, Epi epi) {
    const int wave = threadIdx.x >> 6, lane = threadIdx.x & 63; const int gw = blockIdx.x * 8 + wave, NGW = gridDim.x * 8;
    const int tn_n = N / 64, nt = (M / 64) * tn_n;
    for (int t = gw; t < nt; t += NGW) {
        const int tm = t / tn_n, tn = t % tn_n;
        f32x16 c[2][2];
        wave_tile<1>(K, [&](int i) { return A + (size_t)(tm * 64 + i) * K; }, [&](int j) { return Bt + (size_t)(tn * 64 + j) * K; }, c);
#pragma unroll
        for (int i = 0; i < 2; ++i)
#pragma unroll
            for (int q = 0; q < 16; ++q) { const int row = tm * 64 + TROW(i, q); float s = 0.f, qq = 0.f;
#pragma unroll
                for (int j = 0; j < 2; ++j) { const float v = epi(row, tn * 64 + TCOL(j), c[i][j][q]); s += v; qq += v * v; }
                if (STATS) {
#pragma unroll
                    for (int o = 1; o < 32; o <<= 1) { s += __shfl_xor(s, o); qq += __shfl_xor(qq, o); }
                    if ((lane & 31) == 0) stat_add(st, row, s, qq); } }
    }
}
__device__ void phase_outproj_simple(const Params& p) {
    unsigned char* ws = p.ws; bf16_t* T1B = (bf16_t*)(ws + WS_T1B);
    gemm_simple<true>((const bf16_t*)(ws + WS_YMIX), (const bf16_t*)(ws + WS_WOUT), NTOK, DM, DM, (stat_t*)(ws + WS_STATS1),
        [=](int row, int col, float v) { const float t = ALPHA * bf2f(T1B[(size_t)row * DM + col]) + v; T1B[(size_t)row * DM + col] = f2bf(t); return t; });
}
__device__ void phase_mq_simple(const Params& p) {
    unsigned char* ws = p.ws; bf16_t* QM = (bf16_t*)(ws + WS_QM); const stat_t* st = (const stat_t*)(ws + WS_STATS1); const float* cs = (const float*)(ws + WS_CS1); const float* bs = cs + 1024;
    gemm_simple<false>((const bf16_t*)(ws + WS_T1B), (const bf16_t*)(ws + WS_WMQ), NTOK, DM, DM, nullptr,
        [=](int row, int col, float v) { const RowStat r = row_stat(st, row); QM[(size_t)row * DM + col] = f2bf(r.rstd * (v - r.mean * cs[col]) + bs[col]); return 0.f; });
}
__device__ void phase_xattn_simple(const Params& p, unsigned char* lds) {
    unsigned char* ws = p.ws; const int lane = threadIdx.x & 63, wave = threadIdx.x >> 6; const int gw = blockIdx.x * 8 + wave, NGW = gridDim.x * 8;
    const bf16_t* QM = (const bf16_t*)(ws + WS_QM); const bf16_t* MK = (const bf16_t*)(ws + WS_MEMK); const bf16_t* MVT = (const bf16_t*)(ws + WS_MEMVT); bf16_t* OB = (bf16_t*)(ws + WS_OB);
    float* qs = (float*)(lds + wave * 4096); float* ps = qs + 256;
    for (int it = gw; it < NTOK * MH; it += NGW) {
        const int tok = it / MH, h = it % MH, b = tok / SEQ;
        const bf16_t* qp = QM + (size_t)tok * DM + h * MHD;
#pragma unroll
        for (int j = 0; j < 4; ++j) qs[lane + 64 * j] = bf2f(qp[lane + 64 * j]);
        asm volatile("s_waitcnt lgkmcnt(0)" ::: "memory");
        float sc[4];
#pragma unroll
        for (int j = 0; j < 4; ++j) { const int key = lane + 64 * j; const bf16_t* kp = MK + (size_t)(b * MEML + key) * DM + h * MHD; float dot = 0.f;
#pragma unroll 2
            for (int d8 = 0; d8 < 32; ++d8) { const bf16x8 kv = *(const bf16x8*)(kp + d8 * 8);
#pragma unroll
                for (int e = 0; e < 8; ++e) dot += qs[d8 * 8 + e] * bf2f((bf16_t)kv[e]); }
            sc[j] = dot; }
        const float mx = wave_max(fmaxf(fmaxf(sc[0], sc[1]), fmaxf(sc[2], sc[3])));
        float sum = 0.f;
#pragma unroll
        for (int j = 0; j < 4; ++j) { sc[j] = exp2f(sc[j] - mx); sum += sc[j]; }
        sum = wave_sum(sum); const float inv = 1.0f / sum;
#pragma unroll
        for (int j = 0; j < 4; ++j) ps[lane + 64 * j] = sc[j] * inv;
        asm volatile("s_waitcnt lgkmcnt(0)" ::: "memory");
#pragma unroll
        for (int j = 0; j < 4; ++j) { const int d = lane + 64 * j; const bf16_t* vp = MVT + (size_t)(h * MHD + d) * MVT_LD + b * MEML; float acc = 0.f;
#pragma unroll 2
            for (int k8 = 0; k8 < 32; ++k8) { const bf16x8 vv = *(const bf16x8*)(vp + k8 * 8);
#pragma unroll
                for (int e = 0; e < 8; ++e) acc += ps[k8 * 8 + e] * bf2f((bf16_t)vv[e]); }
            OB[(size_t)tok * DM + h * MHD + d] = f2bf(acc); }
        asm volatile("s_waitcnt lgkmcnt(0)" ::: "memory");
    }
}
__device__ void phase_mo_simple(const Params& p) {
    unsigned char* ws = p.ws; bf16_t* T2B = (bf16_t*)(ws + WS_T2B); const bf16_t* T1B = (const bf16_t*)(ws + WS_T1B); const stat_t* st1 = (const stat_t*)(ws + WS_STATS1);
    const float* g1 = p.ln1_g; const float* b1 = p.ln1_b;
    gemm_simple<true>((const bf16_t*)(ws + WS_OB), (const bf16_t*)(ws + WS_WMO), NTOK, DM, DM, (stat_t*)(ws + WS_STATS2),
        [=](int row, int col, float v) { const RowStat r = row_stat(st1, row); const float x1 = (bf2f(T1B[(size_t)row * DM + col]) - r.mean) * r.rstd * g1[col] + b1[col];
            const float t = ALPHA * x1 + v; T2B[(size_t)row * DM + col] = f2bf(t); return t; });
}
__device__ void phase_router_simple(const Params& p) {
    unsigned char* ws = p.ws; float* LG = (float*)(ws + WS_LOGIT); const stat_t* st = (const stat_t*)(ws + WS_STATS2); const float* cs = (const float*)(ws + WS_CS2); const float* bs = cs + 64;
    gemm_simple<false>((const bf16_t*)(ws + WS_T2B), (const bf16_t*)(ws + WS_WRT), NTOK, 64, DM, nullptr,
        [=](int row, int col, float v) { const RowStat r = row_stat(st, row); LG[(size_t)row * NLOGP + col] = r.rstd * (v - r.mean * cs[col]) + bs[col]; return 0.f; });
}
__device__ void phase_route(const Params& p, unsigned char* lds_, int t_first = -1) {
    unsigned char* ws = p.ws; const int tid = threadIdx.x;
    const float* LG = (const float*)(ws + WS_LOGIT); int* EID = (int*)(ws + WS_EID); float* GATE = (float*)(ws + WS_GATE); unsigned* CNT = (unsigned*)(ws + WS_CNT); int* ROWL = (int*)(ws + WS_ROWL); int* POSI = (int*)(ws + WS_POSI); f32x4* ROWM = (f32x4*)p.out; const stat_t* st2 = (const stat_t*)(ws + WS_STATS2);
    LAS unsigned* lc = (LAS unsigned*)lds_;
    for (int t0 = t_first >= 0 ? t_first : blockIdx.x * 512; t0 < (t_first >= 0 ? t_first + 256 : NTOK); t0 += gridDim.x * 512) {
        if (tid < 64) lc[tid] = 0u;
        __syncthreads();
        const int tok = (t_first >= 0 && tid >= 256) ? NTOK : t0 + tid; int ea = 0, eb = 0; unsigned ra = 0, rb = 0; float ga = 0.f, gb = 0.f;
        if (tok < NTOK) {
            const float* lg = LG + (size_t)tok * NLOGP;
            int grp = 0; float gm = lg[0];
#pragma unroll
            for (int g = 1; g < 4; ++g) if (lg[g] > gm) { gm = lg[g]; grp = g; }
            float gs = 0.f;
#pragma unroll
            for (int g = 0; g < 4; ++g) gs += __expf(lg[g] - gm);
            const float gprob = 1.0f / gs;
            const float* el = lg + 4 + grp * 8;
            int i1 = 0; float l1 = el[0];
#pragma unroll
            for (int j = 1; j < 8; ++j) if (el[j] > l1) { l1 = el[j]; i1 = j; }
            int i2 = -1; float l2 = 0.f;
#pragma unroll
            for (int j = 0; j < 8; ++j) if (j != i1 && (i2 < 0 || el[j] > l2)) { l2 = el[j]; i2 = j; }
            const float e2 = __expf(l2 - l1), w1 = 1.0f / (1.0f + e2), w2 = e2 * w1;
            ea = grp * 8 + i1; eb = grp * 8 + i2;
            EID[2 * tok] = ea; EID[2 * tok + 1] = eb; ga = gprob * w1; gb = gprob * w2; GATE[2 * tok] = ga; GATE[2 * tok + 1] = gb;
            ra = atomicAdd((unsigned*)(lc + ea), 1u); rb = atomicAdd((unsigned*)(lc + eb), 1u);
        }
        __syncthreads();
        if (tid < 32) lc[32 + tid] = lc[tid] ? atomicAdd(CNT + tid, lc[tid]) : 0u;
        __syncthreads();
        if (tok < NTOK) { const RowStat rs = row_stat(st2, tok); const size_t ia = (size_t)ea * CAP + lc[32 + ea] + ra, ib = (size_t)eb * CAP + lc[32 + eb] + rb;
            ROWL[ia] = 2 * tok; ROWL[ib] = 2 * tok + 1; POSI[2 * tok] = (int)(lc[32 + ea] + ra); POSI[2 * tok + 1] = (int)(lc[32 + eb] + rb); ROWM[ia] = (f32x4){ga, rs.mean, rs.rstd, 0.f}; ROWM[ib] = (f32x4){gb, rs.mean, rs.rstd, 0.f}; }
        __syncthreads();
    }
}
__device__ void phase_moe1_simple(const Params& p) {
    unsigned char* ws = p.ws; const int wave = threadIdx.x >> 6; const int gw = blockIdx.x * 8 + wave, NGW = gridDim.x * 8;
    const unsigned* CNT = (const unsigned*)(ws + WS_CNT); const int* ROWL = (const int*)(ws + WS_ROWL); const bf16_t* T2B = (const bf16_t*)(ws + WS_T2B); const bf16_t* WGU = (const bf16_t*)(ws + WS_WGU);
    const stat_t* st = (const stat_t*)(ws + WS_STATS2); const float* csg = (const float*)(ws + WS_CSGU); const float* bsg = csg + NEXP * 1024; bf16_t* H = (bf16_t*)(ws + WS_H);
    int tbase = 0, hoff = 0;
    for (int e = 0; e < NEXP; ++e) {
        const int cnt = (int)CNT[e], nrt = (cnt + 63) / 64, ntile = nrt * 8;
        for (int t = gw - tbase; t < ntile; t += NGW) { if (t < 0) continue;
            const int tm = t / 8, ct = t % 8, pn = ct >> 1, hf = ct & 1; const int* rl = ROWL + (size_t)e * CAP; const bf16_t* W = WGU + (size_t)e * 1024 * 1024;
            f32x16 c[2][4];
            wave_tile<2>(DM, [&](int i) { int r = tm * 64 + i; r = r < cnt ? r : cnt - 1; return T2B + (size_t)(rl[r] >> 1) * DM; },
                         [&](int j) { const int row = 256 * pn + (j >= 64 ? 128 : 0) + 64 * hf + (j & 63); return W + (size_t)row * DM; }, c);
#pragma unroll
            for (int i = 0; i < 2; ++i)
#pragma unroll
                for (int q = 0; q < 16; ++q) { const int r = tm * 64 + TROW(i, q); if (r < cnt) { const RowStat rs = row_stat(st, rl[r] >> 1);
#pragma unroll
                    for (int j = 0; j < 2; ++j) { const int cg_ = 256 * pn + 64 * hf + TCOL(j), cu_ = cg_ + 128;
                        const float g = rs.rstd * (c[i][j][q] - rs.mean * csg[e * 1024 + cg_]) + bsg[e * 1024 + cg_];
                        const float u = rs.rstd * (c[i][j + 2][q] - rs.mean * csg[e * 1024 + cu_]) + bsg[e * 1024 + cu_];
                        H[(size_t)(hoff + r) * DEXP + 128 * pn + 64 * hf + TCOL(j)] = f2bf(g / (1.0f + __expf(-g)) * u); } } }
        }
        tbase = (tbase + ntile) % NGW; hoff += (cnt + 255) / 256 * 256;
    }
}
__device__ void phase_moe2_simple(const Params& p) {
    unsigned char* ws = p.ws; const int wave = threadIdx.x >> 6; const int gw = blockIdx.x * 8 + wave, NGW = gridDim.x * 8;
    const unsigned* CNT = (const unsigned*)(ws + WS_CNT); const int* ROWL = (const int*)(ws + WS_ROWL); const bf16_t* H = (const bf16_t*)(ws + WS_H); const bf16_t* WD = (const bf16_t*)(ws + WS_WD);
    const float* GATE = (const float*)(ws + WS_GATE); bf16_t* Y = (bf16_t*)(ws + WS_Y);
    int tbase = 0, hoff = 0;
    for (int e = 0; e < NEXP; ++e) {
        const int cnt = (int)CNT[e], nrt = (cnt + 63) / 64, ntile = nrt * 16;
        for (int t = gw - tbase; t < ntile; t += NGW) { if (t < 0) continue;
            const int tm = t / 16, tn = t % 16; const int* rl = ROWL + (size_t)e * CAP; const bf16_t* W = WD + (size_t)e * 1024 * 512;
            f32x16 c[2][2];
            wave_tile<1>(DEXP, [&](int i) { int r = tm * 64 + i; r = r < cnt ? r : cnt - 1; return H + (size_t)(hoff + r) * DEXP; }, [&](int j) { return W + (size_t)(tn * 64 + j) * DEXP; }, c);
#pragma unroll
            for (int i = 0; i < 2; ++i)
#pragma unroll
                for (int q = 0; q < 16; ++q) { const int r = tm * 64 + TROW(i, q); if (r < cnt) { const int a = rl[r]; const float g = GATE[a];
#pragma unroll
                    for (int j = 0; j < 2; ++j) Y[(size_t)(hoff + r) * DM + tn * 64 + TCOL(j)] = f2bf(g * c[i][j][q]); } }
        }
        tbase = (tbase + ntile) % NGW; hoff += (cnt + 255) / 256 * 256;
    }
}
__device__ void phase_final(const Params& p) {
    unsigned char* ws = p.ws; const int lane = threadIdx.x & 63, wave = threadIdx.x >> 6; const int gw = blockIdx.x * 8 + wave, NGW = gridDim.x * 8;
    const bf16_t* T2B = (const bf16_t*)(ws + WS_T2B); const bf16_t* Y = (const bf16_t*)(ws + WS_Y); const stat_t* st = (const stat_t*)(ws + WS_STATS2);
    const int* EID = (const int*)(ws + WS_EID); const int* POSI = (const int*)(ws + WS_POSI); const unsigned* CNT = (const unsigned*)(ws + WS_CNT);
    int hoffl = 0;
    { const int c = lane < NEXP ? (int)CNT[lane] : 0; int pad = (c + 255) / 256 * 256, inc = pad;
#pragma unroll
      for (int o = 1; o < 32; o <<= 1) { const int n = __shfl_up(inc, o); if ((lane & 31) >= o) inc += n; }
      hoffl = inc - pad; }
    f32x4 g2v[4], b2v[4], g3v[4], b3v[4];
#pragma unroll
    for (int j = 0; j < 2; ++j)
#pragma unroll
        for (int hf = 0; hf < 2; ++hf) { const int c0 = 512 * j + 8 * lane + 4 * hf; g2v[2 * j + hf] = *(const f32x4*)(p.ln2_g + c0); b2v[2 * j + hf] = *(const f32x4*)(p.ln2_b + c0); g3v[2 * j + hf] = *(const f32x4*)(p.ln3_g + c0); b3v[2 * j + hf] = *(const f32x4*)(p.ln3_b + c0); }
    int e0n = 0, e1n = 0, p0n = 0, p1n = 0;
    if (gw < NTOK) { e0n = EID[2 * gw]; e1n = EID[2 * gw + 1]; p0n = POSI[2 * gw]; p1n = POSI[2 * gw + 1]; }
    for (int tok = gw; tok < NTOK; tok += NGW) {
        u32x4 tw[2], aw[2], bw[2];
        const int ra_ = __shfl(hoffl, e0n) + p0n, rb_ = __shfl(hoffl, e1n) + p1n;
        { const int tn = tok + NGW; if (tn < NTOK) { e0n = EID[2 * tn]; e1n = EID[2 * tn + 1]; p0n = POSI[2 * tn]; p1n = POSI[2 * tn + 1]; } }
#pragma unroll
        for (int j = 0; j < 2; ++j) { const int c0 = 512 * j + 8 * lane; tw[j] = *(const u32x4*)(T2B + (size_t)tok * DM + c0); aw[j] = __builtin_nontemporal_load((const u32x4*)(Y + (size_t)ra_ * DM + c0)); bw[j] = __builtin_nontemporal_load((const u32x4*)(Y + (size_t)rb_ * DM + c0)); }
        const RowStat rs = row_stat(st, tok);
        f32x4 v[4]; float s = 0.f;
#pragma unroll
        for (int j = 0; j < 2; ++j) {
            v[2 * j] = ALPHA * ((unpack_lo(tw[j]) - rs.mean) * rs.rstd * g2v[2 * j] + b2v[2 * j]) + unpack_lo(aw[j]) + unpack_lo(bw[j]);
            v[2 * j + 1] = ALPHA * ((unpack_hi(tw[j]) - rs.mean) * rs.rstd * g2v[2 * j + 1] + b2v[2 * j + 1]) + unpack_hi(aw[j]) + unpack_hi(bw[j]);
            s += sum4(v[2 * j]) + sum4(v[2 * j + 1]); }
        const float mean = wave_sum(s) * (1.f / DM); float qq = 0.f;
#pragma unroll
        for (int i = 0; i < 4; ++i) { v[i] = v[i] - mean; qq += sq4(v[i]); }
        const float rstd = __builtin_amdgcn_rsqf(wave_sum(qq) * (1.f / DM) + LN_EPS);
#pragma unroll
        for (int j = 0; j < 2; ++j)
#pragma unroll
            for (int hf = 0; hf < 2; ++hf) __builtin_nontemporal_store(v[2 * j + hf] * rstd * g3v[2 * j + hf] + b3v[2 * j + hf], (f32x4*)(p.out + (size_t)tok * DM + 512 * j + 8 * lane + 4 * hf));
    }
}

namespace mm {
constexpr int BM = 256, BK = 64, HALF = 128, HTB = HALF * BK * 2, STAGE_BYTES = 8 * HTB, NXCD = 8, WGM = 8;
__device__ __forceinline__ int lds_byte(int r, int c) { const int st = (r >> 4) * 2 + (c >> 5), rr = r & 15, cc = c & 31, ob = rr * 64 + cc * 2; return st * 1024 + (ob ^ (((ob >> 9) & 1) << 5)); }
__device__ __forceinline__ void stage_rc(int b, int& R, int& C) { const int st = b / 1024, sb = b % 1024, swz = sb ^ (((sb >> 9) & 1) << 5); R = (st >> 1) * 16 + swz / 64; C = (st & 1) * 32 + (swz % 64) / 2; }
__device__ __forceinline__ int perm32(int rho) { const int n = rho >> 4, i = rho & 15; return 8 * (i >> 2) + 4 * n + (i & 3); }
__device__ __forceinline__ unsigned cvt_pk_bf16(float lo, float hi) { typedef float f2 __attribute__((ext_vector_type(2))); typedef __bf16 b2 __attribute__((ext_vector_type(2))); f2 v = {lo, hi}; b2 b = __builtin_convertvector(v, b2); return __builtin_bit_cast(unsigned, b); }

struct Unit { int pm, pn, aux, nvalid; const char* a; const char* b; const int* rows; };
struct Meta { float r0, r1; int r2; float c0, c1; };
constexpr int META_OFF = 137216, META_SLOT = 5120;

__device__ __forceinline__ void order_map(int L, int nM, int nN, int& pm, int& pn) {
    const int nwg = nM * nN; int wgid = L; { const int q = nwg / NXCD, r = nwg % NXCD, xcd = wgid % NXCD, off = wgid / NXCD; wgid = (xcd < r ? xcd * (q + 1) : r * (q + 1) + (xcd - r) * q) + off; }
    const int nig = WGM * nN, gid = wgid / nig, fm = gid * WGM, gsz = (nM - fm) < WGM ? (nM - fm) : WGM;
    pm = fm + ((wgid % nig) % gsz); pn = (wgid % nig) / gsz;
}

template <class Epi, class Sched, bool GATHER>
__device__ __forceinline__ void gemm_phase(LAS unsigned char* lds, const int K, const Sched& S, const Epi& E) {
    const int tid = threadIdx.x, wid = __builtin_amdgcn_readfirstlane(tid >> 6), lane = tid & 63, wr = wid >> 2, wc = wid & 3, fr = lane & 15, fq = lane >> 4;
    const int nt = K / BK;
    unsigned voffB, voffA, rp[2];
    { int sR, sC; stage_rc(tid * 16, sR, sC); const int Rb = Epi::PERM ? ((sR & ~31) + perm32(sR & 31)) : sR;
      voffB = (unsigned)(Rb * K + sC) * 2u; voffA = GATHER ? (unsigned)sC * 2u : (unsigned)(sR * K + sC) * 2u; }
    const size_t kstep = (size_t)(BK * 2), hstep = (size_t)HALF * K * 2, r64 = (size_t)64 * K * 2;
    const unsigned ldsw = (unsigned)wid * 1024u;
    const int aoff = lds_byte(wr * 64 + fr, fq * 8), boff = lds_byte(wc * 32 + fr, fq * 8);
#define MM_SA(b, h) (((b) * 2 + (h)) * HTB)
#define MM_SB(b, h) ((4 + (b) * 2 + (h)) * HTB)
#define MM_GLDS(src, dst) __builtin_amdgcn_global_load_lds((const unsigned*)(src), (LAS unsigned*)(dst), 16, 0, 0)
#define MM_STAGE_B(bufoff, gbase) do { MM_GLDS((const char*)(gbase) + voffB, lds + (bufoff) + ldsw); MM_GLDS((const char*)(gbase) + r64 + voffB, lds + (bufoff) + ldsw + 8192); } while (0)
#define MM_STAGE_A(bufoff, gbase, h) do { if (GATHER) { \
        MM_GLDS((const char*)(gbase) + (unsigned)((rp[h] & 0xffffu) * (unsigned)(K * 2) + voffA), lds + (bufoff) + ldsw); MM_GLDS((const char*)(gbase) + (unsigned)((rp[h] >> 16) * (unsigned)(K * 2) + voffA), lds + (bufoff) + ldsw + 8192); } \
      else { MM_GLDS((const char*)(gbase) + (h) * hstep + voffA, lds + (bufoff) + ldsw); MM_GLDS((const char*)(gbase) + (h) * hstep + r64 + voffA, lds + (bufoff) + ldsw + 8192); } } while (0)
#define MM_LDA(dst, b, h) do { _Pragma("unroll") for (int m = 0; m < 4; ++m) _Pragma("unroll") for (int k = 0; k < 2; ++k) dst[m][k] = *(const LAS bf16x8*)(lds + MM_SA(b, h) + aoff + m * 2048 + k * 1024); } while (0)
#define MM_LDB(dst, b, h) do { _Pragma("unroll") for (int n = 0; n < 2; ++n) _Pragma("unroll") for (int k = 0; k < 2; ++k) dst[n][k] = *(const LAS bf16x8*)(lds + MM_SB(b, h) + boff + n * 2048 + k * 1024); } while (0)
#define MM_MMA(ai, bj, At, Bt) do { __builtin_amdgcn_s_setprio(1); _Pragma("unroll") for (int m = 0; m < 4; ++m) _Pragma("unroll") for (int n = 0; n < 2; ++n) _Pragma("unroll") for (int k = 0; k < 2; ++k) \
        acc[ai][bj][m][n] = __builtin_amdgcn_mfma_f32_16x16x32_bf16(Bt[n][k], At[m][k], acc[ai][bj][m][n], 0, 0, 0); __builtin_amdgcn_s_setprio(0); } while (0)
#define MM_WAIT_V(n) asm volatile("s_waitcnt vmcnt(" #n ")" ::: "memory")
#define MM_WAIT_L(n) asm volatile("s_waitcnt lgkmcnt(" #n ")" ::: "memory")
#define MM_BAR __builtin_amdgcn_s_barrier()
#define MM_SCHED __builtin_amdgcn_sched_barrier(0)
#define MM_ROWPAIRS(dst, u) do { int _t = tid; asm volatile("" : "+v"(_t)); int _sR, _sC; stage_rc(_t * 16, _sR, _sC); _Pragma("unroll") for (int _h = 0; _h < 2; ++_h) \
        dst[_h] = (unsigned)S.row(u, _h * HALF + _sR) | ((unsigned)S.row(u, _h * HALF + _sR + 64) << 16); } while (0)
#define MM_NVL() ((LAS unsigned*)(lds + 133120 + tid * 8))
    Unit cur, nxt, nx2; int ui = 0;
    if (!S.next(0, cur)) return;
    f32x4 acc[2][2][4][2];
#pragma unroll
    for (int a = 0; a < 2; ++a)
#pragma unroll
        for (int b = 0; b < 2; ++b)
#pragma unroll
            for (int m = 0; m < 4; ++m)
#pragma unroll
                for (int n = 0; n < 2; ++n) acc[a][b][m][n] = (f32x4){0.f, 0.f, 0.f, 0.f};
    bf16x8 At[4][2], B0[2][2], B1[2][2];
    rp[0] = rp[1] = 0u;
    if (GATHER) { unsigned nv[2]; MM_ROWPAIRS(rp, cur); if (S.next(1, nxt)) { MM_ROWPAIRS(nv, nxt); } else { nv[0] = rp[0]; nv[1] = rp[1]; }
        MM_NVL()[0] = nv[0]; MM_NVL()[1] = nv[1];
        asm volatile("s_waitcnt vmcnt(0) lgkmcnt(0)" ::: "memory");
        asm volatile("" : "+v"(rp[0]), "+v"(rp[1])); }
#define MM_META_STORE(slot_, m_) do { LAS float* s_ = (LAS float*)(lds + META_OFF + (slot_) * META_SLOT); s_[tid] = (m_).r0; s_[256 + tid] = (m_).r1; ((LAS int*)s_)[512 + tid] = (m_).r2; s_[768 + tid] = (m_).c0; s_[1024 + tid] = (m_).c1; } while (0)
    if (Epi::META) { if (tid < 256) { const Meta m0 = E.meta_load(cur, tid); MM_META_STORE(0, m0); } }
    const char* cA = cur.a; const char* cB = cur.b;
    MM_STAGE_B(MM_SB(0, 0), cB); MM_STAGE_B(MM_SB(0, 1), cB + hstep); MM_STAGE_A(MM_SA(0, 0), cA, 0); MM_STAGE_A(MM_SA(0, 1), cA, 1);
    if (wr == 1) MM_BAR;
    MM_WAIT_V(2); MM_BAR;
    MM_STAGE_B(MM_SB(1, 0), cB + kstep); MM_STAGE_A(MM_SA(1, 0), cA + kstep, 0); MM_STAGE_B(MM_SB(1, 1), cB + hstep + kstep);
    MM_WAIT_V(6); MM_BAR;
    for (;;) {
        const bool has_next = S.next(ui + 1, nxt);
        const char* nA = has_next ? nxt.a : cA; const char* nB = has_next ? nxt.b : cB;
        for (int t = 0; t < nt; t += 2) {
            const bool last = (t == nt - 2);
            const char* a1 = cA + (size_t)(t + 1) * kstep;
            const char* a2 = last ? nA : cA + (size_t)(t + 2) * kstep; const char* b2 = last ? nB : cB + (size_t)(t + 2) * kstep;
            const char* a3 = a2 + kstep; const char* b3 = b2 + kstep;
            MM_LDB(B0, 0, 0); MM_LDB(B1, 0, 1); MM_SCHED; MM_LDA(At, 0, 0); MM_STAGE_A(MM_SA(1, 1), a1, 1);
            MM_WAIT_V(8); MM_WAIT_L(0); MM_BAR; MM_MMA(0, 0, At, B0); MM_MMA(0, 1, At, B1); MM_BAR; MM_SCHED;
            if (GATHER) { if (last) { rp[0] = MM_NVL()[0]; rp[1] = MM_NVL()[1]; } }
            MM_LDA(At, 0, 1); MM_STAGE_B(MM_SB(0, 0), b2); MM_STAGE_B(MM_SB(0, 1), b2 + hstep); MM_STAGE_A(MM_SA(0, 0), a2, 0);
            MM_WAIT_V(8); MM_WAIT_L(0); MM_BAR; MM_MMA(1, 0, At, B0); MM_MMA(1, 1, At, B1); MM_BAR; MM_SCHED;
            MM_LDB(B0, 1, 0); MM_LDB(B1, 1, 1); MM_SCHED; MM_LDA(At, 1, 0); MM_STAGE_A(MM_SA(0, 1), a2, 1);
            MM_WAIT_V(8); MM_WAIT_L(0); MM_BAR; MM_MMA(0, 0, At, B0); MM_MMA(0, 1, At, B1); MM_BAR; MM_SCHED;
            MM_LDA(At, 1, 1); MM_STAGE_B(MM_SB(1, 0), b3); MM_STAGE_B(MM_SB(1, 1), b3 + hstep); MM_STAGE_A(MM_SA(1, 0), a3, 0);
            MM_WAIT_V(8); MM_WAIT_L(0); MM_BAR; MM_MMA(1, 0, At, B0); MM_MMA(1, 1, At, B1); MM_BAR; MM_SCHED;
        }
        if (wr == 0) MM_BAR;
        Meta mn; const bool pm_ = Epi::META && has_next && tid < 256;
        if (pm_) mn = E.meta_load(nxt, tid);
        E(acc, cur, wr, wc, fr, fq, (const LAS float*)(lds + META_OFF + (ui & 1) * META_SLOT));
        if (pm_) MM_META_STORE((ui + 1) & 1, mn);
        if (!has_next) break;
        if (GATHER) {
            if (S.next(ui + 2, nx2)) { unsigned nv[2]; MM_ROWPAIRS(nv, nx2); MM_NVL()[0] = nv[0]; MM_NVL()[1] = nv[1]; }
            asm volatile("s_waitcnt vmcnt(0) lgkmcnt(0)" ::: "memory"); }
#pragma unroll
        for (int a = 0; a < 2; ++a)
#pragma unroll
            for (int b = 0; b < 2; ++b)
#pragma unroll
                for (int m = 0; m < 4; ++m)
#pragma unroll
                    for (int n = 0; n < 2; ++n) acc[a][b][m][n] = (f32x4){0.f, 0.f, 0.f, 0.f};
        cur = nxt; cA = nA; cB = nB; ++ui;
        if (wr == 1) MM_BAR;
    }
    MM_WAIT_V(0);
    MM_BAR;
#undef MM_SA
#undef MM_SB
#undef MM_GLDS
#undef MM_STAGE_A
#undef MM_STAGE_B
#undef MM_LDA
#undef MM_LDB
#undef MM_MMA
#undef MM_WAIT_V
#undef MM_WAIT_L
#undef MM_BAR
#undef MM_SCHED
#undef MM_META_STORE
#undef MM_ROWPAIRS
#undef MM_NVL
}
}

typedef mm::Unit MUnit;
typedef f32x4 AccT[2][2][4][2];
__device__ __forceinline__ u32x4 pack8(const f32x4 a, const f32x4 b) { u32x4 w; w.x = mm::cvt_pk_bf16(a[0], a[1]); w.y = mm::cvt_pk_bf16(a[2], a[3]); w.z = mm::cvt_pk_bf16(b[0], b[1]); w.w = mm::cvt_pk_bf16(b[2], b[3]); return w; }

struct SchedProj {
    const char *xb, *win, *memb, *wmk, *wmv; int G, c;
    __device__ __forceinline__ bool next(int i, MUnit& u) const {
        int L = i * G + c; u.rows = nullptr; u.nvalid = 256;
        constexpr int U0 = 256 * 10, U1 = 512, U2 = 128, U3 = 128;
        if (L < U0) { int pm, pn; mm::order_map(L, 256, 10, pm, pn); u.pm = pm; u.pn = pn; u.aux = 0; u.a = xb + (size_t)pm * 256 * 2048; u.b = win + (size_t)pn * 256 * 2048; return true; }
        L -= U0;
        if (L < U1) { u.pm = L & 1; u.pn = L >> 1; u.aux = 1; u.a = win + (size_t)(C_V + 256 * u.pm) * 2048; u.b = xb + (size_t)u.pn * 256 * 2048; return true; }
        L -= U1;
        if (L < U2) { u.pm = L >> 2; u.pn = L & 3; u.aux = 2; u.a = memb + (size_t)u.pm * 256 * 2048; u.b = wmk + (size_t)u.pn * 256 * 2048; return true; }
        L -= U2;
        if (L < U3) { u.pm = L & 3; u.pn = L >> 2; u.aux = 3; u.a = wmv + (size_t)u.pm * 256 * 2048; u.b = memb + (size_t)u.pn * 256 * 2048; return true; }
        return false;
    }
    __device__ __forceinline__ int row(const MUnit&, int r) const { return r; }
};
struct EpiProj {
    static constexpr bool PERM = true, META = false;
    bf16_t *proj, *vt, *mk, *mvt;
    __device__ __forceinline__ mm::Meta meta_load(const MUnit&, int) const { return mm::Meta{}; }
    __device__ __forceinline__ void operator()(const AccT& acc, const MUnit& u, int wr, int wc, int fr, int fq, const LAS float*) const {
        bf16_t* O = u.aux == 0 ? proj : u.aux == 1 ? vt : u.aux == 2 ? mk : mvt; const int ldc = u.aux == 0 ? NPROJ : u.aux == 1 ? VT_LD : u.aux == 2 ? DM : MVT_LD;
        const int row0 = u.pm * 256 + wr * 64 + fr, col0 = u.pn * 256 + wc * 32 + 8 * fq;
#pragma unroll
        for (int ai = 0; ai < 2; ++ai)
#pragma unroll
            for (int m = 0; m < 4; ++m) { bf16_t* rowp = O + (size_t)(row0 + ai * 128 + m * 16) * ldc + col0;
#pragma unroll
                for (int bj = 0; bj < 2; ++bj) *(u32x4*)(rowp + bj * 128) = pack8(acc[ai][bj][m][0], acc[ai][bj][m][1]); }
    }
};
struct SchedDense {
    const char *A, *B; int nM, nN, G, c;
    __device__ __forceinline__ bool next(int i, MUnit& u) const {
        const int L = i * G + c; if (L >= nM * nN) return false;
        int pm, pn; mm::order_map(L, nM, nN, pm, pn); u.pm = pm; u.pn = pn; u.aux = 0; u.nvalid = 256; u.rows = nullptr; u.a = A + (size_t)pm * 256 * 2048; u.b = B + (size_t)pn * 256 * 2048; return true;
    }
    __device__ __forceinline__ int row(const MUnit&, int r) const { return r; }
};
__device__ __forceinline__ void row_stats_add(stat_t* st, int row, float s, float q, int fq) {
    s += __shfl_xor(s, 16); s += __shfl_xor(s, 32); q += __shfl_xor(q, 16); q += __shfl_xor(q, 32);
    if (fq == 0) stat_add(st, row, s, q);
}
struct EpiOut {
    static constexpr bool PERM = true, META = false;
    bf16_t* t1b; stat_t* st;
    __device__ __forceinline__ mm::Meta meta_load(const MUnit&, int) const { return mm::Meta{}; }
    __device__ __forceinline__ void operator()(const AccT& acc, const MUnit& u, int wr, int wc, int fr, int fq, const LAS float*) const {
        bf16_t* base = t1b + (size_t)(u.pm * 256 + wr * 64 + fr) * DM + u.pn * 256 + wc * 32 + 8 * fq;
        u32x4 xw[2][4][2];
#pragma unroll
        for (int ai = 0; ai < 2; ++ai)
#pragma unroll
            for (int m = 0; m < 4; ++m)
#pragma unroll
                for (int bj = 0; bj < 2; ++bj) xw[ai][m][bj] = *(const u32x4*)(base + (size_t)(ai * 128 + m * 16) * DM + bj * 128);
#pragma unroll
        for (int ai = 0; ai < 2; ++ai)
#pragma unroll
            for (int m = 0; m < 4; ++m) { const int row = u.pm * 256 + ai * 128 + wr * 64 + m * 16 + fr; float s = 0.f, q = 0.f;
#pragma unroll
                for (int bj = 0; bj < 2; ++bj) {
                    const f32x4 t0 = ALPHA * unpack_lo(xw[ai][m][bj]) + acc[ai][bj][m][0], t1 = ALPHA * unpack_hi(xw[ai][m][bj]) + acc[ai][bj][m][1];
                    *(u32x4*)(base + (size_t)(ai * 128 + m * 16) * DM + bj * 128) = pack8(t0, t1); s += sum4(t0) + sum4(t1); q += sq4(t0) + sq4(t1); }
                row_stats_add(st, row, s, q, fq); }
    }
};
struct EpiMq {
    static constexpr bool PERM = true, META = true;
    bf16_t* qm; const stat_t* st; const float *cs, *bs;
    __device__ __forceinline__ mm::Meta meta_load(const MUnit& u, int t) const { const RowStat r = row_stat(st, u.pm * 256 + t); mm::Meta m; m.r0 = r.mean; m.r1 = r.rstd; m.r2 = 0; m.c0 = cs[u.pn * 256 + t]; m.c1 = bs[u.pn * 256 + t]; return m; }
    __device__ __forceinline__ void operator()(const AccT& acc, const MUnit& u, int wr, int wc, int fr, int fq, const LAS float* ms) const {
        float mean[8], rstd[8];
#pragma unroll
        for (int g = 0; g < 8; ++g) { const int rl = (g >> 2) * 128 + wr * 64 + (g & 3) * 16 + fr; mean[g] = ms[rl]; rstd[g] = ms[256 + rl]; }
#pragma unroll
        for (int bj = 0; bj < 2; ++bj) { const int cl = bj * 128 + wc * 32 + 8 * fq, col = u.pn * 256 + cl;
            const f32x4 c0 = *(const LAS f32x4*)(ms + 768 + cl), c1 = *(const LAS f32x4*)(ms + 768 + cl + 4), b0 = *(const LAS f32x4*)(ms + 1024 + cl), b1 = *(const LAS f32x4*)(ms + 1024 + cl + 4);
#pragma unroll
            for (int ai = 0; ai < 2; ++ai)
#pragma unroll
                for (int m = 0; m < 4; ++m) { const int row = u.pm * 256 + ai * 128 + wr * 64 + m * 16 + fr; const float mu = mean[ai * 4 + m], rs = rstd[ai * 4 + m];
                    const f32x4 v0 = rs * (acc[ai][bj][m][0] - mu * c0) + b0, v1 = rs * (acc[ai][bj][m][1] - mu * c1) + b1;
                    *(u32x4*)(qm + (size_t)row * DM + col) = pack8(v0, v1); } }
    }
};
struct EpiMo {
    static constexpr bool PERM = true, META = true;
    const bf16_t* t1b; const stat_t* st1; const float *g1, *b1; bf16_t* t2b; stat_t* st2;
    __device__ __forceinline__ mm::Meta meta_load(const MUnit& u, int t) const { const RowStat r = row_stat(st1, u.pm * 256 + t); mm::Meta m; m.r0 = r.mean; m.r1 = r.rstd; m.r2 = 0; m.c0 = g1[u.pn * 256 + t]; m.c1 = b1[u.pn * 256 + t]; return m; }
    __device__ __forceinline__ void operator()(const AccT& acc, const MUnit& u, int wr, int wc, int fr, int fq, const LAS float* ms) const {
        const size_t off0 = (size_t)(u.pm * 256 + wr * 64 + fr) * DM + u.pn * 256 + wc * 32 + 8 * fq;
        f32x4 gv[2][2], bv[2][2];
#pragma unroll
        for (int bj = 0; bj < 2; ++bj)
#pragma unroll
            for (int hf = 0; hf < 2; ++hf) { const int cl = bj * 128 + wc * 32 + 8 * fq + 4 * hf; gv[bj][hf] = *(const LAS f32x4*)(ms + 768 + cl); bv[bj][hf] = *(const LAS f32x4*)(ms + 1024 + cl); }
#pragma unroll
        for (int ai = 0; ai < 2; ++ai) {
            u32x4 tw[4][2]; float mean[4], rstd[4];
#pragma unroll
            for (int m = 0; m < 4; ++m) { const int rl = ai * 128 + wr * 64 + m * 16 + fr; mean[m] = ms[rl]; rstd[m] = ms[256 + rl];
#pragma unroll
                for (int bj = 0; bj < 2; ++bj) tw[m][bj] = *(const u32x4*)(t1b + off0 + (size_t)(ai * 128 + m * 16) * DM + bj * 128); }
#pragma unroll
            for (int m = 0; m < 4; ++m) { const int row = u.pm * 256 + ai * 128 + wr * 64 + m * 16 + fr; float s = 0.f, q = 0.f;
#pragma unroll
                for (int bj = 0; bj < 2; ++bj) {
                    const f32x4 x0 = (unpack_lo(tw[m][bj]) - mean[m]) * rstd[m] * gv[bj][0] + bv[bj][0], x1 = (unpack_hi(tw[m][bj]) - mean[m]) * rstd[m] * gv[bj][1] + bv[bj][1];
                    const f32x4 t0 = ALPHA * x0 + acc[ai][bj][m][0], t1 = ALPHA * x1 + acc[ai][bj][m][1];
                    *(u32x4*)(t2b + off0 + (size_t)(ai * 128 + m * 16) * DM + bj * 128) = pack8(t0, t1); s += sum4(t0) + sum4(t1); q += sq4(t0) + sq4(t1); }
                row_stats_add(st2, row, s, q, fq); }
            asm volatile("" ::: "memory");
        }
    }
};
struct EpiRouter {
    static constexpr bool PERM = false, META = true;
    float* lg; const stat_t* st; const float *cs, *bs;
    __device__ __forceinline__ mm::Meta meta_load(const MUnit& u, int t) const { const RowStat r = row_stat(st, u.pm * 256 + t); mm::Meta m; m.r0 = r.mean; m.r1 = r.rstd; m.r2 = 0; m.c0 = t < 64 ? cs[t] : 0.f; m.c1 = t < 64 ? bs[t] : 0.f; return m; }
    __device__ __forceinline__ void operator()(const AccT& acc, const MUnit& u, int wr, int wc, int fr, int fq, const LAS float* ms) const {
        if (wc < 2) {
#pragma unroll
            for (int n = 0; n < 2; ++n) { const int col = wc * 32 + 16 * n + 4 * fq; const f32x4 c0 = *(const LAS f32x4*)(ms + 768 + col), b0 = *(const LAS f32x4*)(ms + 1024 + col);
#pragma unroll
                for (int ai = 0; ai < 2; ++ai)
#pragma unroll
                    for (int m = 0; m < 4; ++m) { const int rl = ai * 128 + wr * 64 + m * 16 + fr, row = u.pm * 256 + rl;
                        *(f32x4*)(lg + (size_t)row * NLOGP + col) = ms[256 + rl] * (acc[ai][0][m][n] - ms[rl] * c0) + b0; } }
        }
    }
};
constexpr int MOE_TB_OFF = 131072;
__device__ __forceinline__ void moe_tables(const unsigned* CNT, LAS int* tb) {
    if (threadIdx.x == 0) { int ub = 0, ho = 0;
        for (int e = 0; e < NEXP; ++e) { const int c = (int)CNT[e]; tb[e] = ub; tb[64 + e] = ho; tb[128 + e] = c; const int nt = (c + 255) / 256; ub += nt * 4; ho += nt * 256; }
        tb[32] = ub; }
    __syncthreads();
}
__device__ __forceinline__ int uni(int v) { return __builtin_amdgcn_readfirstlane(v); }
template <class T> __device__ __forceinline__ T* uni_ptr(T* q) { const unsigned long long v = (unsigned long long)q; const unsigned lo = __builtin_amdgcn_readfirstlane((unsigned)v), hi = __builtin_amdgcn_readfirstlane((unsigned)(v >> 32)); return (T*)(((unsigned long long)hi << 32) | lo); }
template <int WHICH> struct SchedMoe {
    const char *A, *B; const int* rowl; LAS int* tb; int G, c;
    __device__ __forceinline__ bool next(int i, MUnit& u) const {
        const int L = i * G + c, T = (L >> 5) * 8 + (L & 7), pn = (L >> 3) & 3; if (4 * T >= uni(tb[32])) return false;
        int e = 0; while (uni(tb[e + 1]) <= 4 * T) ++e;
        const int tm = T - (uni(tb[e]) >> 2), cnt = uni(tb[128 + e]), rem = cnt - tm * 256, ho = uni(tb[64 + e]);
        u.pm = tm; u.pn = pn; u.aux = e; u.nvalid = rem < 256 ? rem : 256; u.rows = rowl + (size_t)e * CAP + tm * 256;
        if (WHICH == 1) { u.a = A; u.b = B + ((size_t)e * 1024 + pn * 256) * 2048; }
        else { u.a = A + (size_t)(ho + tm * 256) * 1024; u.b = B + ((size_t)e * 1024 + pn * 256) * 1024; }
        return true;
    }
    __device__ __forceinline__ int row(const MUnit& u, int r) const { return WHICH == 1 ? (u.rows[r < u.nvalid ? r : u.nvalid - 1] >> 1) : r; }
};
struct EpiMoe1 {
    static constexpr bool PERM = true, META = true;
    bf16_t* H; const f32x4* rowm; const float *csg, *bsg; LAS int* tb;
    __device__ __forceinline__ mm::Meta meta_load(const MUnit& u, int t) const { const int r = t < u.nvalid ? t : u.nvalid - 1; const f32x4 rm = rowm[(size_t)u.aux * CAP + u.pm * 256 + r];
        const int wrow = u.aux * 1024 + u.pn * 256 + t; mm::Meta m; m.r0 = rm[1]; m.r1 = rm[2]; m.r2 = 0; m.c0 = csg[wrow]; m.c1 = bsg[wrow]; return m; }
    __device__ __forceinline__ void operator()(const AccT& acc, const MUnit& u, int wr, int wc, int fr, int fq, const LAS float* ms) const {
        const int e = u.aux, hrow0 = uni(tb[64 + e]) + u.pm * 256, c8 = wc * 32 + 8 * fq;
        f32x4 cg[2], bg[2], cu[2], bu[2];
#pragma unroll
        for (int n = 0; n < 2; ++n) { cg[n] = *(const LAS f32x4*)(ms + 768 + c8 + 4 * n); bg[n] = *(const LAS f32x4*)(ms + 1024 + c8 + 4 * n); cu[n] = *(const LAS f32x4*)(ms + 768 + 128 + c8 + 4 * n); bu[n] = *(const LAS f32x4*)(ms + 1024 + 128 + c8 + 4 * n); }
#pragma unroll
        for (int ai = 0; ai < 2; ++ai)
#pragma unroll
            for (int m = 0; m < 4; ++m) { const int rl = ai * 128 + wr * 64 + m * 16 + fr; const float mu = ms[rl], rs = ms[256 + rl];
                f32x4 hv[2];
#pragma unroll
                for (int n = 0; n < 2; ++n) { const f32x4 g = rs * (acc[ai][0][m][n] - mu * cg[n]) + bg[n], uu = rs * (acc[ai][1][m][n] - mu * cu[n]) + bu[n];
#pragma unroll
                    for (int j = 0; j < 4; ++j) hv[n][j] = g[j] * __builtin_amdgcn_rcpf(1.0f + __builtin_amdgcn_exp2f(-LOG2E * g[j])) * uu[j]; }
                *(u32x4*)(H + (size_t)(hrow0 + rl) * DEXP + u.pn * 128 + c8) = pack8(hv[0], hv[1]); }
    }
};
struct EpiMoe2 {
    static constexpr bool PERM = true, META = true;
    bf16_t* YS; const f32x4* rowm; LAS int* tb;
    __device__ __forceinline__ mm::Meta meta_load(const MUnit& u, int t) const { const int r = t < u.nvalid ? t : u.nvalid - 1; mm::Meta m; m.r0 = rowm[(size_t)u.aux * CAP + u.pm * 256 + r][0]; m.r1 = 0.f; m.r2 = 0; m.c0 = 0.f; m.c1 = 0.f; return m; }
    __device__ __forceinline__ void operator()(const AccT& acc, const MUnit& u, int wr, int wc, int fr, int fq, const LAS float* ms) const {
        const int hrow0 = uni(tb[64 + u.aux]) + u.pm * 256;
#pragma unroll
        for (int ai = 0; ai < 2; ++ai)
#pragma unroll
            for (int m = 0; m < 4; ++m) { const int rl = ai * 128 + wr * 64 + m * 16 + fr; const float g = ms[rl];
                bf16_t* rowp = YS + (size_t)(hrow0 + rl) * DM + u.pn * 256 + wc * 32 + 8 * fq;
#pragma unroll
                for (int bj = 0; bj < 2; ++bj) *(u32x4*)(rowp + bj * 128) = pack8(g * acc[ai][bj][m][0], g * acc[ai][bj][m][1]); }
    }
};
__device__ __forceinline__ void phase_proj_fast(const Params& p, LAS unsigned char* lds) {
    unsigned char* ws = p.ws;
    SchedProj S{(const char*)(ws + WS_XB), (const char*)(ws + WS_WIN), (const char*)(ws + WS_MEMB), (const char*)(ws + WS_WMK), (const char*)(ws + WS_WMV), (int)gridDim.x, (int)blockIdx.x};
    EpiProj E{(bf16_t*)(ws + WS_PROJ), (bf16_t*)(ws + WS_VT), (bf16_t*)(ws + WS_MEMK), (bf16_t*)(ws + WS_MEMVT)};
    mm::gemm_phase<EpiProj, SchedProj, false>(lds, DM, S, E);
}
__device__ __forceinline__ void phase_outproj_fast(const Params& p, LAS unsigned char* lds) {
    unsigned char* ws = p.ws;
    SchedDense S{(const char*)(ws + WS_YMIX), (const char*)(ws + WS_WOUT), NTOK / 256, DM / 256, (int)gridDim.x, (int)blockIdx.x};
    EpiOut E{(bf16_t*)(ws + WS_T1B), (stat_t*)(ws + WS_STATS1)};
    mm::gemm_phase<EpiOut, SchedDense, false>(lds, DM, S, E);
}
__device__ __forceinline__ void phase_mq_fast(const Params& p, LAS unsigned char* lds) {
    unsigned char* ws = p.ws;
    SchedDense S{(const char*)(ws + WS_T1B), (const char*)(ws + WS_WMQ), NTOK / 256, DM / 256, (int)gridDim.x, (int)blockIdx.x};
    EpiMq E{(bf16_t*)(ws + WS_QM), (const stat_t*)(ws + WS_STATS1), (const float*)(ws + WS_CS1), (const float*)(ws + WS_CS1) + 1024};
    mm::gemm_phase<EpiMq, SchedDense, false>(lds, DM, S, E);
}
__device__ __forceinline__ void phase_mo_fast(const Params& p, LAS unsigned char* lds) {
    unsigned char* ws = p.ws;
    SchedDense S{(const char*)(ws + WS_OB), (const char*)(ws + WS_WMO), NTOK / 256, DM / 256, (int)gridDim.x, (int)blockIdx.x};
    EpiMo E{(const bf16_t*)(ws + WS_T1B), (const stat_t*)(ws + WS_STATS1), p.ln1_g, p.ln1_b, (bf16_t*)(ws + WS_T2B), (stat_t*)(ws + WS_STATS2)};
    mm::gemm_phase<EpiMo, SchedDense, false>(lds, DM, S, E);
}
__device__ __forceinline__ void phase_router_fast(const Params& p, LAS unsigned char* lds) {
    unsigned char* ws = p.ws;
    SchedDense S{(const char*)(ws + WS_T2B), (const char*)(ws + WS_WRT), NTOK / 256, 1, (int)gridDim.x, (int)blockIdx.x};
    EpiRouter E{(float*)(ws + WS_LOGIT), (const stat_t*)(ws + WS_STATS2), (const float*)(ws + WS_CS2), (const float*)(ws + WS_CS2) + 64};
    mm::gemm_phase<EpiRouter, SchedDense, false>(lds, DM, S, E);
    if (gridDim.x == NTOK / 256) { int pm, pn; mm::order_map((int)blockIdx.x, NTOK / 256, 1, pm, pn); asm volatile("s_waitcnt vmcnt(0)" ::: "memory"); __syncthreads(); phase_route(p, (unsigned char*)lds, pm * 256); }
}
__device__ __forceinline__ void phase_moe1_fast(const Params& p, LAS unsigned char* lds) {
    unsigned char* ws = p.ws; LAS int* tb = (LAS int*)(lds + MOE_TB_OFF);
    moe_tables((const unsigned*)(ws + WS_CNT), tb);
    SchedMoe<1> S{(const char*)(ws + WS_T2B), (const char*)(ws + WS_WGU), (const int*)(ws + WS_ROWL), tb, (int)gridDim.x, (int)blockIdx.x};
    EpiMoe1 E{(bf16_t*)(ws + WS_H), (const f32x4*)p.out, (const float*)(ws + WS_CSGU), (const float*)(ws + WS_CSGU) + NEXP * 1024, tb};
    mm::gemm_phase<EpiMoe1, SchedMoe<1>, true>(lds, DM, S, E);
}
__device__ __forceinline__ void phase_moe2_fast(const Params& p, LAS unsigned char* lds) {
    unsigned char* ws = p.ws; LAS int* tb = (LAS int*)(lds + MOE_TB_OFF);
    moe_tables((const unsigned*)(ws + WS_CNT), tb);
    SchedMoe<2> S{(const char*)(ws + WS_H), (const char*)(ws + WS_WD), (const int*)(ws + WS_ROWL), tb, (int)gridDim.x, (int)blockIdx.x};
    EpiMoe2 E{(bf16_t*)(ws + WS_Y), (const f32x4*)p.out, tb};
    mm::gemm_phase<EpiMoe2, SchedMoe<2>, false>(lds, DEXP, S, E);
}

constexpr int SB_LDS_WAVE = 18432, SB_KROW = 144, SB_VROW = 136;
__device__ __forceinline__ float fexp2(float x) { return __builtin_amdgcn_exp2f(x); }
__device__ __forceinline__ float flog2(float x) { return __builtin_amdgcn_logf(x); }

template <bool MASK>
__device__ __forceinline__ void sb_scan(f32x16 (&pp)[2], float& R, const int kb, const int lim, const int hi) {
    float gp[8];
#pragma unroll
    for (int a = 0; a < 8; ++a) {
        float be[4], om[4];
#pragma unroll
        for (int i = 0; i < 4; ++i) { const float sc = __builtin_amdgcn_fmed3f(pp[a >> 2][4 * (a & 3) + i], -80.f, 80.f);
            const float e = fexp2(-sc); be[i] = __builtin_amdgcn_rcpf(1.0f + e); om[i] = e * be[i];
            if (MASK) { const int kv = kb + 8 * a + 4 * hi + i; if (!(kv < lim)) { be[i] = 0.f; om[i] = 1.f; } } }
        const float s23 = om[2] * om[3], s123 = om[1] * s23;
        pp[a >> 2][4 * (a & 3) + 3] = be[3];
        pp[a >> 2][4 * (a & 3) + 2] = be[2] * om[3];
        pp[a >> 2][4 * (a & 3) + 1] = be[1] * s23;
        pp[a >> 2][4 * (a & 3) + 0] = be[0] * s123;
        gp[a] = om[0] * s123;
        if (a < 7) { const int an = a + 1;
            asm volatile("" : "+v"(gp[a]), "+v"(pp[an >> 2][4 * (an & 3) + 0]), "+v"(pp[an >> 2][4 * (an & 3) + 1]), "+v"(pp[an >> 2][4 * (an & 3) + 2]), "+v"(pp[an >> 2][4 * (an & 3) + 3])); }
    }
    float base[8];
    {
        float ev[8], od[8];
#pragma unroll
        for (int a = 0; a < 8; ++a) { const unsigned own = __float_as_uint(gp[a]); auto rr = __builtin_amdgcn_permlane32_swap(own, own, false, false);
            const float other = __uint_as_float(rr[0] == own ? rr[1] : rr[0]);
            ev[a] = hi ? other : gp[a]; od[a] = hi ? gp[a] : other; }
        float run = R;
#pragma unroll
        for (int a = 7; a >= 0; --a) { const float b_od = run; run *= od[a]; const float b_ev = run; run *= ev[a]; base[a] = hi ? b_od : b_ev; }
        R = run;
    }
#pragma unroll
    for (int a = 0; a < 8; ++a)
#pragma unroll
        for (int i = 0; i < 4; ++i) pp[a >> 2][4 * (a & 3) + i] *= base[a];
}

constexpr int SB_SLOT = 64 * SB_KROW + 64 * SB_VROW  , SB_NSLOT = 7, SB_GAIN_OFF = SB_NSLOT * SB_SLOT;
__device__ __forceinline__ void phase_sb_fast(const Params& p, LAS unsigned char* lds) {
    unsigned char* ws = p.ws; const int lane = threadIdx.x & 63, wave = __builtin_amdgcn_readfirstlane(threadIdx.x >> 6), r32 = lane & 31, hi = lane >> 5;
    const bf16_t* PROJ = (const bf16_t*)(ws + WS_PROJ); const bf16_t* VT = (const bf16_t*)(ws + WS_VT); bf16_t* YMIX = (bf16_t*)(ws + WS_YMIX);
    const int srow = lane >> 3, sch = lane & 7;
    const unsigned koff = (unsigned)(srow * NPROJ + 8 * sch) * 2u, voff = (unsigned)(srow * VT_LD + 8 * sch) * 2u;
    constexpr int NGRP = NB * NHEAD * (SEQ / 256);
    LAS unsigned char* myslot = lds + wave * SB_SLOT;
    LAS float* gl = (LAS float*)(lds + SB_GAIN_OFF);
    LAS float* cwl = (LAS float*)(lds + SB_GAIN_OFF + 256);
    for (int i = threadIdx.x; i < 2048; i += 512) cwl[i] = i < 1536 ? p.conv_w[i] : p.gn_conv[i - 1536];
    u32x4 kst[8], vst[8]; bf16x8 qf[4];
#define SB_LOADT(Kg_, Vg_, kbx) do { const char* kt_ = (const char*)((Kg_) + (size_t)(kbx) * NPROJ); const char* vt_ = (const char*)((Vg_) + (kbx)); \
        _Pragma("unroll") for (int i = 0; i < 8; ++i) { kst[i] = *(const u32x4*)(kt_ + (size_t)i * (8 * NPROJ * 2) + koff); vst[i] = *(const u32x4*)(vt_ + (size_t)i * (8 * VT_LD * 2) + voff); } } while (0)
#define SB_WRITET(kl_) do { _Pragma("unroll") for (int i = 0; i < 8; ++i) { *(LAS u32x4*)((kl_) + (srow + 8 * i) * SB_KROW + 16 * sch) = kst[i]; \
        *(LAS u32x2*)((kl_) + 64 * SB_KROW + (srow + 8 * i) * SB_VROW + 16 * sch) = (u32x2){vst[i].x, vst[i].y}; *(LAS u32x2*)((kl_) + 64 * SB_KROW + (srow + 8 * i) * SB_VROW + 16 * sch + 8) = (u32x2){vst[i].z, vst[i].w}; } } while (0)
#define SB_GROUP(g_, b_, h_, q0_, Kg_, Vg_) do { const int bh_ = (g_) >> 3; b_ = bh_ >> 3; h_ = bh_ & 7; q0_ = ((g_) & 7) * 256; \
        Kg_ = PROJ + (size_t)(b_ * SEQ) * NPROJ + C_K + h_ * 64; Vg_ = VT + (size_t)(h_ * 64) * VT_LD + b_ * SEQ; } while (0)
#define SB_LOADQ(dst, b_, h_, r0_) do { const bf16_t* qp_ = PROJ + (size_t)(b_ * SEQ + r0_ + r32) * NPROJ + C_Q + h_ * 64 + 8 * hi; \
        _Pragma("unroll") for (int d0 = 0; d0 < 4; ++d0) dst[d0] = *(const bf16x8*)(qp_ + 16 * d0); } while (0)
    int g = blockIdx.x, b = 0, h = 0, q0 = 0; const bf16_t* Kg = PROJ; const bf16_t* Vg = VT;
    if (g < NGRP) { SB_GROUP(g, b, h, q0, Kg, Vg); SB_LOADQ(qf, b, h, q0 + 32 * wave); const int tl = (q0 >> 6) + 3 - wave; if (wave < SB_NSLOT && tl >= 0) SB_LOADT(Kg, Vg, 64 * tl); }
    while (g < NGRP) {
        const int ttop = (q0 >> 6) + 3, r0 = q0 + 32 * wave;
        if (wave < SB_NSLOT && ttop - wave >= 0) SB_WRITET(myslot);
        if (wave == 7) gl[lane] = p.gn_sb[h * 64 + lane];
        asm volatile("s_waitcnt vmcnt(0) lgkmcnt(0)" ::: "memory");
        asm volatile("" : "+v"(qf[0]), "+v"(qf[1]), "+v"(qf[2]), "+v"(qf[3]));
        __builtin_amdgcn_s_barrier();
        asm volatile("" ::: "memory");
        const int gn = g + gridDim.x; const int bc = b, hc = h; const bf16_t* Kc = Kg; const bf16_t* Vc = Vg; bf16x8 qn[4];
        if (gn < NGRP) { SB_GROUP(gn, b, h, q0, Kg, Vg); SB_LOADQ(qn, b, h, q0 + 32 * wave); const int tl = (q0 >> 6) + 3 - wave; if (wave < SB_NSLOT && tl >= 0) SB_LOADT(Kg, Vg, 64 * tl); }
        f32x16 o[2];
#pragma unroll
        for (int r = 0; r < 16; ++r) { o[0][r] = 0.f; o[1][r] = 0.f; }
        float R = 1.0f;
        for (int T = (r0 + 31) >> 6, j = 0; T >= 0; --T, ++j) {
            const int kb = 64 * T, si = ttop - T;
            f32x16 pp[2];
#pragma unroll
            for (int r = 0; r < 16; ++r) { pp[0][r] = 0.f; pp[1][r] = 0.f; }
            const LAS unsigned char* kl = lds + si * SB_SLOT;
            if (si < SB_NSLOT) {
#pragma unroll
                for (int half = 0; half < 2; ++half)
#pragma unroll
                    for (int d0 = 0; d0 < 4; ++d0) { const bf16x8 kf = *(const LAS bf16x8*)(kl + (32 * half + r32) * SB_KROW + 32 * d0 + 16 * hi); pp[half] = MFMA32(kf, qf[d0], pp[half]); }
            } else {
#pragma unroll
                for (int half = 0; half < 2; ++half)
#pragma unroll
                    for (int d0 = 0; d0 < 4; ++d0) { const bf16x8 kf = *(const bf16x8*)(Kc + (size_t)(kb + 32 * half + r32) * NPROJ + 16 * d0 + 8 * hi); pp[half] = MFMA32(kf, qf[d0], pp[half]); }
            }
            __builtin_amdgcn_sched_barrier(0);
            if (j == 0) sb_scan<true>(pp, R, kb, r0 + r32, hi); else sb_scan<false>(pp, R, kb, r0 + r32, hi);
            __builtin_amdgcn_sched_barrier(0);
            u32x4 pw[4];
#pragma unroll
            for (int ks = 0; ks < 4; ++ks) {
                pw[ks].x = mm::cvt_pk_bf16(pp[ks >> 1][8 * (ks & 1) + 0], pp[ks >> 1][8 * (ks & 1) + 1]); pw[ks].y = mm::cvt_pk_bf16(pp[ks >> 1][8 * (ks & 1) + 2], pp[ks >> 1][8 * (ks & 1) + 3]);
                pw[ks].z = mm::cvt_pk_bf16(pp[ks >> 1][8 * (ks & 1) + 4], pp[ks >> 1][8 * (ks & 1) + 5]); pw[ks].w = mm::cvt_pk_bf16(pp[ks >> 1][8 * (ks & 1) + 6], pp[ks >> 1][8 * (ks & 1) + 7]); }
            if (si < SB_NSLOT) {
#pragma unroll
                for (int ks = 0; ks < 4; ++ks)
#pragma unroll
                    for (int dh = 0; dh < 2; ++dh) { const LAS unsigned char* vp = kl + 64 * SB_KROW + (32 * dh + r32) * SB_VROW + 32 * ks + 8 * hi;
                        const u32x2 lo = *(const LAS u32x2*)vp, hh = *(const LAS u32x2*)(vp + 16); const u32x4 vf = {lo.x, lo.y, hh.x, hh.y};
                        o[dh] = MFMA32(__builtin_bit_cast(bf16x8, vf), __builtin_bit_cast(bf16x8, pw[ks]), o[dh]); }
            } else {
#pragma unroll
                for (int ks = 0; ks < 4; ++ks)
#pragma unroll
                    for (int dh = 0; dh < 2; ++dh) { const bf16_t* vp = Vc + (size_t)(32 * dh + r32) * VT_LD + kb + 16 * ks + 4 * hi;
                        const u32x2 lo = *(const u32x2*)vp, hh = *(const u32x2*)(vp + 8); const u32x4 vf = {lo.x, lo.y, hh.x, hh.y};
                        o[dh] = MFMA32(__builtin_bit_cast(bf16x8, vf), __builtin_bit_cast(bf16x8, pw[ks]), o[dh]); }
            }
            if (__all(R == 0.0f)) break;
        }
        bf16_t* yp = YMIX + (size_t)(bc * SEQ + r0 + r32) * DM + 512 + hc * 64 + 4 * hi;
        f32x4 gv[2][4];
#pragma unroll
        for (int dh = 0; dh < 2; ++dh)
#pragma unroll
            for (int g4 = 0; g4 < 4; ++g4) gv[dh][g4] = *(const LAS f32x4*)(gl + 4 * hi + 32 * dh + 8 * g4);
        float ss = 0.f;
#pragma unroll
        for (int r = 0; r < 16; ++r) ss += o[0][r] * o[0][r] + o[1][r] * o[1][r];
        ss += __shfl_xor(ss, 32);
        const float rn = __builtin_amdgcn_rsqf(ss * (1.f / 64.f) + RMS_EPS);
#pragma unroll
        for (int dh = 0; dh < 2; ++dh)
#pragma unroll
            for (int g4 = 0; g4 < 4; ++g4) { const f32x4 gg = gv[dh][g4];
                u32x2 w; w.x = mm::cvt_pk_bf16(o[dh][4 * g4] * rn * gg[0], o[dh][4 * g4 + 1] * rn * gg[1]); w.y = mm::cvt_pk_bf16(o[dh][4 * g4 + 2] * rn * gg[2], o[dh][4 * g4 + 3] * rn * gg[3]);
                *(u32x2*)(yp + 32 * dh + 8 * g4) = w; }
#pragma unroll
        for (int d0 = 0; d0 < 4; ++d0) qf[d0] = qn[d0];
        { const int ci = g * 8 + wave, tok0 = 4 * ci, t0 = tok0 & (SEQ - 1), c0 = 8 * lane;
          u32x4 cw_[6], hw_[6], bw_[4];
#pragma unroll
          for (int i = 0; i < 6; ++i) { const int tk = (t0 == 0 && i < 2) ? tok0 : tok0 - 2 + i; const bf16_t* row = PROJ + (size_t)tk * NPROJ + c0; cw_[i] = *(const u32x4*)(row + C_CC); hw_[i] = *(const u32x4*)(row + C_CH); if (i >= 2) bw_[i - 2] = *(const u32x4*)(row + C_CB); }
          f32x4 w0l = *(const LAS f32x4*)(cwl + c0), w0h = *(const LAS f32x4*)(cwl + c0 + 4), w1l = *(const LAS f32x4*)(cwl + 512 + c0), w1h = *(const LAS f32x4*)(cwl + 512 + c0 + 4);
          f32x4 w2l = *(const LAS f32x4*)(cwl + 1024 + c0), w2h = *(const LAS f32x4*)(cwl + 1024 + c0 + 4), gl_ = *(const LAS f32x4*)(cwl + 1536 + c0), gh_ = *(const LAS f32x4*)(cwl + 1536 + c0 + 4);
          f32x4 ul[6], uh[6];
#pragma unroll
          for (int i = 0; i < 6; ++i) { ul[i] = unpack_lo(cw_[i]) * unpack_lo(hw_[i]); uh[i] = unpack_hi(cw_[i]) * unpack_hi(hw_[i]); if (t0 == 0 && i < 2) { ul[i] = ul[i] * 0.f; uh[i] = uh[i] * 0.f; } }
#pragma unroll
          for (int i = 0; i < 4; ++i) {
              const f32x4 yl = unpack_lo(bw_[i]) * (w0l * ul[i] + w1l * ul[i + 1] + w2l * ul[i + 2]), yh = unpack_hi(bw_[i]) * (w0h * uh[i] + w1h * uh[i + 1] + w2h * uh[i + 2]);
              float ssq = sq4(yl) + sq4(yh); ssq += __shfl_xor(ssq, 1); ssq += __shfl_xor(ssq, 2); ssq += __shfl_xor(ssq, 4);
              const float rnc = __builtin_amdgcn_rsqf(ssq * (1.f / 64.f) + RMS_EPS);
              *(u32x4*)(YMIX + (size_t)(tok0 + i) * DM + c0) = pack8(yl * rnc * gl_, yh * rnc * gh_); } }
        g = gn;
        asm volatile("s_waitcnt lgkmcnt(0)" ::: "memory");
        __builtin_amdgcn_s_barrier();
        asm volatile("" ::: "memory");
    }
#undef SB_LOADT
#undef SB_WRITET
#undef SB_GROUP
#undef SB_LOADQ
}
__device__ __forceinline__ void phase_conv_fast(const Params& p) {
    unsigned char* ws = p.ws; const int lane = threadIdx.x & 63, wave = threadIdx.x >> 6; const int gw = blockIdx.x * 8 + wave, NGW = gridDim.x * 8;
    const bf16_t* PROJ = (const bf16_t*)(ws + WS_PROJ); bf16_t* YMIX = (bf16_t*)(ws + WS_YMIX);
    const int c0 = 8 * lane;
    float w0[8], w1[8], w2[8], gn[8];
#pragma unroll
    for (int e = 0; e < 8; ++e) { w0[e] = p.conv_w[c0 + e]; w1[e] = p.conv_w[512 + c0 + e]; w2[e] = p.conv_w[1024 + c0 + e]; gn[e] = p.gn_conv[c0 + e]; }
    constexpr int TCH = 16;
    for (int it = gw; it < NTOK / TCH; it += NGW) {
        const int tok0 = it * TCH, t0 = tok0 % SEQ;
        float um2[8], um1[8];
#pragma unroll
        for (int e = 0; e < 8; ++e) { um2[e] = 0.f; um1[e] = 0.f; }
        if (t0 >= 2) {
            const u32x4 a2 = *(const u32x4*)(PROJ + (size_t)(tok0 - 2) * NPROJ + C_CC + c0), h2 = *(const u32x4*)(PROJ + (size_t)(tok0 - 2) * NPROJ + C_CH + c0);
            const u32x4 a1 = *(const u32x4*)(PROJ + (size_t)(tok0 - 1) * NPROJ + C_CC + c0), h1 = *(const u32x4*)(PROJ + (size_t)(tok0 - 1) * NPROJ + C_CH + c0);
            const f32x4 a2l = unpack_lo(a2), a2h = unpack_hi(a2), h2l = unpack_lo(h2), h2h = unpack_hi(h2), a1l = unpack_lo(a1), a1h = unpack_hi(a1), h1l = unpack_lo(h1), h1h = unpack_hi(h1);
#pragma unroll
            for (int e = 0; e < 4; ++e) { um2[e] = a2l[e] * h2l[e]; um2[4 + e] = a2h[e] * h2h[e]; um1[e] = a1l[e] * h1l[e]; um1[4 + e] = a1h[e] * h1h[e]; }
        }
#pragma unroll 1
        for (int i0 = 0; i0 < TCH; i0 += 4) {
            u32x4 bw[4], cw[4], hw[4];
#pragma unroll
            for (int i = 0; i < 4; ++i) { const bf16_t* row = PROJ + (size_t)(tok0 + i0 + i) * NPROJ + c0; bw[i] = *(const u32x4*)(row + C_CB); cw[i] = *(const u32x4*)(row + C_CC); hw[i] = *(const u32x4*)(row + C_CH); }
#pragma unroll
            for (int i = 0; i < 4; ++i) {
                const f32x4 bl = unpack_lo(bw[i]), bh_ = unpack_hi(bw[i]), cl = unpack_lo(cw[i]), ch_ = unpack_hi(cw[i]), hl = unpack_lo(hw[i]), hh = unpack_hi(hw[i]);
                float y[8], ss = 0.f;
#pragma unroll
                for (int e = 0; e < 8; ++e) { const float u = (e < 4 ? cl[e & 3] * hl[e & 3] : ch_[e & 3] * hh[e & 3]); const float bb = e < 4 ? bl[e & 3] : bh_[e & 3];
                    y[e] = bb * (w0[e] * um2[e] + w1[e] * um1[e] + w2[e] * u); um2[e] = um1[e]; um1[e] = u; ss += y[e] * y[e]; }
                ss += __shfl_xor(ss, 1); ss += __shfl_xor(ss, 2); ss += __shfl_xor(ss, 4);
                const float rn = __builtin_amdgcn_rsqf(ss * (1.f / 64.f) + RMS_EPS);
                f32x4 ol, oh;
#pragma unroll
                for (int e = 0; e < 4; ++e) { ol[e] = y[e] * rn * gn[e]; oh[e] = y[4 + e] * rn * gn[4 + e]; }
                *(u32x4*)(YMIX + (size_t)(tok0 + i0 + i) * DM + c0) = pack8(ol, oh);
            }
        }
    }
}
constexpr int XA_KROW = 528, XA_VROW = 528;
__device__ __forceinline__ void phase_xattn_fast(const Params& p, LAS unsigned char* lds) {
    unsigned char* ws = p.ws; const int tid = threadIdx.x, lane = tid & 63, wave = __builtin_amdgcn_readfirstlane(tid >> 6), r32 = lane & 31, hi = lane >> 5;
    const bf16_t* QM = (const bf16_t*)(ws + WS_QM); const bf16_t* MK = (const bf16_t*)(ws + WS_MEMK); const bf16_t* MVT = (const bf16_t*)(ws + WS_MEMVT); bf16_t* OB = (bf16_t*)(ws + WS_OB);
    const int G = gridDim.x, vcu = (G % 8 == 0) ? ((int)blockIdx.x % 8) * (G / 8) + (int)blockIdx.x / 8 : (int)blockIdx.x;
#define XA_BAR() do { asm volatile("s_waitcnt lgkmcnt(0)" ::: "memory"); __builtin_amdgcn_s_barrier(); asm volatile("" ::: "memory"); } while (0)
#define XA_LOADK(Kg_) do { _Pragma("unroll") for (int i = 0; i < 16; ++i) { const int c = tid + 512 * i; st[i] = *(const u32x4*)((Kg_) + (size_t)(c >> 5) * DM + 8 * (c & 31)); } } while (0)
#define XA_WRITEK() do { _Pragma("unroll") for (int i = 0; i < 16; ++i) { const int c = tid + 512 * i; *(LAS u32x4*)(lds + (c >> 5) * XA_KROW + 16 * (c & 31)) = st[i]; } } while (0)
#define XA_LOADV(Vg_) do { _Pragma("unroll") for (int i = 0; i < 16; ++i) { const int c = tid + 512 * i; st[i] = *(const u32x4*)((Vg_) + (size_t)(c >> 5) * MVT_LD + 8 * (c & 31)); } } while (0)
#define XA_WRITEV() do { _Pragma("unroll") for (int i = 0; i < 16; ++i) { const int c = tid + 512 * i, pc = c & 31; LAS unsigned char* d_ = lds + (c >> 5) * XA_VROW + 32 * (pc >> 1) + 8 * (pc & 1); \
            *(LAS u32x2*)d_ = (u32x2){st[i].x, st[i].y}; *(LAS u32x2*)(d_ + 16) = (u32x2){st[i].z, st[i].w}; } } while (0)
    u32x4 st[16];
    for (int U = vcu; U < NB * MH * 8; U += G) {
        const int bm = U >> 3, qblk = U & 7, b = bm >> 2, mh = bm & 3, q0 = qblk * 256 + wave * 32;
        const bf16_t* Vg = MVT + (size_t)(mh * MHD) * MVT_LD + b * MEML;
        const bf16_t* qp = QM + (size_t)(b * SEQ + q0 + r32) * DM + mh * MHD + 8 * hi;
        XA_LOADK(MK + (size_t)(b * MEML) * DM + mh * MHD);
        XA_WRITEK();
        __builtin_amdgcn_sched_barrier(0);
        bf16x8 qa[2], qb[2], qc[2];
#pragma unroll
        for (int sk = 0; sk < 2; ++sk) { qa[sk] = *(const bf16x8*)(qp + 16 * sk); qb[sk] = *(const bf16x8*)(qp + 32 + 16 * sk); qc[sk] = *(const bf16x8*)(qp + 64 + 16 * sk); }
        XA_BAR();
        f32x16 s[8];
#pragma unroll
        for (int kt = 0; kt < 8; ++kt)
#pragma unroll
            for (int r = 0; r < 16; ++r) s[kt][r] = 0.f;
#pragma unroll 1
        for (int sig = 0; sig < 8; ++sig) {
            bf16x8 qd[2];
#pragma unroll
            for (int sk = 0; sk < 2; ++sk) qd[sk] = (sig < 5) ? *(const bf16x8*)(qp + 32 * (sig + 3) + 16 * sk) : qc[sk];
            const LAS unsigned char* kb_ = lds + r32 * XA_KROW + 64 * sig + 16 * hi;
#pragma unroll
            for (int kt = 0; kt < 8; ++kt)
#pragma unroll
                for (int sk = 0; sk < 2; ++sk) { const bf16x8 kf = *(const LAS bf16x8*)(kb_ + kt * 32 * XA_KROW + 32 * sk); s[kt] = MFMA32(kf, qa[sk], s[kt]); }
#pragma unroll
            for (int sk = 0; sk < 2; ++sk) { qa[sk] = qb[sk]; qb[sk] = qc[sk]; qc[sk] = qd[sk]; }
        }
        float mx = s[0][0];
#pragma unroll
        for (int kt = 0; kt < 8; ++kt)
#pragma unroll
            for (int r = 0; r < 16; ++r) mx = fmaxf(mx, s[kt][r]);
        mx = fmaxf(mx, __shfl_xor(mx, 32));
        float sum = 0.f;
#pragma unroll
        for (int kt = 0; kt < 8; ++kt)
#pragma unroll
            for (int r = 0; r < 16; ++r) { s[kt][r] = __builtin_amdgcn_exp2f(s[kt][r] - mx); sum += s[kt][r]; }
        sum += __shfl_xor(sum, 32);
        const float inv = __builtin_amdgcn_rcpf(sum);
        u32x4 pw[16];
#pragma unroll
        for (int ks = 0; ks < 16; ++ks) { const int kt = ks >> 1, r0_ = 8 * (ks & 1);
            pw[ks].x = mm::cvt_pk_bf16(s[kt][r0_ + 0], s[kt][r0_ + 1]); pw[ks].y = mm::cvt_pk_bf16(s[kt][r0_ + 2], s[kt][r0_ + 3]);
            pw[ks].z = mm::cvt_pk_bf16(s[kt][r0_ + 4], s[kt][r0_ + 5]); pw[ks].w = mm::cvt_pk_bf16(s[kt][r0_ + 6], s[kt][r0_ + 7]); }
        __builtin_amdgcn_sched_barrier(0);
        XA_LOADV(Vg);
        XA_BAR();
        XA_WRITEV();
        XA_BAR();
        bf16_t* op = OB + (size_t)(b * SEQ + q0 + r32) * DM + mh * MHD + 4 * hi;
#pragma unroll 1
        for (int dt = 0; dt < 8; ++dt) {
            f32x16 o;
#pragma unroll
            for (int r = 0; r < 16; ++r) o[r] = 0.f;
            const LAS unsigned char* vb_ = lds + (32 * dt + r32) * XA_VROW + 16 * hi;
#pragma unroll
            for (int ks = 0; ks < 16; ++ks) { const bf16x8 vf = *(const LAS bf16x8*)(vb_ + 32 * ks);
                o = MFMA32(vf, __builtin_bit_cast(bf16x8, pw[ks]), o); }
#pragma unroll
            for (int g = 0; g < 4; ++g) { u32x2 w; w.x = mm::cvt_pk_bf16(o[4 * g] * inv, o[4 * g + 1] * inv); w.y = mm::cvt_pk_bf16(o[4 * g + 2] * inv, o[4 * g + 3] * inv);
                *(u32x2*)(op + 32 * dt + 8 * g) = w; }
        }
        XA_BAR();
    }
#undef XA_BAR
#undef XA_LOADK
#undef XA_WRITEK
#undef XA_LOADV
#undef XA_WRITEV
}

constexpr size_t WS_BAR = 2 * MiB + 65536;
#define XB_TMO      128
#define XB_XCNT(j)  (256  + 64 * (j))
#define XB_XSUB(j)  (1280 + 64 * (j))
#define XB_XGEN(j)  (2304 + 64 * (j))
#define XB_TOP      3328
#define XB_TOPGEN   3392
#define XCD_BAR_WORDS 3456
#define XB_SPIN_CAP (1u << 22)
__device__ __forceinline__ unsigned xb_ld(unsigned* q)              { return __hip_atomic_load(q, __ATOMIC_RELAXED, __HIP_MEMORY_SCOPE_AGENT); }
__device__ __forceinline__ unsigned xb_add(unsigned* q, unsigned v) { return __hip_atomic_fetch_add(q, v, __ATOMIC_RELAXED, __HIP_MEMORY_SCOPE_AGENT); }
__device__ __forceinline__ unsigned xb_xcc_id() { return (unsigned)__builtin_amdgcn_s_getreg((3 << 11) | 20) & 0xFu; }
#define XB_SPIN(cond, bar) do { unsigned _sp = 0; while (cond) { __builtin_amdgcn_s_sleep(1); \
    if ((++_sp & 255u) == 0u) { if (xb_ld(&(bar)[XB_TMO])) break; if (_sp > XB_SPIN_CAP) { atomicAdd(&(bar)[XB_TMO], 1u); break; } } } } while (0)
struct XcdBarrier { unsigned* bar; unsigned x; unsigned nloc, nx; };
__device__ __forceinline__ XcdBarrier xcd_barrier_post(unsigned* bar) {
    XcdBarrier b; b.bar = bar; b.x = xb_xcc_id(); b.nloc = 0u; b.nx = 0u;
    if (threadIdx.x == 0) (void)xb_add(&bar[XB_XCNT(b.x)], 1u);
    return b;
}
__device__ __forceinline__ void xcd_barrier_complete(unsigned* bar, unsigned x, unsigned& nloc, unsigned& nx) {
    const unsigned G = gridDim.x * gridDim.y * gridDim.z;
    unsigned sum, cnt, mine, sp = 0u;
    for (;;) {
        sum = 0u; cnt = 0u; mine = 0u;
#pragma unroll
        for (unsigned j = 0; j < 16; ++j) { const unsigned c = xb_ld(&bar[XB_XCNT(j)]); sum += c; cnt += (c > 0u) ? 1u : 0u; mine = (j == x) ? c : mine; }
        if (sum == G) break;
        __builtin_amdgcn_s_sleep(1);
        if ((++sp & 255u) == 0u) { if (xb_ld(&bar[XB_TMO])) break; if (sp > XB_SPIN_CAP) { atomicAdd(&bar[XB_TMO], 1u); break; } }
    }
    nloc = mine > 0u ? mine : 1u; nx = cnt > 0u ? cnt : 1u;
}
__device__ __forceinline__ void xcd_barrier(XcdBarrier& b) {
    asm volatile("s_waitcnt vmcnt(0)" ::: "memory");
    __syncthreads();
    if (threadIdx.x == 0) {
        unsigned* bar = b.bar;
        __builtin_amdgcn_s_waitcnt(0);
        unsigned nloc = b.nloc, nx = b.nx;
        if (nloc == 0u) { xcd_barrier_complete(bar, b.x, nloc, nx); b.nloc = nloc; b.nx = nx; }
        const unsigned old = xb_add(&bar[XB_XSUB(b.x)], 1u);
        const unsigned gen = old / nloc;
        if (old + 1u == (gen + 1u) * nloc) {
            __builtin_amdgcn_fence(__ATOMIC_RELEASE, "agent");
            asm volatile("s_waitcnt vmcnt(0)" ::: "memory");
            const unsigned og = xb_add(&bar[XB_TOP], 1u);
            const unsigned tg = og / nx;
            if (og + 1u == (tg + 1u) * nx) xb_add(&bar[XB_TOPGEN], 1u);
            else XB_SPIN(xb_ld(&bar[XB_TOPGEN]) == tg, bar);
            __builtin_amdgcn_fence(__ATOMIC_ACQUIRE, "agent");
            xb_add(&bar[XB_XGEN(b.x)], 1u);
            asm volatile("s_waitcnt vmcnt(0)" ::: "memory");
        } else {
            XB_SPIN(xb_ld(&bar[XB_XGEN(b.x)]) == gen, bar);
            __builtin_amdgcn_fence(__ATOMIC_ACQUIRE, "agent");
            asm volatile("s_waitcnt vmcnt(0)" ::: "memory");
        }
    }
    __syncthreads();
}

__global__ void __launch_bounds__(512, 2) fwd_kernel(Params p) {
    extern __shared__ __attribute__((aligned(16))) unsigned char lds[];
    cg::grid_group grid = cg::this_grid();
#ifndef ONLY
#define ONLY -1
#endif
#ifdef PMASK
#define RUNP(k) ((PMASK >> (k)) & 1)
#else
#define RUNP(k) (ONLY < 0 || ONLY == (k))
#endif
    const int lo = p.ph_lo, hi = p.ph_hi;
    XcdBarrier xbar = xcd_barrier_post((unsigned*)(p.ws + WS_BAR));
    LAS unsigned char* l3 = (LAS unsigned char*)lds;
#ifndef FASTMASK
#define FASTMASK 0x6FE
#endif
#define FAST(k) ((FASTMASK >> (k)) & 1)
#define IN(k) (RUNP(k) && lo <= (k) && (k) < hi)
#ifndef PROBE_PH
#define PROBE_PH -1
#endif
#define STAMP(k) do { if (PROBE_PH >= 0 && blockIdx.x == 0 && threadIdx.x == 0) ((volatile unsigned long long*)(p.ws + WS_CNT + 1024))[k] = __builtin_amdgcn_s_memrealtime(); } while (0)
#define SEAM(k) do { if (lo <= (k) && (k) + 1 < hi) xcd_barrier(xbar); STAMP((k) + 1); } while (0)
    STAMP(0);
    if (hi > 1000) grid.sync();
    if (IN(0)) { phase_prep(p, lds); }
    SEAM(0);
    if (IN(1)) { if (FAST(1)) phase_proj_fast(p, l3); else phase_proj_simple(p); } SEAM(1);
    if (IN(2)) { finalize_colsums(p); if (FAST(2)) { phase_sb_fast(p, l3); } else { phase_conv_simple(p); phase_sb_simple(p); } } SEAM(2);
    if (IN(3)) { if (FAST(3)) phase_outproj_fast(p, l3); else phase_outproj_simple(p); } SEAM(3);
    if (IN(4)) { if (FAST(4)) phase_mq_fast(p, l3); else phase_mq_simple(p); } SEAM(4);
    if (IN(5)) { if (FAST(5)) phase_xattn_fast(p, l3); else phase_xattn_simple(p, lds); } SEAM(5);
    if (IN(6)) { if (FAST(6)) phase_mo_fast(p, l3); else phase_mo_simple(p); } SEAM(6);
    if (IN(7)) { if (FAST(7)) phase_router_fast(p, l3); else phase_router_simple(p); } SEAM(7);
    if (IN(8)) { if (!(FAST(7) && gridDim.x == NTOK / 256)) phase_route(p, lds); }
    if (!(FAST(7) && gridDim.x == NTOK / 256)) SEAM(8); else STAMP(9);
    if (IN(9)) { if (FAST(9)) phase_moe1_fast(p, l3); else phase_moe1_simple(p); } SEAM(9);
    if (IN(10)) { if (FAST(10)) phase_moe2_fast(p, l3); else phase_moe2_simple(p); } SEAM(10);
    if (IN(11)) { phase_final(p); }
    if (PROBE_PH >= 0 && blockIdx.x == 0 && threadIdx.x == 0) {
        STAMP(12);
        volatile unsigned long long* ts = (volatile unsigned long long*)(p.ws + WS_CNT + 1024);
        const unsigned long long d = (ts[PROBE_PH + 1] - ts[PROBE_PH]) * 8ull, t0 = __builtin_amdgcn_s_memrealtime();
        while (__builtin_amdgcn_s_memrealtime() - t0 < d) __builtin_amdgcn_s_sleep(8);
    }
}

extern "C" void kernel_launch(void* const* d_in, const int* in_sizes, int n_in, void* d_out, int out_size, void* d_ws, size_t ws_size, hipStream_t stream) {
    static int grid = 0;
    if (grid == 0) {
        if (n_in != 24 || out_size != NTOK * DM || ws_size < WS_END) { fprintf(stderr, "kernel_launch: unexpected problem: n_in %d out %d ws %zu\n", n_in, out_size, ws_size); grid = -1; return; }
        int dev = 0, cus = 0, per_cu = 0;
        (void)hipGetDevice(&dev); (void)hipDeviceGetAttribute(&cus, hipDeviceAttributeMultiprocessorCount, dev);
        (void)hipFuncSetAttribute((const void*)fwd_kernel, hipFuncAttributeMaxDynamicSharedMemorySize, LDS_BYTES);
        (void)hipOccupancyMaxActiveBlocksPerMultiprocessor(&per_cu, (const void*)fwd_kernel, 512, LDS_BYTES);
        if (per_cu < 1) { fprintf(stderr, "kernel_launch: occupancy query reports %d blocks per CU\n", per_cu); }
        grid = cus;
    }
    if (grid < 0) return;
    if (hipMemsetAsync(d_ws, 0, WS_ZERO_BYTES, stream) != hipSuccess) { fprintf(stderr, "kernel_launch: hipMemsetAsync failed\n"); return; }
    Params p{};
    const float** f = (const float**)&p;
    for (int i = 0; i < 24; ++i) f[i] = (const float*)d_in[i];
    p.out = (float*)d_out; p.ws = (unsigned char*)d_ws;
#if MK_ONE_LAUNCH
    p.ph_lo = 0; p.ph_hi = NPHASE;
    void* args[] = {&p};
    hipError_t e = hipLaunchCooperativeKernel((void*)fwd_kernel, dim3(grid), dim3(512), args, LDS_BYTES, stream);
    if (e != hipSuccess) fprintf(stderr, "cooperative launch failed: %s\n", hipGetErrorString(e));
#else
    for (int ph = 0; ph < NPHASE; ++ph) {
        p.ph_lo = ph; p.ph_hi = ph + 1;
        void* args[] = {&p};
        hipError_t e = hipLaunchCooperativeKernel((void*)fwd_kernel, dim3(grid), dim3(512), args, LDS_BYTES, stream);
        if (e != hipSuccess) { fprintf(stderr, "launch %d failed: %s\n", ph, hipGetErrorString(e)); break; }
    }
#endif
}
```

```cpp
#include <hip/hip_runtime.h>
#include <hip/hip_cooperative_groups.h>
#include <cstdio>
#include <cstdint>
namespace cg = cooperative_groups;

#ifndef MK_ONE_LAUNCH
#define MK_ONE_LAUNCH 1
#endif

typedef unsigned short bf16_t;
typedef short bf16x8 __attribute__((ext_vector_type(8)));
typedef float f32x4 __attribute__((ext_vector_type(4)));
typedef float f32x16 __attribute__((ext_vector_type(16)));
typedef unsigned u32x4 __attribute__((ext_vector_type(4)));
typedef unsigned u32x2 __attribute__((ext_vector_type(2)));

constexpr int NB = 32, SEQ = 2048, DM = 1024, NTOK = NB * SEQ;
constexpr int MEML = 256, NMEM = NB * MEML;
constexpr int NPROJ = 2560;
constexpr int PW = 3072;
constexpr int C_CB = 0, C_CC = 512, C_CH = 1024, C_Q = 1536, C_K = 2048, C_V = 2560;
constexpr int NHEAD = 8, HD = 64;
constexpr int MH = 4, MHD = 256;
constexpr int NEXP = 32, DEXP = 512, NLOG = 36, NLOGP = 64;
constexpr int CAP = 2 * NTOK;
constexpr float ALPHA = 1.189207115002721f;
constexpr float LN_EPS = 1e-5f, RMS_EPS = 1e-6f;
constexpr float LOG2E = 1.4426950408889634f;
constexpr float QS_SB = 0.125f * LOG2E;
constexpr float QS_X = 0.0625f * LOG2E;

constexpr size_t MiB = 1u << 20;
constexpr size_t WS_STATS1 = 0;
constexpr size_t WS_STATS2 = 1 * MiB;
constexpr size_t WS_CNT = 2 * MiB;
constexpr size_t WS_CS1 = 2 * MiB + 4096;
constexpr size_t WS_CS2 = WS_CS1 + 8192;
constexpr size_t WS_CSGU = 3 * MiB;
constexpr size_t WS_EID = 4 * MiB;
constexpr size_t WS_GATE = 5 * MiB;
constexpr size_t WS_CSI = 6 * MiB;
constexpr size_t WS_CSB = 7 * MiB;
constexpr size_t WS_BSB = 7 * MiB + 512 * 1024;
constexpr size_t WS_ZERO_BYTES = 8 * MiB;
constexpr size_t WS_LOGIT = 8 * MiB;
constexpr size_t WS_ROWL = 24 * MiB;
constexpr size_t WS_WRT = 40 * MiB;
constexpr size_t WS_WIN = 64 * MiB;
constexpr size_t WS_WOUT = 70 * MiB;
constexpr size_t WS_WMQ = 72 * MiB, WS_WMK = 74 * MiB, WS_WMV = 76 * MiB, WS_WMO = 78 * MiB;
constexpr size_t WS_WGU = 80 * MiB;
constexpr size_t WS_WD = 144 * MiB;
constexpr size_t WS_XB = 192 * MiB;
constexpr size_t WS_T1B = 192 * MiB;
constexpr size_t WS_MEMB = 320 * MiB;
constexpr size_t WS_MEMK = 336 * MiB;
constexpr size_t WS_MEMVT = 352 * MiB;
constexpr size_t WS_PROJ = 370 * MiB;
constexpr size_t WS_QM = 370 * MiB;
constexpr size_t WS_WQK = 883 * MiB;
constexpr size_t WS_VWT = 947 * MiB;
constexpr size_t WS_WQP = 42 * MiB;
constexpr size_t WS_MEMV = 352 * MiB;
constexpr size_t WS_OB = 498 * MiB;
constexpr size_t WS_Y = 370 * MiB;
constexpr size_t WS_VT = 690 * MiB;
constexpr size_t WS_YMIX = 755 * MiB;
constexpr size_t WS_T2B = 755 * MiB;
constexpr size_t WS_H = 883 * MiB;
constexpr size_t WS_END = 1019 * MiB;
constexpr int VT_LD = NTOK + 64, MVT_LD = NMEM + 64;

constexpr int LDS_BYTES = 147456;
constexpr int NPHASE = 12;

struct Params {
    const float *x, *mem, *w_in, *conv_w, *gn_conv, *gn_sb, *w_out, *ln1_g, *ln1_b, *w_mq, *w_mk, *w_mv, *w_mo, *ln2_g, *ln2_b,
        *w_rg, *b_rg, *w_re, *b_re, *w_gate, *w_up, *w_down, *ln3_g, *ln3_b;
    float* out; unsigned char* ws; int ph_lo, ph_hi;
};

#define LAS __attribute__((address_space(3)))
__device__ __forceinline__ float bf2f(bf16_t v) { return __uint_as_float((unsigned)v << 16); }
__device__ __forceinline__ bf16_t f2bf(float f) { unsigned u = __float_as_uint(f); return (bf16_t)((u + 0x7fffu + ((u >> 16) & 1u)) >> 16); }
__device__ __forceinline__ unsigned pk2(float lo, float hi) { return (unsigned)f2bf(lo) | ((unsigned)f2bf(hi) << 16); }
__device__ __forceinline__ float wave_sum(float v) {
#pragma unroll
    for (int o = 1; o < 64; o <<= 1) v += __shfl_xor(v, o);
    return v;
}
__device__ __forceinline__ float wave_max(float v) {
#pragma unroll
    for (int o = 1; o < 64; o <<= 1) v = fmaxf(v, __shfl_xor(v, o));
    return v;
}
__device__ __forceinline__ f32x4 unpack_lo(const u32x4 w) { return (f32x4){__uint_as_float(w.x << 16), __uint_as_float(w.x & 0xffff0000u), __uint_as_float(w.y << 16), __uint_as_float(w.y & 0xffff0000u)}; }
__device__ __forceinline__ f32x4 unpack_hi(const u32x4 w) { return (f32x4){__uint_as_float(w.z << 16), __uint_as_float(w.z & 0xffff0000u), __uint_as_float(w.w << 16), __uint_as_float(w.w & 0xffff0000u)}; }
__device__ __forceinline__ float sum4(const f32x4 v) { return (v[0] + v[1]) + (v[2] + v[3]); }
__device__ __forceinline__ float sq4(const f32x4 v) { return (v[0] * v[0] + v[1] * v[1]) + (v[2] * v[2] + v[3] * v[3]); }
#define MFMA32(a, b, c) __builtin_amdgcn_mfma_f32_32x32x16_bf16((a), (b), (c), 0, 0, 0)

template <int NBLK, class AR, class BR>
__device__ __forceinline__ void wave_tile(int K, AR arow, BR brow, f32x16 (&c)[2][2 * NBLK]) {
    const int lane = threadIdx.x & 63, r = lane & 31, h = lane >> 5;
    const bf16_t* ap[2]; const bf16_t* bp[2 * NBLK];
#pragma unroll
    for (int i = 0; i < 2; ++i) ap[i] = arow(32 * i + r) + 8 * h;
#pragma unroll
    for (int j = 0; j < 2 * NBLK; ++j) bp[j] = brow(32 * j + r) + 8 * h;
#pragma unroll
    for (int i = 0; i < 2; ++i)
#pragma unroll
        for (int j = 0; j < 2 * NBLK; ++j)
#pragma unroll
            for (int q = 0; q < 16; ++q) c[i][j][q] = 0.f;
#pragma unroll 2
    for (int k = 0; k < K; k += 16) {
        bf16x8 fa[2], fb[2 * NBLK];
#pragma unroll
        for (int i = 0; i < 2; ++i) fa[i] = *(const bf16x8*)(ap[i] + k);
#pragma unroll
        for (int j = 0; j < 2 * NBLK; ++j) fb[j] = *(const bf16x8*)(bp[j] + k);
#pragma unroll
        for (int i = 0; i < 2; ++i)
#pragma unroll
            for (int j = 0; j < 2 * NBLK; ++j) c[i][j] = MFMA32(fa[i], fb[j], c[i][j]);
    }
}
#define TROW(i, q) (32 * (i) + ((q) & 3) + 8 * ((q) >> 2) + 4 * ((int)(threadIdx.x & 63) >> 5))
#define TCOL(j) (32 * (j) + (int)(threadIdx.x & 31))

struct RowStat { float mean, rstd; };
typedef long long stat_t;
constexpr float STAT_SCALE = 16777216.0f, STAT_INV = 1.0f / 16777216.0f;
__device__ __forceinline__ void stat_add(stat_t* st, int row, float s, float q) {
    atomicAdd((unsigned long long*)st + 2 * row, (unsigned long long)__float2ll_rn(s * STAT_SCALE)); atomicAdd((unsigned long long*)st + 2 * row + 1, (unsigned long long)__float2ll_rn(q * STAT_SCALE)); }
__device__ __forceinline__ RowStat row_stat(const stat_t* st, int row) {
    const float s = (float)st[2 * row] * STAT_INV, q = (float)st[2 * row + 1] * STAT_INV;
    RowStat r; r.mean = s * (1.f / DM); const float var = fmaxf(q * (1.f / DM) - r.mean * r.mean, 0.f); r.rstd = __builtin_amdgcn_rsqf(var + LN_EPS); return r;
}

constexpr float CS_SCALE = 4294967296.0f, CS_INV = 1.0f / 4294967296.0f;
__device__ __forceinline__ void transpose_item(const float* W, int K, int N, int k0, int n0, bf16_t* WT, int orow0, const float* ks, float ns, const float* bvec, stat_t* csum, stat_t* bsum, int oidx0,
                                               LAS float* scr, int lane) {
    const int rq = lane >> 4, c4 = (lane & 15) * 4;
    f32x4 cs = {0.f, 0.f, 0.f, 0.f}, bs = {0.f, 0.f, 0.f, 0.f};
    f32x4 wv[16];
#pragma unroll
    for (int i = 0; i < 16; ++i) wv[i] = __builtin_nontemporal_load((const f32x4*)(W + (size_t)(k0 + 4 * i + rq) * N + n0 + c4));
#pragma unroll
    for (int i = 0; i < 16; ++i) { const int kk = 4 * i + rq; f32x4 v = wv[i];
        if (csum) { const float bk = bvec[k0 + kk] * ns; bs += v * bk; }
        if (ks) v = v * ks[k0 + kk];
        v = v * ns;
        if (csum) { cs[0] += bf2f(f2bf(v[0])); cs[1] += bf2f(f2bf(v[1])); cs[2] += bf2f(f2bf(v[2])); cs[3] += bf2f(f2bf(v[3])); }
        LAS float* d = scr + kk * 65 + c4; d[0] = v[0]; d[1] = v[1]; d[2] = v[2]; d[3] = v[3]; }
    if (csum) {
#pragma unroll
        for (int e = 0; e < 4; ++e) { cs[e] += __shfl_xor(cs[e], 16); cs[e] += __shfl_xor(cs[e], 32); bs[e] += __shfl_xor(bs[e], 16); bs[e] += __shfl_xor(bs[e], 32); }
        if (rq == 0) {
#pragma unroll
            for (int e = 0; e < 4; ++e) { atomicAdd((unsigned long long*)csum + oidx0 + c4 + e, (unsigned long long)__float2ll_rn(cs[e] * CS_SCALE)); atomicAdd((unsigned long long*)bsum + oidx0 + c4 + e, (unsigned long long)__float2ll_rn(bs[e] * CS_SCALE)); } }
    }
    asm volatile("s_waitcnt lgkmcnt(0)" ::: "memory");
    const int c = lane & 7;
#pragma unroll
    for (int j = 0; j < 8; ++j) { const int n = (lane >> 3) + 8 * j; const LAS float* sp = scr + (8 * c) * 65 + n;
        u32x4 o; o.x = pk2(sp[0 * 65], sp[1 * 65]); o.y = pk2(sp[2 * 65], sp[3 * 65]); o.z = pk2(sp[4 * 65], sp[5 * 65]); o.w = pk2(sp[6 * 65], sp[7 * 65]);
        *(u32x4*)(WT + (size_t)(orow0 + n) * K + k0 + 8 * c) = o; }
    asm volatile("s_waitcnt lgkmcnt(0)" ::: "memory");
}
__device__ void phase_prep(const Params& p, unsigned char* lds) {
    unsigned char* ws = p.ws;
    const int tid = threadIdx.x, lane = tid & 63, wave = tid >> 6;
    const int gw = blockIdx.x * 8 + wave, NGW = gridDim.x * 8;
    const int gt = blockIdx.x * 512 + tid, NGT = gridDim.x * 512;
    LAS float* scr = (LAS float*)((LAS unsigned char*)lds + wave * 16640);
    bf16_t* WIN = (bf16_t*)(ws + WS_WIN); bf16_t* WOUT = (bf16_t*)(ws + WS_WOUT); bf16_t* WMQ = (bf16_t*)(ws + WS_WMQ); bf16_t* WMK = (bf16_t*)(ws + WS_WMK);
    bf16_t* WMV = (bf16_t*)(ws + WS_WMV); bf16_t* WMO = (bf16_t*)(ws + WS_WMO); bf16_t* WGU = (bf16_t*)(ws + WS_WGU); bf16_t* WD = (bf16_t*)(ws + WS_WD);
    stat_t* ci = (stat_t*)(ws + WS_CSI);
    { const f32x4* x4 = (const f32x4*)p.x; u32x4* xb4 = (u32x4*)(ws + WS_XB);
      constexpr int NX = NTOK * DM / 8;
      for (int i = gt; i < NX; i += 4 * NGT) { f32x4 v[8];
#pragma unroll
          for (int u = 0; u < 4; ++u) { const int j = i + u * NGT; if (j < NX) { v[2 * u] = __builtin_nontemporal_load(x4 + 2 * j); v[2 * u + 1] = __builtin_nontemporal_load(x4 + 2 * j + 1); } }
#pragma unroll
          for (int u = 0; u < 4; ++u) { const int j = i + u * NGT; if (j < NX) { u32x4 o; o.x = pk2(v[2 * u].x, v[2 * u].y); o.y = pk2(v[2 * u].z, v[2 * u].w); o.z = pk2(v[2 * u + 1].x, v[2 * u + 1].y); o.w = pk2(v[2 * u + 1].z, v[2 * u + 1].w); xb4[j] = o; } } }
      const f32x4* m4 = (const f32x4*)p.mem; u32x4* mb4 = (u32x4*)(ws + WS_MEMB);
      constexpr int NM = NMEM * DM / 8;
      for (int i = gt; i < NM; i += 4 * NGT) { f32x4 v[8];
#pragma unroll
          for (int u = 0; u < 4; ++u) { const int j = i + u * NGT; if (j < NM) { v[2 * u] = __builtin_nontemporal_load(m4 + 2 * j); v[2 * u + 1] = __builtin_nontemporal_load(m4 + 2 * j + 1); } }
#pragma unroll
          for (int u = 0; u < 4; ++u) { const int j = i + u * NGT; if (j < NM) { u32x4 o; o.x = pk2(v[2 * u].x, v[2 * u].y); o.y = pk2(v[2 * u].z, v[2 * u].w); o.z = pk2(v[2 * u + 1].x, v[2 * u + 1].y); o.w = pk2(v[2 * u + 1].z, v[2 * u + 1].w); mb4[j] = o; } } } }
    constexpr int I_IN = 16 * 48, I_SQ = 16 * 16, I_G = 32 * 16 * 8, I_D = 32 * 8 * 16;
    constexpr int NITEMS = I_IN + 5 * I_SQ + 2 * I_G + I_D;
    for (int it = gw; it < NITEMS; it += NGW) {
        int r = it;
        if (r < I_IN) { const int kb = r / 48, n0 = (r % 48) * 64; transpose_item(p.w_in, DM, PW, kb * 64, n0, WIN, n0, nullptr, (n0 >= C_Q && n0 < C_K) ? QS_SB : 1.f, nullptr, nullptr, nullptr, 0, scr, lane); continue; } r -= I_IN;
        if (r < I_SQ) { transpose_item(p.w_out, DM, DM, (r / 16) * 64, (r % 16) * 64, WOUT, (r % 16) * 64, nullptr, 1.f, nullptr, nullptr, nullptr, 0, scr, lane); continue; } r -= I_SQ;
        if (r < I_SQ) { transpose_item(p.w_mq, DM, DM, (r / 16) * 64, (r % 16) * 64, WMQ, (r % 16) * 64, p.ln1_g, QS_X, p.ln1_b, ci, ci + 1024, (r % 16) * 64, scr, lane); continue; } r -= I_SQ;
        if (r < I_SQ) { transpose_item(p.w_mk, DM, DM, (r / 16) * 64, (r % 16) * 64, WMK, (r % 16) * 64, nullptr, 1.f, nullptr, nullptr, nullptr, 0, scr, lane); continue; } r -= I_SQ;
        if (r < I_SQ) { transpose_item(p.w_mv, DM, DM, (r / 16) * 64, (r % 16) * 64, WMV, (r % 16) * 64, nullptr, 1.f, nullptr, nullptr, nullptr, 0, scr, lane); continue; } r -= I_SQ;
        if (r < I_SQ) { transpose_item(p.w_mo, DM, DM, (r / 16) * 64, (r % 16) * 64, WMO, (r % 16) * 64, nullptr, 1.f, nullptr, nullptr, nullptr, 0, scr, lane); continue; } r -= I_SQ;
        if (r < 2 * I_G) { const int up = r >= I_G; if (up) r -= I_G; const int e = r / 128, q = r % 128, kb = q / 8, n0 = (q % 8) * 64;
            const float* W = (up ? p.w_up : p.w_gate) + (size_t)e * DM * DEXP; const int orow0 = 256 * (n0 / 128) + (up ? 128 : 0) + (n0 % 128);
            transpose_item(W, DM, DEXP, kb * 64, n0, WGU + (size_t)e * 1024 * 1024, orow0, p.ln2_g, 1.f, p.ln2_b, ci + 2048, ci + 2048 + NEXP * 1024, e * 1024 + orow0 - (0), scr, lane); continue; } r -= 2 * I_G;
        { const int e = r / 128, q = r % 128, kb = q / 16, n0 = (q % 16) * 64; transpose_item(p.w_down + (size_t)e * DEXP * DM, DEXP, DM, kb * 64, n0, WD + (size_t)e * 1024 * 512, n0, nullptr, 1.f, nullptr, nullptr, nullptr, 0, scr, lane); }
    }
    { bf16_t* WQP = (bf16_t*)(ws + WS_WQP); const f32x4* w4 = (const f32x4*)p.w_mq; u32x2* o2 = (u32x2*)WQP;
      for (int i = gt; i < DM * DM / 4; i += NGT) { const f32x4 v = w4[i] * (p.ln1_g[i / (DM / 4)] * QS_X); u32x2 o; o.x = pk2(v.x, v.y); o.y = pk2(v.z, v.w); o2[i] = o; } }
    { bf16_t* WRT = (bf16_t*)(ws + WS_WRT);
      for (int i = gt; i < 256 * DM; i += NGT) { const int n = i / DM, k = i % DM; float v = 0.f;
          if (n < 4) v = p.w_rg[k * 4 + n] * p.ln2_g[k]; else if (n < NLOG) v = p.w_re[k * 32 + (n - 4)] * p.ln2_g[k];
          WRT[i] = f2bf(v); }
      float* cs2 = (float*)(ws + WS_CS2); float* bs2 = cs2 + 64;
      for (int n = gw; n < 64; n += NGW) { float cs = 0.f, bs = 0.f;
          if (n < NLOG) { float wv[16];
#pragma unroll
              for (int i = 0; i < 16; ++i) { const int k = lane + 64 * i; wv[i] = n < 4 ? p.w_rg[k * 4 + n] : p.w_re[k * 32 + (n - 4)]; }
#pragma unroll
              for (int i = 0; i < 16; ++i) { const int k = lane + 64 * i; cs += bf2f(f2bf(wv[i] * p.ln2_g[k])); bs += p.ln2_b[k] * wv[i]; }
              cs = wave_sum(cs); bs = wave_sum(bs); bs += n < 4 ? p.b_rg[n] : p.b_re[n - 4]; }
          if (lane == 0) { cs2[n] = cs; bs2[n] = bs; } } }
}
__device__ __forceinline__ void finalize_colsums(const Params& p) {
    unsigned char* ws = p.ws; const int gt = blockIdx.x * 512 + threadIdx.x, NGT = gridDim.x * 512;
    const stat_t* ci = (const stat_t*)(ws + WS_CSI); float* cs1 = (float*)(ws + WS_CS1); float* csg = (float*)(ws + WS_CSGU);
    for (int i = gt; i < 2048 + 2 * NEXP * 1024; i += NGT) { const float v = (float)ci[i] * CS_INV; if (i < 2048) cs1[i] = v; else csg[i - 2048] = v; }
}

__device__ void phase_proj_simple(const Params& p) {
    unsigned char* ws = p.ws; const int wave = threadIdx.x >> 6; const int gw = blockIdx.x * 8 + wave, NGW = gridDim.x * 8;
    const bf16_t* XB = (const bf16_t*)(ws + WS_XB); const bf16_t* WIN = (const bf16_t*)(ws + WS_WIN); const bf16_t* MB = (const bf16_t*)(ws + WS_MEMB);
    const bf16_t* WMK = (const bf16_t*)(ws + WS_WMK); const bf16_t* WMV = (const bf16_t*)(ws + WS_WMV);
    bf16_t* PROJ = (bf16_t*)(ws + WS_PROJ); bf16_t* VT = (bf16_t*)(ws + WS_VT); bf16_t* MK = (bf16_t*)(ws + WS_MEMK); bf16_t* MVT = (bf16_t*)(ws + WS_MEMVT);
    constexpr int TA = (NTOK / 64) * (NPROJ / 64), TB = (512 / 64) * (NTOK / 64), TC = (NMEM / 64) * (DM / 64), TD = (DM / 64) * (NMEM / 64);
    for (int t = gw; t < TA + TB + TC + TD; t += NGW) {
        const bf16_t *A, *Bt; bf16_t* O; int ldo, tm, tn, r = t;
        if (r < TA) { A = XB; Bt = WIN; O = PROJ; ldo = NPROJ; tm = r / (NPROJ / 64); tn = r % (NPROJ / 64); }
        else if ((r -= TA) < TB) { A = WIN + (size_t)C_V * DM; Bt = XB; O = VT; ldo = VT_LD; tm = r / (NTOK / 64); tn = r % (NTOK / 64); }
        else if ((r -= TB) < TC) { A = MB; Bt = WMK; O = MK; ldo = DM; tm = r / (DM / 64); tn = r % (DM / 64); }
        else { r -= TC; A = WMV; Bt = MB; O = MVT; ldo = MVT_LD; tm = r / (NMEM / 64); tn = r % (NMEM / 64); }
        f32x16 c[2][2];
        wave_tile<1>(DM, [&](int i) { return A + (size_t)(tm * 64 + i) * DM; }, [&](int j) { return Bt + (size_t)(tn * 64 + j) * DM; }, c);
#pragma unroll
        for (int i = 0; i < 2; ++i)
#pragma unroll
            for (int j = 0; j < 2; ++j)
#pragma unroll
                for (int q = 0; q < 16; ++q) O[(size_t)(tm * 64 + TROW(i, q)) * ldo + tn * 64 + TCOL(j)] = f2bf(c[i][j][q]);
    }
}

__device__ void phase_conv_simple(const Params& p) {
    unsigned char* ws = p.ws; const int lane = threadIdx.x & 63, wave = threadIdx.x >> 6; const int gw = blockIdx.x * 8 + wave, NGW = gridDim.x * 8;
    const bf16_t* PROJ = (const bf16_t*)(ws + WS_PROJ); bf16_t* YMIX = (bf16_t*)(ws + WS_YMIX);
    for (int it = gw; it < NTOK * 8; it += NGW) {
        const int tok = it >> 3, g = it & 7, c = g * 64 + lane, t = tok % SEQ;
        float acc = 0.f;
#pragma unroll
        for (int k = 0; k < 3; ++k) { const int tt = t - 2 + k; if (tt >= 0) { const bf16_t* row = PROJ + (size_t)(tok - 2 + k) * NPROJ; acc += p.conv_w[k * 512 + c] * (bf2f(row[C_CC + c]) * bf2f(row[C_CH + c])); } }
        const float y = bf2f(PROJ[(size_t)tok * NPROJ + C_CB + c]) * acc;
        const float ms = wave_sum(y * y) * (1.f / 64.f);
        YMIX[(size_t)tok * DM + c] = f2bf(y * (1.0f / sqrtf(ms + RMS_EPS)) * p.gn_conv[c]);
    }
}
__device__ void phase_sb_simple(const Params& p) {
    unsigned char* ws = p.ws; const int lane = threadIdx.x & 63, wave = threadIdx.x >> 6; const int gw = blockIdx.x * 8 + wave, NGW = gridDim.x * 8;
    const bf16_t* PROJ = (const bf16_t*)(ws + WS_PROJ); const bf16_t* VT = (const bf16_t*)(ws + WS_VT); bf16_t* YMIX = (bf16_t*)(ws + WS_YMIX);
    for (int it = gw; it < NTOK * NHEAD; it += NGW) {
        const int tok = it / NHEAD, h = it % NHEAD, b = tok / SEQ, t = tok % SEQ;
        float q[64], o[64];
        { const bf16_t* qp = PROJ + (size_t)tok * NPROJ + C_Q + h * 64;
#pragma unroll
          for (int d = 0; d < 64; ++d) { q[d] = bf2f(qp[d]); o[d] = 0.f; } }
        float R = 0.f;
        for (int c0 = t - 1; c0 >= 0; c0 -= 64) {
            const int s = c0 - lane; const bool valid = s >= 0; const int sc = valid ? s : 0;
            const bf16_t* kp = PROJ + (size_t)(b * SEQ + sc) * NPROJ + C_K + h * 64;
            float dot = 0.f;
#pragma unroll
            for (int d8 = 0; d8 < 8; ++d8) { const bf16x8 kv = *(const bf16x8*)(kp + d8 * 8);
#pragma unroll
                for (int j = 0; j < 8; ++j) dot += q[d8 * 8 + j] * bf2f((bf16_t)kv[j]); }
            const float sp = fmaxf(dot, 0.f) + __log2f(1.0f + exp2f(-fabsf(dot)));
            const float L = valid ? -sp : 0.f;
            float incl = L;
#pragma unroll
            for (int off = 1; off < 64; off <<= 1) { const float n = __shfl_up(incl, off); if (lane >= off) incl += n; }
            const float w = valid ? exp2f(dot + L + (R + incl - L)) : 0.f;
            R += __shfl(incl, 63);
            const bf16_t* vp = VT + (size_t)(h * 64) * VT_LD + b * SEQ + sc;
#pragma unroll
            for (int d = 0; d < 64; ++d) o[d] += w * bf2f(vp[(size_t)d * VT_LD]);
        }
        float ss = 0.f, mine = 0.f;
#pragma unroll
        for (int d = 0; d < 64; ++d) { const float v = wave_sum(o[d]); ss += v * v; if (d == lane) mine = v; }
        YMIX[(size_t)tok * DM + 512 + h * 64 + lane] = f2bf(mine * (1.0f / sqrtf(ss * (1.f / 64.f) + RMS_EPS)) * p.gn_sb[h * 64 + lane]);
    }
}

template <bool STATS, class Epi>
__device__ __forceinline__ void gemm_simple(const bf16_t* A, const bf16_t* Bt, int M, int N, int K, stat_t* st, Epi epi) {
    const int wave = threadIdx.x >> 6, lane = threadIdx.x & 63; const int gw = blockIdx.x * 8 + wave, NGW = gridDim.x * 8;
    const int tn_n = N / 64, nt = (M / 64) * tn_n;
    for (int t = gw; t < nt; t += NGW) {
        const int tm = t / tn_n, tn = t % tn_n;
        f32x16 c[2][2];
        wave_tile<1>(K, [&](int i) { return A + (size_t)(tm * 64 + i) * K; }, [&](int j) { return Bt + (size_t)(tn * 64 + j) * K; }, c);
#pragma unroll
        for (int i = 0; i < 2; ++i)
#pragma unroll
            for (int q = 0; q < 16; ++q) { const int row = tm * 64 + TROW(i, q); float s = 0.f, qq = 0.f;
#pragma unroll
                for (int j = 0; j < 2; ++j) { const float v = epi(row, tn * 64 + TCOL(j), c[i][j][q]); s += v; qq += v * v; }
                if (STATS) {
#pragma unroll
                    for (int o = 1; o < 32; o <<= 1) { s += __shfl_xor(s, o); qq += __shfl_xor(qq, o); }
                    if ((lane & 31) == 0) stat_add(st, row, s, qq); } }
    }
}
__device__ void phase_outproj_simple(const Params& p) {
    unsigned char* ws = p.ws; bf16_t* T1B = (bf16_t*)(ws + WS_T1B);
    gemm_simple<true>((const bf16_t*)(ws + WS_YMIX), (const bf16_t*)(ws + WS_WOUT), NTOK, DM, DM, (stat_t*)(ws + WS_STATS1),
        [=](int row, int col, float v) { const float t = ALPHA * bf2f(T1B[(size_t)row * DM + col]) + v; T1B[(size_t)row * DM + col] = f2bf(t); return t; });
}
__device__ void phase_mq_simple(const Params& p) {
    unsigned char* ws = p.ws; bf16_t* QM = (bf16_t*)(ws + WS_QM); const stat_t* st = (const stat_t*)(ws + WS_STATS1); const float* cs = (const float*)(ws + WS_CS1); const float* bs = cs + 1024;
    gemm_simple<false>((const bf16_t*)(ws + WS_T1B), (const bf16_t*)(ws + WS_WMQ), NTOK, DM, DM, nullptr,
        [=](int row, int col, float v) { const RowStat r = row_stat(st, row); QM[(size_t)row * DM + col] = f2bf(r.rstd * (v - r.mean * cs[col]) + bs[col]); return 0.f; });
}
__device__ void phase_xattn_simple(const Params& p, unsigned char* lds) {
    unsigned char* ws = p.ws; const int lane = threadIdx.x & 63, wave = threadIdx.x >> 6; const int gw = blockIdx.x * 8 + wave, NGW = gridDim.x * 8;
    const bf16_t* QM = (const bf16_t*)(ws + WS_QM); const bf16_t* MK = (const bf16_t*)(ws + WS_MEMK); const bf16_t* MVT = (const bf16_t*)(ws + WS_MEMVT); bf16_t* OB = (bf16_t*)(ws + WS_OB);
    float* qs = (float*)(lds + wave * 4096); float* ps = qs + 256;
    for (int it = gw; it < NTOK * MH; it += NGW) {
        const int tok = it / MH, h = it % MH, b = tok / SEQ;
        const bf16_t* qp = QM + (size_t)tok * DM + h * MHD;
#pragma unroll
        for (int j = 0; j < 4; ++j) qs[lane + 64 * j] = bf2f(qp[lane + 64 * j]);
        asm volatile("s_waitcnt lgkmcnt(0)" ::: "memory");
        float sc[4];
#pragma unroll
        for (int j = 0; j < 4; ++j) { const int key = lane + 64 * j; const bf16_t* kp = MK + (size_t)(b * MEML + key) * DM + h * MHD; float dot = 0.f;
#pragma unroll 2
            for (int d8 = 0; d8 < 32; ++d8) { const bf16x8 kv = *(const bf16x8*)(kp + d8 * 8);
#pragma unroll
                for (int e = 0; e < 8; ++e) dot += qs[d8 * 8 + e] * bf2f((bf16_t)kv[e]); }
            sc[j] = dot; }
        const float mx = wave_max(fmaxf(fmaxf(sc[0], sc[1]), fmaxf(sc[2], sc[3])));
        float sum = 0.f;
#pragma unroll
        for (int j = 0; j < 4; ++j) { sc[j] = exp2f(sc[j] - mx); sum += sc[j]; }
        sum = wave_sum(sum); const float inv = 1.0f / sum;
#pragma unroll
        for (int j = 0; j < 4; ++j) ps[lane + 64 * j] = sc[j] * inv;
        asm volatile("s_waitcnt lgkmcnt(0)" ::: "memory");
#pragma unroll
        for (int j = 0; j < 4; ++j) { const int d = lane + 64 * j; const bf16_t* vp = MVT + (size_t)(h * MHD + d) * MVT_LD + b * MEML; float acc = 0.f;
#pragma unroll 2
            for (int k8 = 0; k8 < 32; ++k8) { const bf16x8 vv = *(const bf16x8*)(vp + k8 * 8);
#pragma unroll
                for (int e = 0; e < 8; ++e) acc += ps[k8 * 8 + e] * bf2f((bf16_t)vv[e]); }
            OB[(size_t)tok * DM + h * MHD + d] = f2bf(acc); }
        asm volatile("s_waitcnt lgkmcnt(0)" ::: "memory");
    }
}
__device__ void phase_mo_simple(const Params& p) {
    unsigned char* ws = p.ws; bf16_t* T2B = (bf16_t*)(ws + WS_T2B); const bf16_t* T1B = (const bf16_t*)(ws + WS_T1B); const stat_t* st1 = (const stat_t*)(ws + WS_STATS1);
    const float* g1 = p.ln1_g; const float* b1 = p.ln1_b;
    gemm_simple<true>((const bf16_t*)(ws + WS_OB), (const bf16_t*)(ws + WS_WMO), NTOK, DM, DM, (stat_t*)(ws + WS_STATS2),
        [=](int row, int col, float v) { const RowStat r = row_stat(st1, row); const float x1 = (bf2f(T1B[(size_t)row * DM + col]) - r.mean) * r.rstd * g1[col] + b1[col];
            const float t = ALPHA * x1 + v; T2B[(size_t)row * DM + col] = f2bf(t); return t; });
}
__device__ void phase_router_simple(const Params& p) {
    unsigned char* ws = p.ws; float* LG = (float*)(ws + WS_LOGIT); const stat_t* st = (const stat_t*)(ws + WS_STATS2); const float* cs = (const float*)(ws + WS_CS2); const float* bs = cs + 64;
    gemm_simple<false>((const bf16_t*)(ws + WS_T2B), (const bf16_t*)(ws + WS_WRT), NTOK, 64, DM, nullptr,
        [=](int row, int col, float v) { const RowStat r = row_stat(st, row); LG[(size_t)row * NLOGP + col] = r.rstd * (v - r.mean * cs[col]) + bs[col]; return 0.f; });
}
__device__ void phase_route(const Params& p, unsigned char* lds_, int t_first = -1) {
    unsigned char* ws = p.ws; const int tid = threadIdx.x;
    const float* LG = (const float*)(ws + WS_LOGIT); int* EID = (int*)(ws + WS_EID); float* GATE = (float*)(ws + WS_GATE); unsigned* CNT = (unsigned*)(ws + WS_CNT); int* ROWL = (int*)(ws + WS_ROWL); f32x4* ROWM = (f32x4*)p.out; const stat_t* st2 = (const stat_t*)(ws + WS_STATS2);
    LAS unsigned* lc = (LAS unsigned*)lds_;
    for (int t0 = t_first >= 0 ? t_first : blockIdx.x * 512; t0 < (t_first >= 0 ? t_first + 256 : NTOK); t0 += gridDim.x * 512) {
        if (tid < 64) lc[tid] = 0u;
        __syncthreads();
        const int tok = (t_first >= 0 && tid >= 256) ? NTOK : t0 + tid; int ea = 0, eb = 0; unsigned ra = 0, rb = 0; float ga = 0.f, gb = 0.f;
        if (tok < NTOK) {
            const float* lg = LG + (size_t)tok * NLOGP;
            int grp = 0; float gm = lg[0];
#pragma unroll
            for (int g = 1; g < 4; ++g) if (lg[g] > gm) { gm = lg[g]; grp = g; }
            float gs = 0.f;
#pragma unroll
            for (int g = 0; g < 4; ++g) gs += __expf(lg[g] - gm);
            const float gprob = 1.0f / gs;
            const float* el = lg + 4 + grp * 8;
            int i1 = 0; float l1 = el[0];
#pragma unroll
            for (int j = 1; j < 8; ++j) if (el[j] > l1) { l1 = el[j]; i1 = j; }
            int i2 = -1; float l2 = 0.f;
#pragma unroll
            for (int j = 0; j < 8; ++j) if (j != i1 && (i2 < 0 || el[j] > l2)) { l2 = el[j]; i2 = j; }
            const float e2 = __expf(l2 - l1), w1 = 1.0f / (1.0f + e2), w2 = e2 * w1;
            ea = grp * 8 + i1; eb = grp * 8 + i2;
            EID[2 * tok] = ea; EID[2 * tok + 1] = eb; ga = gprob * w1; gb = gprob * w2; GATE[2 * tok] = ga; GATE[2 * tok + 1] = gb;
            ra = atomicAdd((unsigned*)(lc + ea), 1u); rb = atomicAdd((unsigned*)(lc + eb), 1u);
        }
        __syncthreads();
        if (tid < 32) lc[32 + tid] = lc[tid] ? atomicAdd(CNT + tid, lc[tid]) : 0u;
        __syncthreads();
        if (tok < NTOK) { const RowStat rs = row_stat(st2, tok); const size_t ia = (size_t)ea * CAP + lc[32 + ea] + ra, ib = (size_t)eb * CAP + lc[32 + eb] + rb;
            ROWL[ia] = 2 * tok; ROWL[ib] = 2 * tok + 1; ROWM[ia] = (f32x4){ga, rs.mean, rs.rstd, 0.f}; ROWM[ib] = (f32x4){gb, rs.mean, rs.rstd, 0.f}; }
        __syncthreads();
    }
}
__device__ void phase_moe1_simple(const Params& p) {
    unsigned char* ws = p.ws; const int wave = threadIdx.x >> 6; const int gw = blockIdx.x * 8 + wave, NGW = gridDim.x * 8;
    const unsigned* CNT = (const unsigned*)(ws + WS_CNT); const int* ROWL = (const int*)(ws + WS_ROWL); const bf16_t* T2B = (const bf16_t*)(ws + WS_T2B); const bf16_t* WGU = (const bf16_t*)(ws + WS_WGU);
    const stat_t* st = (const stat_t*)(ws + WS_STATS2); const float* csg = (const float*)(ws + WS_CSGU); const float* bsg = csg + NEXP * 1024; bf16_t* H = (bf16_t*)(ws + WS_H);
    int tbase = 0, hoff = 0;
    for (int e = 0; e < NEXP; ++e) {
        const int cnt = (int)CNT[e], nrt = (cnt + 63) / 64, ntile = nrt * 8;
        for (int t = gw - tbase; t < ntile; t += NGW) { if (t < 0) continue;
            const int tm = t / 8, ct = t % 8, pn = ct >> 1, hf = ct & 1; const int* rl = ROWL + (size_t)e * CAP; const bf16_t* W = WGU + (size_t)e * 1024 * 1024;
            f32x16 c[2][4];
            wave_tile<2>(DM, [&](int i) { int r = tm * 64 + i; r = r < cnt ? r : cnt - 1; return T2B + (size_t)(rl[r] >> 1) * DM; },
                         [&](int j) { const int row = 256 * pn + (j >= 64 ? 128 : 0) + 64 * hf + (j & 63); return W + (size_t)row * DM; }, c);
#pragma unroll
            for (int i = 0; i < 2; ++i)
#pragma unroll
                for (int q = 0; q < 16; ++q) { const int r = tm * 64 + TROW(i, q); if (r < cnt) { const RowStat rs = row_stat(st, rl[r] >> 1);
#pragma unroll
                    for (int j = 0; j < 2; ++j) { const int cg_ = 256 * pn + 64 * hf + TCOL(j), cu_ = cg_ + 128;
                        const float g = rs.rstd * (c[i][j][q] - rs.mean * csg[e * 1024 + cg_]) + bsg[e * 1024 + cg_];
                        const float u = rs.rstd * (c[i][j + 2][q] - rs.mean * csg[e * 1024 + cu_]) + bsg[e * 1024 + cu_];
                        H[(size_t)(hoff + r) * DEXP + 128 * pn + 64 * hf + TCOL(j)] = f2bf(g / (1.0f + __expf(-g)) * u); } } }
        }
        tbase = (tbase + ntile) % NGW; hoff += (cnt + 255) / 256 * 256;
    }
}
__device__ void phase_moe2_simple(const Params& p) {
    unsigned char* ws = p.ws; const int wave = threadIdx.x >> 6; const int gw = blockIdx.x * 8 + wave, NGW = gridDim.x * 8;
    const unsigned* CNT = (const unsigned*)(ws + WS_CNT); const int* ROWL = (const int*)(ws + WS_ROWL); const bf16_t* H = (const bf16_t*)(ws + WS_H); const bf16_t* WD = (const bf16_t*)(ws + WS_WD);
    const float* GATE = (const float*)(ws + WS_GATE); bf16_t* Y = (bf16_t*)(ws + WS_Y);
    int tbase = 0, hoff = 0;
    for (int e = 0; e < NEXP; ++e) {
        const int cnt = (int)CNT[e], nrt = (cnt + 63) / 64, ntile = nrt * 16;
        for (int t = gw - tbase; t < ntile; t += NGW) { if (t < 0) continue;
            const int tm = t / 16, tn = t % 16; const int* rl = ROWL + (size_t)e * CAP; const bf16_t* W = WD + (size_t)e * 1024 * 512;
            f32x16 c[2][2];
            wave_tile<1>(DEXP, [&](int i) { int r = tm * 64 + i; r = r < cnt ? r : cnt - 1; return H + (size_t)(hoff + r) * DEXP; }, [&](int j) { return W + (size_t)(tn * 64 + j) * DEXP; }, c);
#pragma unroll
            for (int i = 0; i < 2; ++i)
#pragma unroll
                for (int q = 0; q < 16; ++q) { const int r = tm * 64 + TROW(i, q); if (r < cnt) { const int a = rl[r]; const float g = GATE[a];
#pragma unroll
                    for (int j = 0; j < 2; ++j) Y[(size_t)a * DM + tn * 64 + TCOL(j)] = f2bf(g * c[i][j][q]); } }
        }
        tbase = (tbase + ntile) % NGW; hoff += (cnt + 255) / 256 * 256;
    }
}
__device__ void phase_final(const Params& p) {
    unsigned char* ws = p.ws; const int lane = threadIdx.x & 63, wave = threadIdx.x >> 6; const int gw = blockIdx.x * 8 + wave, NGW = gridDim.x * 8;
    const bf16_t* T2B = (const bf16_t*)(ws + WS_T2B); const bf16_t* Y = (const bf16_t*)(ws + WS_Y); const stat_t* st = (const stat_t*)(ws + WS_STATS2);
    f32x4 g2v[4], b2v[4], g3v[4], b3v[4];
#pragma unroll
    for (int j = 0; j < 2; ++j)
#pragma unroll
        for (int hf = 0; hf < 2; ++hf) { const int c0 = 512 * j + 8 * lane + 4 * hf; g2v[2 * j + hf] = *(const f32x4*)(p.ln2_g + c0); b2v[2 * j + hf] = *(const f32x4*)(p.ln2_b + c0); g3v[2 * j + hf] = *(const f32x4*)(p.ln3_g + c0); b3v[2 * j + hf] = *(const f32x4*)(p.ln3_b + c0); }
    for (int tok = gw; tok < NTOK; tok += NGW) {
        u32x4 tw[2], aw[2], bw[2];
#pragma unroll
        for (int j = 0; j < 2; ++j) { const int c0 = 512 * j + 8 * lane; tw[j] = *(const u32x4*)(T2B + (size_t)tok * DM + c0); aw[j] = __builtin_nontemporal_load((const u32x4*)(Y + (size_t)(2 * tok) * DM + c0)); bw[j] = __builtin_nontemporal_load((const u32x4*)(Y + (size_t)(2 * tok + 1) * DM + c0)); }
        const RowStat rs = row_stat(st, tok);
        f32x4 v[4]; float s = 0.f;
#pragma unroll
        for (int j = 0; j < 2; ++j) {
            v[2 * j] = ALPHA * ((unpack_lo(tw[j]) - rs.mean) * rs.rstd * g2v[2 * j] + b2v[2 * j]) + unpack_lo(aw[j]) + unpack_lo(bw[j]);
            v[2 * j + 1] = ALPHA * ((unpack_hi(tw[j]) - rs.mean) * rs.rstd * g2v[2 * j + 1] + b2v[2 * j + 1]) + unpack_hi(aw[j]) + unpack_hi(bw[j]);
            s += sum4(v[2 * j]) + sum4(v[2 * j + 1]); }
        const float mean = wave_sum(s) * (1.f / DM); float qq = 0.f;
#pragma unroll
        for (int i = 0; i < 4; ++i) { v[i] = v[i] - mean; qq += sq4(v[i]); }
        const float rstd = __builtin_amdgcn_rsqf(wave_sum(qq) * (1.f / DM) + LN_EPS);
#pragma unroll
        for (int j = 0; j < 2; ++j)
#pragma unroll
            for (int hf = 0; hf < 2; ++hf) __builtin_nontemporal_store(v[2 * j + hf] * rstd * g3v[2 * j + hf] + b3v[2 * j + hf], (f32x4*)(p.out + (size_t)tok * DM + 512 * j + 8 * lane + 4 * hf));
    }
}

namespace mm {
constexpr int BM = 256, BK = 64, HALF = 128, HTB = HALF * BK * 2, STAGE_BYTES = 8 * HTB, NXCD = 8, WGM = 8;
__device__ __forceinline__ int lds_byte(int r, int c) { const int st = (r >> 4) * 2 + (c >> 5), rr = r & 15, cc = c & 31, ob = rr * 64 + cc * 2; return st * 1024 + (ob ^ (((ob >> 9) & 1) << 5)); }
__device__ __forceinline__ void stage_rc(int b, int& R, int& C) { const int st = b / 1024, sb = b % 1024, swz = sb ^ (((sb >> 9) & 1) << 5); R = (st >> 1) * 16 + swz / 64; C = (st & 1) * 32 + (swz % 64) / 2; }
__device__ __forceinline__ int perm32(int rho) { const int n = rho >> 4, i = rho & 15; return 8 * (i >> 2) + 4 * n + (i & 3); }
__device__ __forceinline__ unsigned cvt_pk_bf16(float lo, float hi) { typedef float f2 __attribute__((ext_vector_type(2))); typedef __bf16 b2 __attribute__((ext_vector_type(2))); f2 v = {lo, hi}; b2 b = __builtin_convertvector(v, b2); return __builtin_bit_cast(unsigned, b); }

struct Unit { int pm, pn, aux, nvalid; const char* a; const char* b; const int* rows; };
struct Meta { float r0, r1; int r2; float c0, c1; };
constexpr int META_OFF = 137216, META_SLOT = 5120;

__device__ __forceinline__ void order_map(int L, int nM, int nN, int& pm, int& pn) {
    const int nwg = nM * nN; int wgid = L; { const int q = nwg / NXCD, r = nwg % NXCD, xcd = wgid % NXCD, off = wgid / NXCD; wgid = (xcd < r ? xcd * (q + 1) : r * (q + 1) + (xcd - r) * q) + off; }
    const int nig = WGM * nN, gid = wgid / nig, fm = gid * WGM, gsz = (nM - fm) < WGM ? (nM - fm) : WGM;
    pm = fm + ((wgid % nig) % gsz); pn = (wgid % nig) / gsz;
}

template <class Epi, class Sched, bool GATHER>
__device__ __forceinline__ void gemm_phase(LAS unsigned char* lds, const int K, const Sched& S, const Epi& E, const int LD_ = 0) {
    const int LD = LD_ ? LD_ : K;
    const int tid = threadIdx.x, wid = __builtin_amdgcn_readfirstlane(tid >> 6), lane = tid & 63, wr = wid >> 2, wc = wid & 3, fr = lane & 15, fq = lane >> 4;
    const int nt = K / BK;
    unsigned voffB, voffA, rp[2];
    { int sR, sC; stage_rc(tid * 16, sR, sC); const int Rb = Epi::PERM ? ((sR & ~31) + perm32(sR & 31)) : sR;
      voffB = (unsigned)(Rb * LD + sC) * 2u; voffA = GATHER ? (unsigned)sC * 2u : (unsigned)(sR * LD + sC) * 2u; }
    const size_t kstep = (size_t)(BK * 2), hstep = (size_t)HALF * LD * 2, r64 = (size_t)64 * LD * 2;
    const unsigned ldsw = (unsigned)wid * 1024u;
    const int aoff = lds_byte(wr * 64 + fr, fq * 8), boff = lds_byte(wc * 32 + fr, fq * 8);
#define MM_SA(b, h) (((b) * 2 + (h)) * HTB)
#define MM_SB(b, h) ((4 + (b) * 2 + (h)) * HTB)
#define MM_GLDS(src, dst) __builtin_amdgcn_global_load_lds((const unsigned*)(src), (LAS unsigned*)(dst), 16, 0, 0)
#define MM_STAGE_B(bufoff, gbase) do { MM_GLDS((const char*)(gbase) + voffB, lds + (bufoff) + ldsw); MM_GLDS((const char*)(gbase) + r64 + voffB, lds + (bufoff) + ldsw + 8192); } while (0)
#define MM_STAGE_A(bufoff, gbase, h) do { if (GATHER) { \
        MM_GLDS((const char*)(gbase) + (unsigned)((rp[h] & 0xffffu) * (unsigned)(LD * 2) + voffA), lds + (bufoff) + ldsw); MM_GLDS((const char*)(gbase) + (unsigned)((rp[h] >> 16) * (unsigned)(LD * 2) + voffA), lds + (bufoff) + ldsw + 8192); } \
      else { MM_GLDS((const char*)(gbase) + (h) * hstep + voffA, lds + (bufoff) + ldsw); MM_GLDS((const char*)(gbase) + (h) * hstep + r64 + voffA, lds + (bufoff) + ldsw + 8192); } } while (0)
#define MM_LDA(dst, b, h) do { _Pragma("unroll") for (int m = 0; m < 4; ++m) _Pragma("unroll") for (int k = 0; k < 2; ++k) dst[m][k] = *(const LAS bf16x8*)(lds + MM_SA(b, h) + aoff + m * 2048 + k * 1024); } while (0)
#define MM_LDB(dst, b, h) do { _Pragma("unroll") for (int n = 0; n < 2; ++n) _Pragma("unroll") for (int k = 0; k < 2; ++k) dst[n][k] = *(const LAS bf16x8*)(lds + MM_SB(b, h) + boff + n * 2048 + k * 1024); } while (0)
#define MM_MMA(ai, bj, At, Bt) do { __builtin_amdgcn_s_setprio(1); _Pragma("unroll") for (int m = 0; m < 4; ++m) _Pragma("unroll") for (int n = 0; n < 2; ++n) _Pragma("unroll") for (int k = 0; k < 2; ++k) \
        acc[ai][bj][m][n] = __builtin_amdgcn_mfma_f32_16x16x32_bf16(Bt[n][k], At[m][k], acc[ai][bj][m][n], 0, 0, 0); __builtin_amdgcn_s_setprio(0); } while (0)
#define MM_WAIT_V(n) asm volatile("s_waitcnt vmcnt(" #n ")" ::: "memory")
#define MM_WAIT_L(n) asm volatile("s_waitcnt lgkmcnt(" #n ")" ::: "memory")
#define MM_BAR __builtin_amdgcn_s_barrier()
#define MM_SCHED __builtin_amdgcn_sched_barrier(0)
#define MM_ROWPAIRS(dst, u) do { int _t = tid; asm volatile("" : "+v"(_t)); int _sR, _sC; stage_rc(_t * 16, _sR, _sC); _Pragma("unroll") for (int _h = 0; _h < 2; ++_h) \
        dst[_h] = (unsigned)S.row(u, _h * HALF + _sR) | ((unsigned)S.row(u, _h * HALF + _sR + 64) << 16); } while (0)
#define MM_NVL() ((LAS unsigned*)(lds + 133120 + tid * 8))
    Unit cur, nxt, nx2; int ui = 0;
    if (!S.next(0, cur)) return;
    f32x4 acc[2][2][4][2];
#pragma unroll
    for (int a = 0; a < 2; ++a)
#pragma unroll
        for (int b = 0; b < 2; ++b)
#pragma unroll
            for (int m = 0; m < 4; ++m)
#pragma unroll
                for (int n = 0; n < 2; ++n) acc[a][b][m][n] = (f32x4){0.f, 0.f, 0.f, 0.f};
    bf16x8 At[4][2], B0[2][2], B1[2][2];
    rp[0] = rp[1] = 0u;
    if (GATHER) { unsigned nv[2]; MM_ROWPAIRS(rp, cur); if (S.next(1, nxt)) { MM_ROWPAIRS(nv, nxt); } else { nv[0] = rp[0]; nv[1] = rp[1]; }
        MM_NVL()[0] = nv[0]; MM_NVL()[1] = nv[1];
        asm volatile("s_waitcnt vmcnt(0) lgkmcnt(0)" ::: "memory");
        asm volatile("" : "+v"(rp[0]), "+v"(rp[1])); }
#define MM_META_STORE(slot_, m_) do { LAS float* s_ = (LAS float*)(lds + META_OFF + (slot_) * META_SLOT); s_[tid] = (m_).r0; s_[256 + tid] = (m_).r1; ((LAS int*)s_)[512 + tid] = (m_).r2; s_[768 + tid] = (m_).c0; s_[1024 + tid] = (m_).c1; } while (0)
    if (Epi::META) { if (tid < 256) { const Meta m0 = E.meta_load(cur, tid); MM_META_STORE(0, m0); } }
    const char* cA = cur.a; const char* cB = cur.b;
    MM_STAGE_B(MM_SB(0, 0), cB); MM_STAGE_B(MM_SB(0, 1), cB + hstep); MM_STAGE_A(MM_SA(0, 0), cA, 0); MM_STAGE_A(MM_SA(0, 1), cA, 1);
    if (wr == 1) MM_BAR;
    MM_WAIT_V(2); MM_BAR;
    MM_STAGE_B(MM_SB(1, 0), cB + kstep); MM_STAGE_A(MM_SA(1, 0), cA + kstep, 0); MM_STAGE_B(MM_SB(1, 1), cB + hstep + kstep);
    MM_WAIT_V(6); MM_BAR;
    for (;;) {
        const bool has_next = S.next(ui + 1, nxt);
        const char* nA = has_next ? nxt.a : cA; const char* nB = has_next ? nxt.b : cB;
        for (int t = 0; t < nt; t += 2) {
            const bool last = (t == nt - 2);
            const char* a1 = cA + (size_t)(t + 1) * kstep;
            const char* a2 = last ? nA : cA + (size_t)(t + 2) * kstep; const char* b2 = last ? nB : cB + (size_t)(t + 2) * kstep;
            const char* a3 = a2 + kstep; const char* b3 = b2 + kstep;
            MM_LDB(B0, 0, 0); MM_LDB(B1, 0, 1); MM_SCHED; MM_LDA(At, 0, 0); MM_STAGE_A(MM_SA(1, 1), a1, 1);
            MM_WAIT_V(8); MM_WAIT_L(0); MM_BAR; MM_MMA(0, 0, At, B0); MM_MMA(0, 1, At, B1); MM_BAR; MM_SCHED;
            if (GATHER) { if (last) { rp[0] = MM_NVL()[0]; rp[1] = MM_NVL()[1]; } }
            MM_LDA(At, 0, 1); MM_STAGE_B(MM_SB(0, 0), b2); MM_STAGE_B(MM_SB(0, 1), b2 + hstep); MM_STAGE_A(MM_SA(0, 0), a2, 0);
            MM_WAIT_V(8); MM_WAIT_L(0); MM_BAR; MM_MMA(1, 0, At, B0); MM_MMA(1, 1, At, B1); MM_BAR; MM_SCHED;
            MM_LDB(B0, 1, 0); MM_LDB(B1, 1, 1); MM_SCHED; MM_LDA(At, 1, 0); MM_STAGE_A(MM_SA(0, 1), a2, 1);
            MM_WAIT_V(8); MM_WAIT_L(0); MM_BAR; MM_MMA(0, 0, At, B0); MM_MMA(0, 1, At, B1); MM_BAR; MM_SCHED;
            MM_LDA(At, 1, 1); MM_STAGE_B(MM_SB(1, 0), b3); MM_STAGE_B(MM_SB(1, 1), b3 + hstep); MM_STAGE_A(MM_SA(1, 0), a3, 0);
            MM_WAIT_V(8); MM_WAIT_L(0); MM_BAR; MM_MMA(1, 0, At, B0); MM_MMA(1, 1, At, B1); MM_BAR; MM_SCHED;
        }
        if (wr == 0) MM_BAR;
        Meta mn; const bool pm_ = Epi::META && has_next && tid < 256;
        if (pm_) mn = E.meta_load(nxt, tid);
        E(acc, cur, wr, wc, fr, fq, (const LAS float*)(lds + META_OFF + (ui & 1) * META_SLOT));
        if (pm_) MM_META_STORE((ui + 1) & 1, mn);
        if (!has_next) break;
        if (GATHER) {
            if (S.next(ui + 2, nx2)) { unsigned nv[2]; MM_ROWPAIRS(nv, nx2); MM_NVL()[0] = nv[0]; MM_NVL()[1] = nv[1]; }
            asm volatile("s_waitcnt vmcnt(0) lgkmcnt(0)" ::: "memory"); }
#pragma unroll
        for (int a = 0; a < 2; ++a)
#pragma unroll
            for (int b = 0; b < 2; ++b)
#pragma unroll
                for (int m = 0; m < 4; ++m)
#pragma unroll
                    for (int n = 0; n < 2; ++n) acc[a][b][m][n] = (f32x4){0.f, 0.f, 0.f, 0.f};
        cur = nxt; cA = nA; cB = nB; ++ui;
        if (wr == 1) MM_BAR;
    }
    MM_WAIT_V(0);
    MM_BAR;
#undef MM_SA
#undef MM_SB
#undef MM_GLDS
#undef MM_STAGE_A
#undef MM_STAGE_B
#undef MM_LDA
#undef MM_LDB
#undef MM_MMA
#undef MM_WAIT_V
#undef MM_WAIT_L
#undef MM_BAR
#undef MM_SCHED
#undef MM_META_STORE
#undef MM_ROWPAIRS
#undef MM_NVL
}
}

typedef mm::Unit MUnit;
typedef f32x4 AccT[2][2][4][2];
__device__ __forceinline__ u32x4 pack8(const f32x4 a, const f32x4 b) { u32x4 w; w.x = mm::cvt_pk_bf16(a[0], a[1]); w.y = mm::cvt_pk_bf16(a[2], a[3]); w.z = mm::cvt_pk_bf16(b[0], b[1]); w.w = mm::cvt_pk_bf16(b[2], b[3]); return w; }

struct SchedProj {
    const char *xb, *win, *memb, *wmk, *wmv; int G, c;
    __device__ __forceinline__ bool next(int i, MUnit& u) const {
        int L = i * G + c; u.rows = nullptr; u.nvalid = 256;
        constexpr int U0 = 256 * 10, U1 = 512, U2 = 128, U3 = 128;
        if (L < U0) { int pm, pn; mm::order_map(L, 256, 10, pm, pn); u.pm = pm; u.pn = pn; u.aux = 0; u.a = xb + (size_t)pm * 256 * 2048; u.b = win + (size_t)pn * 256 * 2048; return true; }
        L -= U0;
        if (L < U1) { u.pm = L & 1; u.pn = L >> 1; u.aux = 1; u.a = win + (size_t)(C_V + 256 * u.pm) * 2048; u.b = xb + (size_t)u.pn * 256 * 2048; return true; }
        L -= U1;
        if (L < U2) { u.pm = L >> 2; u.pn = L & 3; u.aux = 2; u.a = memb + (size_t)u.pm * 256 * 2048; u.b = wmk + (size_t)u.pn * 256 * 2048; return true; }
        L -= U2;
        if (L < U3) { u.pm = L >> 2; u.pn = L & 3; u.aux = 3; u.a = memb + (size_t)u.pm * 256 * 2048; u.b = wmv + (size_t)u.pn * 256 * 2048; return true; }
        return false;
    }
    __device__ __forceinline__ int row(const MUnit&, int r) const { return r; }
};
struct EpiProj {
    static constexpr bool PERM = true, META = false;
    bf16_t *proj, *vt, *mk, *mvt;
    __device__ __forceinline__ mm::Meta meta_load(const MUnit&, int) const { return mm::Meta{}; }
    __device__ __forceinline__ void operator()(const AccT& acc, const MUnit& u, int wr, int wc, int fr, int fq, const LAS float*) const {
        bf16_t* O = u.aux == 0 ? proj : u.aux == 1 ? vt : u.aux == 2 ? mk : mvt; const int ldc = u.aux == 0 ? NPROJ : u.aux == 1 ? VT_LD : DM;
        const int row0 = u.pm * 256 + wr * 64 + fr, col0 = u.pn * 256 + wc * 32 + 8 * fq;
#pragma unroll
        for (int ai = 0; ai < 2; ++ai)
#pragma unroll
            for (int m = 0; m < 4; ++m) { bf16_t* rowp = O + (size_t)(row0 + ai * 128 + m * 16) * ldc + col0;
#pragma unroll
                for (int bj = 0; bj < 2; ++bj) *(u32x4*)(rowp + bj * 128) = pack8(acc[ai][bj][m][0], acc[ai][bj][m][1]); }
    }
};
struct SchedDense {
    const char *A, *B; int nM, nN, G, c;
    __device__ __forceinline__ bool next(int i, MUnit& u) const {
        const int L = i * G + c; if (L >= nM * nN) return false;
        int pm, pn; mm::order_map(L, nM, nN, pm, pn); u.pm = pm; u.pn = pn; u.aux = 0; u.nvalid = 256; u.rows = nullptr; u.a = A + (size_t)pm * 256 * 2048; u.b = B + (size_t)pn * 256 * 2048; return true;
    }
    __device__ __forceinline__ int row(const MUnit&, int r) const { return r; }
};
__device__ __forceinline__ void row_stats_add(stat_t* st, int row, float s, float q, int fq) {
    s += __shfl_xor(s, 16); s += __shfl_xor(s, 32); q += __shfl_xor(q, 16); q += __shfl_xor(q, 32);
    if (fq == 0) stat_add(st, row, s, q);
}
struct EpiOut {
    static constexpr bool PERM = true, META = false;
    bf16_t* t1b; stat_t* st;
    __device__ __forceinline__ mm::Meta meta_load(const MUnit&, int) const { return mm::Meta{}; }
    __device__ __forceinline__ void operator()(const AccT& acc, const MUnit& u, int wr, int wc, int fr, int fq, const LAS float*) const {
        bf16_t* base = t1b + (size_t)(u.pm * 256 + wr * 64 + fr) * DM + u.pn * 256 + wc * 32 + 8 * fq;
        u32x4 xw[2][4][2];
#pragma unroll
        for (int ai = 0; ai < 2; ++ai)
#pragma unroll
            for (int m = 0; m < 4; ++m)
#pragma unroll
                for (int bj = 0; bj < 2; ++bj) xw[ai][m][bj] = *(const u32x4*)(base + (size_t)(ai * 128 + m * 16) * DM + bj * 128);
#pragma unroll
        for (int ai = 0; ai < 2; ++ai)
#pragma unroll
            for (int m = 0; m < 4; ++m) { const int row = u.pm * 256 + ai * 128 + wr * 64 + m * 16 + fr; float s = 0.f, q = 0.f;
#pragma unroll
                for (int bj = 0; bj < 2; ++bj) {
                    const f32x4 t0 = ALPHA * unpack_lo(xw[ai][m][bj]) + acc[ai][bj][m][0], t1 = ALPHA * unpack_hi(xw[ai][m][bj]) + acc[ai][bj][m][1];
                    *(u32x4*)(base + (size_t)(ai * 128 + m * 16) * DM + bj * 128) = pack8(t0, t1); s += sum4(t0) + sum4(t1); q += sq4(t0) + sq4(t1); }
                row_stats_add(st, row, s, q, fq); }
    }
};
struct EpiMq {
    static constexpr bool PERM = true, META = true;
    bf16_t* qm; const stat_t* st; const float *cs, *bs;
    __device__ __forceinline__ mm::Meta meta_load(const MUnit& u, int t) const { const RowStat r = row_stat(st, u.pm * 256 + t); mm::Meta m; m.r0 = r.mean; m.r1 = r.rstd; m.r2 = 0; m.c0 = cs[u.pn * 256 + t]; m.c1 = bs[u.pn * 256 + t]; return m; }
    __device__ __forceinline__ void operator()(const AccT& acc, const MUnit& u, int wr, int wc, int fr, int fq, const LAS float* ms) const {
        float mean[8], rstd[8];
#pragma unroll
        for (int g = 0; g < 8; ++g) { const int rl = (g >> 2) * 128 + wr * 64 + (g & 3) * 16 + fr; mean[g] = ms[rl]; rstd[g] = ms[256 + rl]; }
#pragma unroll
        for (int bj = 0; bj < 2; ++bj) { const int cl = bj * 128 + wc * 32 + 8 * fq, col = u.pn * 256 + cl;
            const f32x4 c0 = *(const LAS f32x4*)(ms + 768 + cl), c1 = *(const LAS f32x4*)(ms + 768 + cl + 4), b0 = *(const LAS f32x4*)(ms + 1024 + cl), b1 = *(const LAS f32x4*)(ms + 1024 + cl + 4);
#pragma unroll
            for (int ai = 0; ai < 2; ++ai)
#pragma unroll
                for (int m = 0; m < 4; ++m) { const int row = u.pm * 256 + ai * 128 + wr * 64 + m * 16 + fr; const float mu = mean[ai * 4 + m], rs = rstd[ai * 4 + m];
                    const f32x4 v0 = rs * (acc[ai][bj][m][0] - mu * c0) + b0, v1 = rs * (acc[ai][bj][m][1] - mu * c1) + b1;
                    *(u32x4*)(qm + (size_t)row * DM + col) = pack8(v0, v1); } }
    }
};
struct EpiMo {
    static constexpr bool PERM = true, META = true;
    const bf16_t* t1b; const stat_t* st1; const float *g1, *b1; bf16_t* t2b; stat_t* st2;
    __device__ __forceinline__ mm::Meta meta_load(const MUnit& u, int t) const { const RowStat r = row_stat(st1, u.pm * 256 + t); mm::Meta m; m.r0 = r.mean; m.r1 = r.rstd; m.r2 = 0; m.c0 = g1[u.pn * 256 + t]; m.c1 = b1[u.pn * 256 + t]; return m; }
    __device__ __forceinline__ void operator()(const AccT& acc, const MUnit& u, int wr, int wc, int fr, int fq, const LAS float* ms) const {
        const size_t off0 = (size_t)(u.pm * 256 + wr * 64 + fr) * DM + u.pn * 256 + wc * 32 + 8 * fq;
        f32x4 gv[2][2], bv[2][2];
#pragma unroll
        for (int bj = 0; bj < 2; ++bj)
#pragma unroll
            for (int hf = 0; hf < 2; ++hf) { const int cl = bj * 128 + wc * 32 + 8 * fq + 4 * hf; gv[bj][hf] = *(const LAS f32x4*)(ms + 768 + cl); bv[bj][hf] = *(const LAS f32x4*)(ms + 1024 + cl); }
#pragma unroll
        for (int ai = 0; ai < 2; ++ai) {
            u32x4 tw[4][2]; float mean[4], rstd[4];
#pragma unroll
            for (int m = 0; m < 4; ++m) { const int rl = ai * 128 + wr * 64 + m * 16 + fr; mean[m] = ms[rl]; rstd[m] = ms[256 + rl];
#pragma unroll
                for (int bj = 0; bj < 2; ++bj) tw[m][bj] = *(const u32x4*)(t1b + off0 + (size_t)(ai * 128 + m * 16) * DM + bj * 128); }
#pragma unroll
            for (int m = 0; m < 4; ++m) { const int row = u.pm * 256 + ai * 128 + wr * 64 + m * 16 + fr; float s = 0.f, q = 0.f;
#pragma unroll
                for (int bj = 0; bj < 2; ++bj) {
                    const f32x4 x0 = (unpack_lo(tw[m][bj]) - mean[m]) * rstd[m] * gv[bj][0] + bv[bj][0], x1 = (unpack_hi(tw[m][bj]) - mean[m]) * rstd[m] * gv[bj][1] + bv[bj][1];
                    const f32x4 t0 = ALPHA * x0 + acc[ai][bj][m][0], t1 = ALPHA * x1 + acc[ai][bj][m][1];
                    *(u32x4*)(t2b + off0 + (size_t)(ai * 128 + m * 16) * DM + bj * 128) = pack8(t0, t1); s += sum4(t0) + sum4(t1); q += sq4(t0) + sq4(t1); }
                row_stats_add(st2, row, s, q, fq); }
            asm volatile("" ::: "memory");
        }
    }
};
struct EpiRouter {
    static constexpr bool PERM = false, META = true;
    float* lg; const stat_t* st; const float *cs, *bs;
    __device__ __forceinline__ mm::Meta meta_load(const MUnit& u, int t) const { const RowStat r = row_stat(st, u.pm * 256 + t); mm::Meta m; m.r0 = r.mean; m.r1 = r.rstd; m.r2 = 0; m.c0 = t < 64 ? cs[t] : 0.f; m.c1 = t < 64 ? bs[t] : 0.f; return m; }
    __device__ __forceinline__ void operator()(const AccT& acc, const MUnit& u, int wr, int wc, int fr, int fq, const LAS float* ms) const {
        if (wc < 2) {
#pragma unroll
            for (int n = 0; n < 2; ++n) { const int col = wc * 32 + 16 * n + 4 * fq; const f32x4 c0 = *(const LAS f32x4*)(ms + 768 + col), b0 = *(const LAS f32x4*)(ms + 1024 + col);
#pragma unroll
                for (int ai = 0; ai < 2; ++ai)
#pragma unroll
                    for (int m = 0; m < 4; ++m) { const int rl = ai * 128 + wr * 64 + m * 16 + fr, row = u.pm * 256 + rl;
                        *(f32x4*)(lg + (size_t)row * NLOGP + col) = ms[256 + rl] * (acc[ai][0][m][n] - ms[rl] * c0) + b0; } }
        }
    }
};
constexpr int MOE_TB_OFF = 131072;
__device__ __forceinline__ void moe_tables(const unsigned* CNT, LAS int* tb) {
    if (threadIdx.x == 0) { int ub = 0, ho = 0;
        for (int e = 0; e < NEXP; ++e) { const int c = (int)CNT[e]; tb[e] = ub; tb[64 + e] = ho; tb[128 + e] = c; const int nt = (c + 255) / 256; ub += nt * 4; ho += nt * 256; }
        tb[32] = ub; }
    __syncthreads();
}
__device__ __forceinline__ int uni(int v) { return __builtin_amdgcn_readfirstlane(v); }
template <class T> __device__ __forceinline__ T* uni_ptr(T* q) { const unsigned long long v = (unsigned long long)q; const unsigned lo = __builtin_amdgcn_readfirstlane((unsigned)v), hi = __builtin_amdgcn_readfirstlane((unsigned)(v >> 32)); return (T*)(((unsigned long long)hi << 32) | lo); }
template <int WHICH> struct SchedMoe {
    const char *A, *B; const int* rowl; LAS int* tb; int G, c;
    __device__ __forceinline__ bool next(int i, MUnit& u) const {
        const int L = i * G + c, T = (L >> 5) * 8 + (L & 7), pn = (L >> 3) & 3; if (4 * T >= uni(tb[32])) return false;
        int e = 0; while (uni(tb[e + 1]) <= 4 * T) ++e;
        const int tm = T - (uni(tb[e]) >> 2), cnt = uni(tb[128 + e]), rem = cnt - tm * 256, ho = uni(tb[64 + e]);
        u.pm = tm; u.pn = pn; u.aux = e; u.nvalid = rem < 256 ? rem : 256; u.rows = rowl + (size_t)e * CAP + tm * 256;
        if (WHICH == 1) { u.a = A; u.b = B + ((size_t)e * 1024 + pn * 256) * 2048; }
        else { u.a = A + (size_t)(ho + tm * 256) * 1024; u.b = B + ((size_t)e * 1024 + pn * 256) * 1024; }
        return true;
    }
    __device__ __forceinline__ int row(const MUnit& u, int r) const { return WHICH == 1 ? (u.rows[r < u.nvalid ? r : u.nvalid - 1] >> 1) : r; }
};
struct EpiMoe1 {
    static constexpr bool PERM = true, META = true;
    bf16_t* H; const f32x4* rowm; const float *csg, *bsg; LAS int* tb;
    __device__ __forceinline__ mm::Meta meta_load(const MUnit& u, int t) const { const int r = t < u.nvalid ? t : u.nvalid - 1; const f32x4 rm = rowm[(size_t)u.aux * CAP + u.pm * 256 + r];
        const int wrow = u.aux * 1024 + u.pn * 256 + t; mm::Meta m; m.r0 = rm[1]; m.r1 = rm[2]; m.r2 = 0; m.c0 = csg[wrow]; m.c1 = bsg[wrow]; return m; }
    __device__ __forceinline__ void operator()(const AccT& acc, const MUnit& u, int wr, int wc, int fr, int fq, const LAS float* ms) const {
        const int e = u.aux, hrow0 = uni(tb[64 + e]) + u.pm * 256, c8 = wc * 32 + 8 * fq;
        f32x4 cg[2], bg[2], cu[2], bu[2];
#pragma unroll
        for (int n = 0; n < 2; ++n) { cg[n] = *(const LAS f32x4*)(ms + 768 + c8 + 4 * n); bg[n] = *(const LAS f32x4*)(ms + 1024 + c8 + 4 * n); cu[n] = *(const LAS f32x4*)(ms + 768 + 128 + c8 + 4 * n); bu[n] = *(const LAS f32x4*)(ms + 1024 + 128 + c8 + 4 * n); }
#pragma unroll
        for (int ai = 0; ai < 2; ++ai)
#pragma unroll
            for (int m = 0; m < 4; ++m) { const int rl = ai * 128 + wr * 64 + m * 16 + fr; const float mu = ms[rl], rs = ms[256 + rl];
                f32x4 hv[2];
#pragma unroll
                for (int n = 0; n < 2; ++n) { const f32x4 g = rs * (acc[ai][0][m][n] - mu * cg[n]) + bg[n], uu = rs * (acc[ai][1][m][n] - mu * cu[n]) + bu[n];
#pragma unroll
                    for (int j = 0; j < 4; ++j) hv[n][j] = g[j] * __builtin_amdgcn_rcpf(1.0f + __builtin_amdgcn_exp2f(-LOG2E * g[j])) * uu[j]; }
                *(u32x4*)(H + (size_t)(hrow0 + rl) * DEXP + u.pn * 128 + c8) = pack8(hv[0], hv[1]); }
    }
};
struct EpiMoe2 {
    static constexpr bool PERM = true, META = true;
    bf16_t* Y; const f32x4* rowm;
    __device__ __forceinline__ mm::Meta meta_load(const MUnit& u, int t) const { const int r = t < u.nvalid ? t : u.nvalid - 1; mm::Meta m; m.r0 = rowm[(size_t)u.aux * CAP + u.pm * 256 + r][0]; m.r1 = 0.f; m.r2 = u.rows[r]; m.c0 = 0.f; m.c1 = 0.f; return m; }
    __device__ __forceinline__ void operator()(const AccT& acc, const MUnit& u, int wr, int wc, int fr, int fq, const LAS float* ms) const {
#pragma unroll
        for (int ai = 0; ai < 2; ++ai)
#pragma unroll
            for (int m = 0; m < 4; ++m) { const int rl = ai * 128 + wr * 64 + m * 16 + fr;
                if (rl < u.nvalid) { const int a = ((const LAS int*)ms)[512 + rl]; const float g = ms[rl];
#pragma unroll
                    for (int bj = 0; bj < 2; ++bj) *(u32x4*)(Y + (size_t)a * DM + u.pn * 256 + bj * 128 + wc * 32 + 8 * fq) = pack8(g * acc[ai][bj][m][0], g * acc[ai][bj][m][1]); } }
    }
};
__device__ __forceinline__ void phase_proj_fast(const Params& p, LAS unsigned char* lds) {
    unsigned char* ws = p.ws;
    SchedProj S{(const char*)(ws + WS_XB), (const char*)(ws + WS_WIN), (const char*)(ws + WS_MEMB), (const char*)(ws + WS_WMK), (const char*)(ws + WS_WMV), (int)gridDim.x, (int)blockIdx.x};
    EpiProj E{(bf16_t*)(ws + WS_PROJ), (bf16_t*)(ws + WS_VT), (bf16_t*)(ws + WS_MEMK), (bf16_t*)(ws + WS_MEMVT)};
    mm::gemm_phase<EpiProj, SchedProj, false>(lds, DM, S, E);
}
__device__ __forceinline__ void phase_outproj_fast(const Params& p, LAS unsigned char* lds) {
    unsigned char* ws = p.ws;
    SchedDense S{(const char*)(ws + WS_YMIX), (const char*)(ws + WS_WOUT), NTOK / 256, DM / 256, (int)gridDim.x, (int)blockIdx.x};
    EpiOut E{(bf16_t*)(ws + WS_T1B), (stat_t*)(ws + WS_STATS1)};
    mm::gemm_phase<EpiOut, SchedDense, false>(lds, DM, S, E);
}
__device__ __forceinline__ void phase_mq_fast(const Params& p, LAS unsigned char* lds) {
    unsigned char* ws = p.ws;
    SchedDense S{(const char*)(ws + WS_T1B), (const char*)(ws + WS_WMQ), NTOK / 256, DM / 256, (int)gridDim.x, (int)blockIdx.x};
    EpiMq E{(bf16_t*)(ws + WS_QM), (const stat_t*)(ws + WS_STATS1), (const float*)(ws + WS_CS1), (const float*)(ws + WS_CS1) + 1024};
    mm::gemm_phase<EpiMq, SchedDense, false>(lds, DM, S, E);
}
__device__ __forceinline__ void phase_mo_fast(const Params& p, LAS unsigned char* lds) {
    unsigned char* ws = p.ws;
    SchedDense S{(const char*)(ws + WS_OB), (const char*)(ws + WS_WMO), NTOK / 256, DM / 256, (int)gridDim.x, (int)blockIdx.x};
    EpiMo E{(const bf16_t*)(ws + WS_T1B), (const stat_t*)(ws + WS_STATS1), p.ln1_g, p.ln1_b, (bf16_t*)(ws + WS_T2B), (stat_t*)(ws + WS_STATS2)};
    mm::gemm_phase<EpiMo, SchedDense, false>(lds, DM, S, E);
}
__device__ __forceinline__ void phase_router_fast(const Params& p, LAS unsigned char* lds) {
    unsigned char* ws = p.ws;
    SchedDense S{(const char*)(ws + WS_T2B), (const char*)(ws + WS_WRT), NTOK / 256, 1, (int)gridDim.x, (int)blockIdx.x};
    EpiRouter E{(float*)(ws + WS_LOGIT), (const stat_t*)(ws + WS_STATS2), (const float*)(ws + WS_CS2), (const float*)(ws + WS_CS2) + 64};
    mm::gemm_phase<EpiRouter, SchedDense, false>(lds, DM, S, E);
    if (gridDim.x == NTOK / 256) { int pm, pn; mm::order_map((int)blockIdx.x, NTOK / 256, 1, pm, pn); asm volatile("s_waitcnt vmcnt(0)" ::: "memory"); __syncthreads(); phase_route(p, (unsigned char*)lds, pm * 256); }
}
__device__ __forceinline__ void phase_moe1_fast(const Params& p, LAS unsigned char* lds) {
    unsigned char* ws = p.ws; LAS int* tb = (LAS int*)(lds + MOE_TB_OFF);
    moe_tables((const unsigned*)(ws + WS_CNT), tb);
    SchedMoe<1> S{(const char*)(ws + WS_T2B), (const char*)(ws + WS_WGU), (const int*)(ws + WS_ROWL), tb, (int)gridDim.x, (int)blockIdx.x};
    EpiMoe1 E{(bf16_t*)(ws + WS_H), (const f32x4*)p.out, (const float*)(ws + WS_CSGU), (const float*)(ws + WS_CSGU) + NEXP * 1024, tb};
    mm::gemm_phase<EpiMoe1, SchedMoe<1>, true>(lds, DM, S, E);
}
__device__ __forceinline__ void phase_moe2_fast(const Params& p, LAS unsigned char* lds) {
    unsigned char* ws = p.ws; LAS int* tb = (LAS int*)(lds + MOE_TB_OFF);
    moe_tables((const unsigned*)(ws + WS_CNT), tb);
    SchedMoe<2> S{(const char*)(ws + WS_H), (const char*)(ws + WS_WD), (const int*)(ws + WS_ROWL), tb, (int)gridDim.x, (int)blockIdx.x};
    EpiMoe2 E{(bf16_t*)(ws + WS_Y), (const f32x4*)p.out};
    mm::gemm_phase<EpiMoe2, SchedMoe<2>, false>(lds, DEXP, S, E);
}


struct SchedFold {
    const char *memk, *memv, *wqp, *wmot; int G, c;
    __device__ __forceinline__ bool next(int i, MUnit& u) const {
        const int L = i * G + c; if (L >= 1024) return false;
        const int job = L >> 9, l = L & 511, b = l >> 4, h = (l >> 2) & 3, t = l & 3;
        u.aux = job; u.nvalid = 256; u.rows = nullptr;
        if (job == 0) { u.pm = b * 4 + h; u.pn = t; u.a = memk + ((size_t)(b * 256) * 1024 + h * 256) * 2; u.b = wqp + ((size_t)(t * 256) * 1024 + h * 256) * 2; }
        else { u.pm = b * 4 + t; u.pn = h; u.a = wmot + ((size_t)(t * 256) * 1024 + h * 256) * 2; u.b = memv + ((size_t)(b * 256) * 1024 + h * 256) * 2; }
        return true;
    }
    __device__ __forceinline__ int row(const MUnit&, int r) const { return r; }
};
struct EpiFold {
    static constexpr bool PERM = true, META = false;
    bf16_t *wqk, *vwt; stat_t* csb;
    __device__ __forceinline__ mm::Meta meta_load(const MUnit&, int) const { return mm::Meta{}; }
    __device__ __forceinline__ void operator()(const AccT& acc, const MUnit& u, int wr, int wc, int fr, int fq, const LAS float*) const {
        bf16_t* O = u.aux == 0 ? wqk : vwt;
#pragma unroll
        for (int ai = 0; ai < 2; ++ai)
#pragma unroll
            for (int m = 0; m < 4; ++m) { const int row = u.pm * 256 + ai * 128 + wr * 64 + m * 16 + fr; float sum = 0.f;
#pragma unroll
                for (int bj = 0; bj < 2; ++bj) { const u32x4 w = pack8(acc[ai][bj][m][0], acc[ai][bj][m][1]); *(u32x4*)(O + (size_t)row * DM + u.pn * 256 + bj * 128 + wc * 32 + 8 * fq) = w; sum += sum4(unpack_lo(w)) + sum4(unpack_hi(w)); }
                if (u.aux == 0) { sum += __shfl_xor(sum, 16); sum += __shfl_xor(sum, 32); if (fq == 0) atomicAdd((unsigned long long*)csb + row, (unsigned long long)__float2ll_rn(sum * CS_SCALE)); } }
    }
};
__device__ __forceinline__ void phase_fold(const Params& p, LAS unsigned char* lds) {
    unsigned char* ws = p.ws;
    SchedFold S{(const char*)(ws + WS_MEMK), (const char*)(ws + WS_MEMV), (const char*)(ws + WS_WQP), (const char*)(ws + WS_WMO), (int)gridDim.x, (int)blockIdx.x};
    EpiFold E{(bf16_t*)(ws + WS_WQK), (bf16_t*)(ws + WS_VWT), (stat_t*)(ws + WS_CSB)};
    mm::gemm_phase<EpiFold, SchedFold, false>(lds, 256, S, E, 1024);
    const int lane = threadIdx.x & 63, gw = blockIdx.x * 8 + (threadIdx.x >> 6), NGW = gridDim.x * 8;
    const bf16_t* MK = (const bf16_t*)(ws + WS_MEMK); const stat_t* bqi = (const stat_t*)(ws + WS_CSI) + 1024; float* bsb = (float*)(ws + WS_BSB);
    for (int o = gw; o < NB * 1024; o += NGW) { const int b = o >> 10, hk = o & 1023, h = hk >> 8, key = hk & 255;
        const u32x2 kv = *(const u32x2*)(MK + (size_t)(b * 256 + key) * DM + h * 256 + 4 * lane); f32x4 bv; for (int e = 0; e < 4; ++e) bv[e] = (float)bqi[h * 256 + 4 * lane + e] * CS_INV;
        float d = bv[0] * __uint_as_float(kv.x << 16) + bv[1] * __uint_as_float(kv.x & 0xffff0000u) + bv[2] * __uint_as_float(kv.y << 16) + bv[3] * __uint_as_float(kv.y & 0xffff0000u);
        d = wave_sum(d); if (lane == 0) bsb[o] = d; }
}
struct SchedBatchB {
    const char *A, *B; int G, c;
    __device__ __forceinline__ bool next(int i, MUnit& u) const {
        const int L = i * G + c; if (L >= (NTOK / 256) * 4) return false;
        int pm, pn; mm::order_map(L, NTOK / 256, 4, pm, pn); u.pm = pm; u.pn = pn; u.aux = 0; u.nvalid = 256; u.rows = nullptr;
        u.a = A + (size_t)pm * 256 * 2048; u.b = B + ((size_t)(pm >> 3) * 1024 + pn * 256) * 2048; return true;
    }
    __device__ __forceinline__ int row(const MUnit&, int r) const { return r; }
};
struct EpiSoftmax {
    static constexpr bool PERM = true, META = true;
    bf16_t* pb; const stat_t* st; const stat_t* csb; const float* bsb; LAS unsigned char* ldsx;
    __device__ __forceinline__ mm::Meta meta_load(const MUnit& u, int t) const { const RowStat r = row_stat(st, u.pm * 256 + t); const int n = (u.pm >> 3) * 1024 + u.pn * 256 + t;
        mm::Meta m; m.r0 = r.mean; m.r1 = r.rstd; m.r2 = 0; m.c0 = (float)csb[n] * CS_INV; m.c1 = bsb[n]; return m; }
    __device__ __forceinline__ void operator()(const AccT& acc, const MUnit& u, int wr, int wc, int fr, int fq, const LAS float* ms) const {
        LAS float* xq = (LAS float*)ldsx;
        f32x4 v[2][4][2][2];
        float mx[8];
#pragma unroll
        for (int bj = 0; bj < 2; ++bj) { const int cl = bj * 128 + wc * 32 + 8 * fq;
            const f32x4 c0 = *(const LAS f32x4*)(ms + 768 + cl), c1 = *(const LAS f32x4*)(ms + 768 + cl + 4), b0 = *(const LAS f32x4*)(ms + 1024 + cl), b1 = *(const LAS f32x4*)(ms + 1024 + cl + 4);
#pragma unroll
            for (int ai = 0; ai < 2; ++ai)
#pragma unroll
                for (int m = 0; m < 4; ++m) { const int rl = ai * 128 + wr * 64 + m * 16 + fr; const float mu = ms[rl], rs = ms[256 + rl];
                    v[ai][m][bj][0] = rs * (acc[ai][bj][m][0] - mu * c0) + b0; v[ai][m][bj][1] = rs * (acc[ai][bj][m][1] - mu * c1) + b1; } }
#pragma unroll
        for (int g = 0; g < 8; ++g) { float a = -INFINITY;
#pragma unroll
            for (int bj = 0; bj < 2; ++bj)
#pragma unroll
                for (int hf = 0; hf < 2; ++hf) { const f32x4 x = v[g >> 2][g & 3][bj][hf]; a = fmaxf(fmaxf(a, fmaxf(x[0], x[1])), fmaxf(x[2], x[3])); }
            a = fmaxf(a, __shfl_xor(a, 16)); a = fmaxf(a, __shfl_xor(a, 32)); mx[g] = a;
            if (fq == 0) xq[((g >> 2) * 128 + wr * 64 + (g & 3) * 16 + fr) * 4 + wc] = a; }
        asm volatile("s_waitcnt lgkmcnt(0)" ::: "memory"); __builtin_amdgcn_s_barrier(); asm volatile("" ::: "memory");
        float sm[8];
#pragma unroll
        for (int g = 0; g < 8; ++g) { const f32x4 q = *(const LAS f32x4*)(xq + ((g >> 2) * 128 + wr * 64 + (g & 3) * 16 + fr) * 4); const float M = fmaxf(fmaxf(q[0], q[1]), fmaxf(q[2], q[3])); float sacc = 0.f;
#pragma unroll
            for (int bj = 0; bj < 2; ++bj)
#pragma unroll
                for (int hf = 0; hf < 2; ++hf) { f32x4 x = v[g >> 2][g & 3][bj][hf];
#pragma unroll
                    for (int j = 0; j < 4; ++j) { x[j] = __builtin_amdgcn_exp2f(x[j] - M); sacc += x[j]; }
                    v[g >> 2][g & 3][bj][hf] = x; }
            sacc += __shfl_xor(sacc, 16); sacc += __shfl_xor(sacc, 32); sm[g] = sacc; }
        asm volatile("s_waitcnt lgkmcnt(0)" ::: "memory"); __builtin_amdgcn_s_barrier(); asm volatile("" ::: "memory");
#pragma unroll
        for (int g = 0; g < 8; ++g) if (fq == 0) xq[((g >> 2) * 128 + wr * 64 + (g & 3) * 16 + fr) * 4 + wc] = sm[g];
        asm volatile("s_waitcnt lgkmcnt(0)" ::: "memory"); __builtin_amdgcn_s_barrier(); asm volatile("" ::: "memory");
#pragma unroll
        for (int g = 0; g < 8; ++g) { const f32x4 q = *(const LAS f32x4*)(xq + ((g >> 2) * 128 + wr * 64 + (g & 3) * 16 + fr) * 4); const float inv = __builtin_amdgcn_rcpf((q[0] + q[1]) + (q[2] + q[3]));
            const int row = u.pm * 256 + (g >> 2) * 128 + wr * 64 + (g & 3) * 16 + fr;
#pragma unroll
            for (int bj = 0; bj < 2; ++bj) *(u32x4*)(pb + (size_t)row * DM + u.pn * 256 + bj * 128 + wc * 32 + 8 * fq) = pack8(v[g >> 2][g & 3][bj][0] * inv, v[g >> 2][g & 3][bj][1] * inv); }
        asm volatile("s_waitcnt lgkmcnt(0)" ::: "memory"); __builtin_amdgcn_s_barrier(); asm volatile("" ::: "memory");
    }
};
__device__ __forceinline__ void phase_scores_fast(const Params& p, LAS unsigned char* lds) {
    unsigned char* ws = p.ws;
    SchedBatchB S{(const char*)(ws + WS_T1B), (const char*)(ws + WS_WQK), (int)gridDim.x, (int)blockIdx.x};
    EpiSoftmax E{(bf16_t*)(ws + WS_OB), (const stat_t*)(ws + WS_STATS1), (const stat_t*)(ws + WS_CSB), (const float*)(ws + WS_BSB), lds + 133120};
    mm::gemm_phase<EpiSoftmax, SchedBatchB, false>(lds, DM, S, E);
}
__device__ __forceinline__ void phase_mo_fold(const Params& p, LAS unsigned char* lds) {
    unsigned char* ws = p.ws;
    SchedBatchB S{(const char*)(ws + WS_OB), (const char*)(ws + WS_VWT), (int)gridDim.x, (int)blockIdx.x};
    EpiMo E{(const bf16_t*)(ws + WS_T1B), (const stat_t*)(ws + WS_STATS1), p.ln1_g, p.ln1_b, (bf16_t*)(ws + WS_T2B), (stat_t*)(ws + WS_STATS2)};
    mm::gemm_phase<EpiMo, SchedBatchB, false>(lds, DM, S, E);
}

constexpr int SB_LDS_WAVE = 18432, SB_KROW = 144, SB_VROW = 136;
__device__ __forceinline__ float fexp2(float x) { return __builtin_amdgcn_exp2f(x); }
__device__ __forceinline__ float flog2(float x) { return __builtin_amdgcn_logf(x); }

template <bool MASK>
__device__ __forceinline__ void sb_scan(f32x16 (&pp)[2], float& R, const int kb, const int lim, const int hi) {
    float gp[8];
#pragma unroll
    for (int a = 0; a < 8; ++a) {
        float be[4], om[4];
#pragma unroll
        for (int i = 0; i < 4; ++i) { const float sc = __builtin_amdgcn_fmed3f(pp[a >> 2][4 * (a & 3) + i], -80.f, 80.f);
            const float e = fexp2(-sc); be[i] = __builtin_amdgcn_rcpf(1.0f + e); om[i] = e * be[i];
            if (MASK) { const int kv = kb + 8 * a + 4 * hi + i; if (!(kv < lim)) { be[i] = 0.f; om[i] = 1.f; } } }
        const float s23 = om[2] * om[3], s123 = om[1] * s23;
        pp[a >> 2][4 * (a & 3) + 3] = be[3];
        pp[a >> 2][4 * (a & 3) + 2] = be[2] * om[3];
        pp[a >> 2][4 * (a & 3) + 1] = be[1] * s23;
        pp[a >> 2][4 * (a & 3) + 0] = be[0] * s123;
        gp[a] = om[0] * s123;
        if (a < 7) { const int an = a + 1;
            asm volatile("" : "+v"(gp[a]), "+v"(pp[an >> 2][4 * (an & 3) + 0]), "+v"(pp[an >> 2][4 * (an & 3) + 1]), "+v"(pp[an >> 2][4 * (an & 3) + 2]), "+v"(pp[an >> 2][4 * (an & 3) + 3])); }
    }
    float base[8];
    {
        float ev[8], od[8];
#pragma unroll
        for (int a = 0; a < 8; ++a) { const unsigned own = __float_as_uint(gp[a]); auto rr = __builtin_amdgcn_permlane32_swap(own, own, false, false);
            const float other = __uint_as_float(rr[0] == own ? rr[1] : rr[0]);
            ev[a] = hi ? other : gp[a]; od[a] = hi ? gp[a] : other; }
        float run = R;
#pragma unroll
        for (int a = 7; a >= 0; --a) { const float b_od = run; run *= od[a]; const float b_ev = run; run *= ev[a]; base[a] = hi ? b_od : b_ev; }
        R = run;
    }
#pragma unroll
    for (int a = 0; a < 8; ++a)
#pragma unroll
        for (int i = 0; i < 4; ++i) pp[a >> 2][4 * (a & 3) + i] *= base[a];
}

constexpr int SB_SLOT = 64 * SB_KROW + 64 * SB_VROW  , SB_NSLOT = 7, SB_GAIN_OFF = SB_NSLOT * SB_SLOT;
__device__ __forceinline__ void phase_sb_fast(const Params& p, LAS unsigned char* lds) {
    unsigned char* ws = p.ws; const int lane = threadIdx.x & 63, wave = __builtin_amdgcn_readfirstlane(threadIdx.x >> 6), r32 = lane & 31, hi = lane >> 5;
    const bf16_t* PROJ = (const bf16_t*)(ws + WS_PROJ); const bf16_t* VT = (const bf16_t*)(ws + WS_VT); bf16_t* YMIX = (bf16_t*)(ws + WS_YMIX);
    const int srow = lane >> 3, sch = lane & 7;
    const unsigned koff = (unsigned)(srow * NPROJ + 8 * sch) * 2u, voff = (unsigned)(srow * VT_LD + 8 * sch) * 2u;
    constexpr int NGRP = NB * NHEAD * (SEQ / 256);
    LAS unsigned char* myslot = lds + wave * SB_SLOT;
    LAS float* gl = (LAS float*)(lds + SB_GAIN_OFF);
    LAS float* cwl = (LAS float*)(lds + SB_GAIN_OFF + 256);
    for (int i = threadIdx.x; i < 2048; i += 512) cwl[i] = i < 1536 ? p.conv_w[i] : p.gn_conv[i - 1536];
    u32x4 kst[8], vst[8]; bf16x8 qf[4];
#define SB_LOADT(Kg_, Vg_, kbx) do { const char* kt_ = (const char*)((Kg_) + (size_t)(kbx) * NPROJ); const char* vt_ = (const char*)((Vg_) + (kbx)); \
        _Pragma("unroll") for (int i = 0; i < 8; ++i) { kst[i] = *(const u32x4*)(kt_ + (size_t)i * (8 * NPROJ * 2) + koff); vst[i] = *(const u32x4*)(vt_ + (size_t)i * (8 * VT_LD * 2) + voff); } } while (0)
#define SB_WRITET(kl_) do { _Pragma("unroll") for (int i = 0; i < 8; ++i) { *(LAS u32x4*)((kl_) + (srow + 8 * i) * SB_KROW + 16 * sch) = kst[i]; \
        *(LAS u32x2*)((kl_) + 64 * SB_KROW + (srow + 8 * i) * SB_VROW + 16 * sch) = (u32x2){vst[i].x, vst[i].y}; *(LAS u32x2*)((kl_) + 64 * SB_KROW + (srow + 8 * i) * SB_VROW + 16 * sch + 8) = (u32x2){vst[i].z, vst[i].w}; } } while (0)
#define SB_GROUP(g_, b_, h_, q0_, Kg_, Vg_) do { const int bh_ = (g_) >> 3; b_ = bh_ >> 3; h_ = bh_ & 7; q0_ = ((g_) & 7) * 256; \
        Kg_ = PROJ + (size_t)(b_ * SEQ) * NPROJ + C_K + h_ * 64; Vg_ = VT + (size_t)(h_ * 64) * VT_LD + b_ * SEQ; } while (0)
#define SB_LOADQ(dst, b_, h_, r0_) do { const bf16_t* qp_ = PROJ + (size_t)(b_ * SEQ + r0_ + r32) * NPROJ + C_Q + h_ * 64 + 8 * hi; \
        _Pragma("unroll") for (int d0 = 0; d0 < 4; ++d0) dst[d0] = *(const bf16x8*)(qp_ + 16 * d0); } while (0)
    int g = blockIdx.x, b = 0, h = 0, q0 = 0; const bf16_t* Kg = PROJ; const bf16_t* Vg = VT;
    if (g < NGRP) { SB_GROUP(g, b, h, q0, Kg, Vg); SB_LOADQ(qf, b, h, q0 + 32 * wave); const int tl = (q0 >> 6) + 3 - wave; if (wave < SB_NSLOT && tl >= 0) SB_LOADT(Kg, Vg, 64 * tl); }
    while (g < NGRP) {
        const int ttop = (q0 >> 6) + 3, r0 = q0 + 32 * wave;
        if (wave < SB_NSLOT && ttop - wave >= 0) SB_WRITET(myslot);
        if (wave == 7) gl[lane] = p.gn_sb[h * 64 + lane];
        asm volatile("s_waitcnt vmcnt(0) lgkmcnt(0)" ::: "memory");
        asm volatile("" : "+v"(qf[0]), "+v"(qf[1]), "+v"(qf[2]), "+v"(qf[3]));
        __builtin_amdgcn_s_barrier();
        asm volatile("" ::: "memory");
        const int gn = g + gridDim.x; const int bc = b, hc = h; const bf16_t* Kc = Kg; const bf16_t* Vc = Vg; bf16x8 qn[4];
        if (gn < NGRP) { SB_GROUP(gn, b, h, q0, Kg, Vg); SB_LOADQ(qn, b, h, q0 + 32 * wave); const int tl = (q0 >> 6) + 3 - wave; if (wave < SB_NSLOT && tl >= 0) SB_LOADT(Kg, Vg, 64 * tl); }
        f32x16 o[2];
#pragma unroll
        for (int r = 0; r < 16; ++r) { o[0][r] = 0.f; o[1][r] = 0.f; }
        float R = 1.0f;
        for (int T = (r0 + 31) >> 6, j = 0; T >= 0; --T, ++j) {
            const int kb = 64 * T, si = ttop - T;
            f32x16 pp[2];
#pragma unroll
            for (int r = 0; r < 16; ++r) { pp[0][r] = 0.f; pp[1][r] = 0.f; }
            const LAS unsigned char* kl = lds + si * SB_SLOT;
            if (si < SB_NSLOT) {
#pragma unroll
                for (int half = 0; half < 2; ++half)
#pragma unroll
                    for (int d0 = 0; d0 < 4; ++d0) { const bf16x8 kf = *(const LAS bf16x8*)(kl + (32 * half + r32) * SB_KROW + 32 * d0 + 16 * hi); pp[half] = MFMA32(kf, qf[d0], pp[half]); }
            } else {
#pragma unroll
                for (int half = 0; half < 2; ++half)
#pragma unroll
                    for (int d0 = 0; d0 < 4; ++d0) { const bf16x8 kf = *(const bf16x8*)(Kc + (size_t)(kb + 32 * half + r32) * NPROJ + 16 * d0 + 8 * hi); pp[half] = MFMA32(kf, qf[d0], pp[half]); }
            }
            __builtin_amdgcn_sched_barrier(0);
            if (j == 0) sb_scan<true>(pp, R, kb, r0 + r32, hi); else sb_scan<false>(pp, R, kb, r0 + r32, hi);
            __builtin_amdgcn_sched_barrier(0);
            u32x4 pw[4];
#pragma unroll
            for (int ks = 0; ks < 4; ++ks) {
                pw[ks].x = mm::cvt_pk_bf16(pp[ks >> 1][8 * (ks & 1) + 0], pp[ks >> 1][8 * (ks & 1) + 1]); pw[ks].y = mm::cvt_pk_bf16(pp[ks >> 1][8 * (ks & 1) + 2], pp[ks >> 1][8 * (ks & 1) + 3]);
                pw[ks].z = mm::cvt_pk_bf16(pp[ks >> 1][8 * (ks & 1) + 4], pp[ks >> 1][8 * (ks & 1) + 5]); pw[ks].w = mm::cvt_pk_bf16(pp[ks >> 1][8 * (ks & 1) + 6], pp[ks >> 1][8 * (ks & 1) + 7]); }
            if (si < SB_NSLOT) {
#pragma unroll
                for (int ks = 0; ks < 4; ++ks)
#pragma unroll
                    for (int dh = 0; dh < 2; ++dh) { const LAS unsigned char* vp = kl + 64 * SB_KROW + (32 * dh + r32) * SB_VROW + 32 * ks + 8 * hi;
                        const u32x2 lo = *(const LAS u32x2*)vp, hh = *(const LAS u32x2*)(vp + 16); const u32x4 vf = {lo.x, lo.y, hh.x, hh.y};
                        o[dh] = MFMA32(__builtin_bit_cast(bf16x8, vf), __builtin_bit_cast(bf16x8, pw[ks]), o[dh]); }
            } else {
#pragma unroll
                for (int ks = 0; ks < 4; ++ks)
#pragma unroll
                    for (int dh = 0; dh < 2; ++dh) { const bf16_t* vp = Vc + (size_t)(32 * dh + r32) * VT_LD + kb + 16 * ks + 4 * hi;
                        const u32x2 lo = *(const u32x2*)vp, hh = *(const u32x2*)(vp + 8); const u32x4 vf = {lo.x, lo.y, hh.x, hh.y};
                        o[dh] = MFMA32(__builtin_bit_cast(bf16x8, vf), __builtin_bit_cast(bf16x8, pw[ks]), o[dh]); }
            }
            if (__all(R == 0.0f)) break;
        }
        bf16_t* yp = YMIX + (size_t)(bc * SEQ + r0 + r32) * DM + 512 + hc * 64 + 4 * hi;
        f32x4 gv[2][4];
#pragma unroll
        for (int dh = 0; dh < 2; ++dh)
#pragma unroll
            for (int g4 = 0; g4 < 4; ++g4) gv[dh][g4] = *(const LAS f32x4*)(gl + 4 * hi + 32 * dh + 8 * g4);
        float ss = 0.f;
#pragma unroll
        for (int r = 0; r < 16; ++r) ss += o[0][r] * o[0][r] + o[1][r] * o[1][r];
        ss += __shfl_xor(ss, 32);
        const float rn = __builtin_amdgcn_rsqf(ss * (1.f / 64.f) + RMS_EPS);
#pragma unroll
        for (int dh = 0; dh < 2; ++dh)
#pragma unroll
            for (int g4 = 0; g4 < 4; ++g4) { const f32x4 gg = gv[dh][g4];
                u32x2 w; w.x = mm::cvt_pk_bf16(o[dh][4 * g4] * rn * gg[0], o[dh][4 * g4 + 1] * rn * gg[1]); w.y = mm::cvt_pk_bf16(o[dh][4 * g4 + 2] * rn * gg[2], o[dh][4 * g4 + 3] * rn * gg[3]);
                *(u32x2*)(yp + 32 * dh + 8 * g4) = w; }
#pragma unroll
        for (int d0 = 0; d0 < 4; ++d0) qf[d0] = qn[d0];
        { const int ci = g * 8 + wave, tok0 = 4 * ci, t0 = tok0 & (SEQ - 1), c0 = 8 * lane;
          u32x4 cw_[6], hw_[6], bw_[4];
#pragma unroll
          for (int i = 0; i < 6; ++i) { const int tk = (t0 == 0 && i < 2) ? tok0 : tok0 - 2 + i; const bf16_t* row = PROJ + (size_t)tk * NPROJ + c0; cw_[i] = *(const u32x4*)(row + C_CC); hw_[i] = *(const u32x4*)(row + C_CH); if (i >= 2) bw_[i - 2] = *(const u32x4*)(row + C_CB); }
          f32x4 w0l = *(const LAS f32x4*)(cwl + c0), w0h = *(const LAS f32x4*)(cwl + c0 + 4), w1l = *(const LAS f32x4*)(cwl + 512 + c0), w1h = *(const LAS f32x4*)(cwl + 512 + c0 + 4);
          f32x4 w2l = *(const LAS f32x4*)(cwl + 1024 + c0), w2h = *(const LAS f32x4*)(cwl + 1024 + c0 + 4), gl_ = *(const LAS f32x4*)(cwl + 1536 + c0), gh_ = *(const LAS f32x4*)(cwl + 1536 + c0 + 4);
          f32x4 ul[6], uh[6];
#pragma unroll
          for (int i = 0; i < 6; ++i) { ul[i] = unpack_lo(cw_[i]) * unpack_lo(hw_[i]); uh[i] = unpack_hi(cw_[i]) * unpack_hi(hw_[i]); if (t0 == 0 && i < 2) { ul[i] = ul[i] * 0.f; uh[i] = uh[i] * 0.f; } }
#pragma unroll
          for (int i = 0; i < 4; ++i) {
              const f32x4 yl = unpack_lo(bw_[i]) * (w0l * ul[i] + w1l * ul[i + 1] + w2l * ul[i + 2]), yh = unpack_hi(bw_[i]) * (w0h * uh[i] + w1h * uh[i + 1] + w2h * uh[i + 2]);
              float ssq = sq4(yl) + sq4(yh); ssq += __shfl_xor(ssq, 1); ssq += __shfl_xor(ssq, 2); ssq += __shfl_xor(ssq, 4);
              const float rnc = __builtin_amdgcn_rsqf(ssq * (1.f / 64.f) + RMS_EPS);
              *(u32x4*)(YMIX + (size_t)(tok0 + i) * DM + c0) = pack8(yl * rnc * gl_, yh * rnc * gh_); } }
        g = gn;
        asm volatile("s_waitcnt lgkmcnt(0)" ::: "memory");
        __builtin_amdgcn_s_barrier();
        asm volatile("" ::: "memory");
    }
#undef SB_LOADT
#undef SB_WRITET
#undef SB_GROUP
#undef SB_LOADQ
}
__device__ __forceinline__ void phase_conv_fast(const Params& p) {
    unsigned char* ws = p.ws; const int lane = threadIdx.x & 63, wave = threadIdx.x >> 6; const int gw = blockIdx.x * 8 + wave, NGW = gridDim.x * 8;
    const bf16_t* PROJ = (const bf16_t*)(ws + WS_PROJ); bf16_t* YMIX = (bf16_t*)(ws + WS_YMIX);
    const int c0 = 8 * lane;
    float w0[8], w1[8], w2[8], gn[8];
#pragma unroll
    for (int e = 0; e < 8; ++e) { w0[e] = p.conv_w[c0 + e]; w1[e] = p.conv_w[512 + c0 + e]; w2[e] = p.conv_w[1024 + c0 + e]; gn[e] = p.gn_conv[c0 + e]; }
    constexpr int TCH = 16;
    for (int it = gw; it < NTOK / TCH; it += NGW) {
        const int tok0 = it * TCH, t0 = tok0 % SEQ;
        float um2[8], um1[8];
#pragma unroll
        for (int e = 0; e < 8; ++e) { um2[e] = 0.f; um1[e] = 0.f; }
        if (t0 >= 2) {
            const u32x4 a2 = *(const u32x4*)(PROJ + (size_t)(tok0 - 2) * NPROJ + C_CC + c0), h2 = *(const u32x4*)(PROJ + (size_t)(tok0 - 2) * NPROJ + C_CH + c0);
            const u32x4 a1 = *(const u32x4*)(PROJ + (size_t)(tok0 - 1) * NPROJ + C_CC + c0), h1 = *(const u32x4*)(PROJ + (size_t)(tok0 - 1) * NPROJ + C_CH + c0);
            const f32x4 a2l = unpack_lo(a2), a2h = unpack_hi(a2), h2l = unpack_lo(h2), h2h = unpack_hi(h2), a1l = unpack_lo(a1), a1h = unpack_hi(a1), h1l = unpack_lo(h1), h1h = unpack_hi(h1);
#pragma unroll
            for (int e = 0; e < 4; ++e) { um2[e] = a2l[e] * h2l[e]; um2[4 + e] = a2h[e] * h2h[e]; um1[e] = a1l[e] * h1l[e]; um1[4 + e] = a1h[e] * h1h[e]; }
        }
#pragma unroll 1
        for (int i0 = 0; i0 < TCH; i0 += 4) {
            u32x4 bw[4], cw[4], hw[4];
#pragma unroll
            for (int i = 0; i < 4; ++i) { const bf16_t* row = PROJ + (size_t)(tok0 + i0 + i) * NPROJ + c0; bw[i] = *(const u32x4*)(row + C_CB); cw[i] = *(const u32x4*)(row + C_CC); hw[i] = *(const u32x4*)(row + C_CH); }
#pragma unroll
            for (int i = 0; i < 4; ++i) {
                const f32x4 bl = unpack_lo(bw[i]), bh_ = unpack_hi(bw[i]), cl = unpack_lo(cw[i]), ch_ = unpack_hi(cw[i]), hl = unpack_lo(hw[i]), hh = unpack_hi(hw[i]);
                float y[8], ss = 0.f;
#pragma unroll
                for (int e = 0; e < 8; ++e) { const float u = (e < 4 ? cl[e & 3] * hl[e & 3] : ch_[e & 3] * hh[e & 3]); const float bb = e < 4 ? bl[e & 3] : bh_[e & 3];
                    y[e] = bb * (w0[e] * um2[e] + w1[e] * um1[e] + w2[e] * u); um2[e] = um1[e]; um1[e] = u; ss += y[e] * y[e]; }
                ss += __shfl_xor(ss, 1); ss += __shfl_xor(ss, 2); ss += __shfl_xor(ss, 4);
                const float rn = __builtin_amdgcn_rsqf(ss * (1.f / 64.f) + RMS_EPS);
                f32x4 ol, oh;
#pragma unroll
                for (int e = 0; e < 4; ++e) { ol[e] = y[e] * rn * gn[e]; oh[e] = y[4 + e] * rn * gn[4 + e]; }
                *(u32x4*)(YMIX + (size_t)(tok0 + i0 + i) * DM + c0) = pack8(ol, oh);
            }
        }
    }
}
constexpr int XA_KROW = 528, XA_VROW = 528;
__device__ __forceinline__ void phase_xattn_fast(const Params& p, LAS unsigned char* lds) {
    unsigned char* ws = p.ws; const int tid = threadIdx.x, lane = tid & 63, wave = __builtin_amdgcn_readfirstlane(tid >> 6), r32 = lane & 31, hi = lane >> 5;
    const bf16_t* QM = (const bf16_t*)(ws + WS_QM); const bf16_t* MK = (const bf16_t*)(ws + WS_MEMK); const bf16_t* MVT = (const bf16_t*)(ws + WS_MEMVT); bf16_t* OB = (bf16_t*)(ws + WS_OB);
    const int G = gridDim.x, vcu = (G % 8 == 0) ? ((int)blockIdx.x % 8) * (G / 8) + (int)blockIdx.x / 8 : (int)blockIdx.x;
#define XA_BAR() do { asm volatile("s_waitcnt lgkmcnt(0)" ::: "memory"); __builtin_amdgcn_s_barrier(); asm volatile("" ::: "memory"); } while (0)
#define XA_LOADK(Kg_) do { _Pragma("unroll") for (int i = 0; i < 16; ++i) { const int c = tid + 512 * i; st[i] = *(const u32x4*)((Kg_) + (size_t)(c >> 5) * DM + 8 * (c & 31)); } } while (0)
#define XA_WRITEK() do { _Pragma("unroll") for (int i = 0; i < 16; ++i) { const int c = tid + 512 * i; *(LAS u32x4*)(lds + (c >> 5) * XA_KROW + 16 * (c & 31)) = st[i]; } } while (0)
#define XA_LOADV(Vg_) do { _Pragma("unroll") for (int i = 0; i < 16; ++i) { const int c = tid + 512 * i; st[i] = *(const u32x4*)((Vg_) + (size_t)(c >> 5) * MVT_LD + 8 * (c & 31)); } } while (0)
#define XA_WRITEV() do { _Pragma("unroll") for (int i = 0; i < 16; ++i) { const int c = tid + 512 * i, pc = c & 31; LAS unsigned char* d_ = lds + (c >> 5) * XA_VROW + 32 * (pc >> 1) + 8 * (pc & 1); \
            *(LAS u32x2*)d_ = (u32x2){st[i].x, st[i].y}; *(LAS u32x2*)(d_ + 16) = (u32x2){st[i].z, st[i].w}; } } while (0)
    u32x4 st[16];
    for (int U = vcu; U < NB * MH * 8; U += G) {
        const int bm = U >> 3, qblk = U & 7, b = bm >> 2, mh = bm & 3, q0 = qblk * 256 + wave * 32;
        const bf16_t* Vg = MVT + (size_t)(mh * MHD) * MVT_LD + b * MEML;
        const bf16_t* qp = QM + (size_t)(b * SEQ + q0 + r32) * DM + mh * MHD + 8 * hi;
        XA_LOADK(MK + (size_t)(b * MEML) * DM + mh * MHD);
        XA_WRITEK();
        __builtin_amdgcn_sched_barrier(0);
        bf16x8 qa[2], qb[2], qc[2];
#pragma unroll
        for (int sk = 0; sk < 2; ++sk) { qa[sk] = *(const bf16x8*)(qp + 16 * sk); qb[sk] = *(const bf16x8*)(qp + 32 + 16 * sk); qc[sk] = *(const bf16x8*)(qp + 64 + 16 * sk); }
        XA_BAR();
        f32x16 s[8];
#pragma unroll
        for (int kt = 0; kt < 8; ++kt)
#pragma unroll
            for (int r = 0; r < 16; ++r) s[kt][r] = 0.f;
#pragma unroll 1
        for (int sig = 0; sig < 8; ++sig) {
            bf16x8 qd[2];
#pragma unroll
            for (int sk = 0; sk < 2; ++sk) qd[sk] = (sig < 5) ? *(const bf16x8*)(qp + 32 * (sig + 3) + 16 * sk) : qc[sk];
            const LAS unsigned char* kb_ = lds + r32 * XA_KROW + 64 * sig + 16 * hi;
#pragma unroll
            for (int kt = 0; kt < 8; ++kt)
#pragma unroll
                for (int sk = 0; sk < 2; ++sk) { const bf16x8 kf = *(const LAS bf16x8*)(kb_ + kt * 32 * XA_KROW + 32 * sk); s[kt] = MFMA32(kf, qa[sk], s[kt]); }
#pragma unroll
            for (int sk = 0; sk < 2; ++sk) { qa[sk] = qb[sk]; qb[sk] = qc[sk]; qc[sk] = qd[sk]; }
        }
        float mx = s[0][0];
#pragma unroll
        for (int kt = 0; kt < 8; ++kt)
#pragma unroll
            for (int r = 0; r < 16; ++r) mx = fmaxf(mx, s[kt][r]);
        mx = fmaxf(mx, __shfl_xor(mx, 32));
        float sum = 0.f;
#pragma unroll
        for (int kt = 0; kt < 8; ++kt)
#pragma unroll
            for (int r = 0; r < 16; ++r) { s[kt][r] = __builtin_amdgcn_exp2f(s[kt][r] - mx); sum += s[kt][r]; }
        sum += __shfl_xor(sum, 32);
        const float inv = __builtin_amdgcn_rcpf(sum);
        u32x4 pw[16];
#pragma unroll
        for (int ks = 0; ks < 16; ++ks) { const int kt = ks >> 1, r0_ = 8 * (ks & 1);
            pw[ks].x = mm::cvt_pk_bf16(s[kt][r0_ + 0], s[kt][r0_ + 1]); pw[ks].y = mm::cvt_pk_bf16(s[kt][r0_ + 2], s[kt][r0_ + 3]);
            pw[ks].z = mm::cvt_pk_bf16(s[kt][r0_ + 4], s[kt][r0_ + 5]); pw[ks].w = mm::cvt_pk_bf16(s[kt][r0_ + 6], s[kt][r0_ + 7]); }
        __builtin_amdgcn_sched_barrier(0);
        XA_LOADV(Vg);
        XA_BAR();
        XA_WRITEV();
        XA_BAR();
        bf16_t* op = OB + (size_t)(b * SEQ + q0 + r32) * DM + mh * MHD + 4 * hi;
#pragma unroll 1
        for (int dt = 0; dt < 8; ++dt) {
            f32x16 o;
#pragma unroll
            for (int r = 0; r < 16; ++r) o[r] = 0.f;
            const LAS unsigned char* vb_ = lds + (32 * dt + r32) * XA_VROW + 16 * hi;
#pragma unroll
            for (int ks = 0; ks < 16; ++ks) { const bf16x8 vf = *(const LAS bf16x8*)(vb_ + 32 * ks);
                o = MFMA32(vf, __builtin_bit_cast(bf16x8, pw[ks]), o); }
#pragma unroll
            for (int g = 0; g < 4; ++g) { u32x2 w; w.x = mm::cvt_pk_bf16(o[4 * g] * inv, o[4 * g + 1] * inv); w.y = mm::cvt_pk_bf16(o[4 * g + 2] * inv, o[4 * g + 3] * inv);
                *(u32x2*)(op + 32 * dt + 8 * g) = w; }
        }
        XA_BAR();
    }
#undef XA_BAR
#undef XA_LOADK
#undef XA_WRITEK
#undef XA_LOADV
#undef XA_WRITEV
}

constexpr size_t WS_BAR = 2 * MiB + 65536;
#define XB_TMO      128
#define XB_XCNT(j)  (256  + 64 * (j))
#define XB_XSUB(j)  (1280 + 64 * (j))
#define XB_XGEN(j)  (2304 + 64 * (j))
#define XB_TOP      3328
#define XB_TOPGEN   3392
#define XCD_BAR_WORDS 3456
#define XB_SPIN_CAP (1u << 22)
__device__ __forceinline__ unsigned xb_ld(unsigned* q)              { return __hip_atomic_load(q, __ATOMIC_RELAXED, __HIP_MEMORY_SCOPE_AGENT); }
__device__ __forceinline__ unsigned xb_add(unsigned* q, unsigned v) { return __hip_atomic_fetch_add(q, v, __ATOMIC_RELAXED, __HIP_MEMORY_SCOPE_AGENT); }
__device__ __forceinline__ unsigned xb_xcc_id() { return (unsigned)__builtin_amdgcn_s_getreg((3 << 11) | 20) & 0xFu; }
#define XB_SPIN(cond, bar) do { unsigned _sp = 0; while (cond) { __builtin_amdgcn_s_sleep(1); \
    if ((++_sp & 255u) == 0u) { if (xb_ld(&(bar)[XB_TMO])) break; if (_sp > XB_SPIN_CAP) { atomicAdd(&(bar)[XB_TMO], 1u); break; } } } } while (0)
struct XcdBarrier { unsigned* bar; unsigned x; unsigned nloc, nx; };
__device__ __forceinline__ XcdBarrier xcd_barrier_post(unsigned* bar) {
    XcdBarrier b; b.bar = bar; b.x = xb_xcc_id(); b.nloc = 0u; b.nx = 0u;
    if (threadIdx.x == 0) (void)xb_add(&bar[XB_XCNT(b.x)], 1u);
    return b;
}
__device__ __forceinline__ void xcd_barrier_complete(unsigned* bar, unsigned x, unsigned& nloc, unsigned& nx) {
    const unsigned G = gridDim.x * gridDim.y * gridDim.z;
    unsigned sum, cnt, mine, sp = 0u;
    for (;;) {
        sum = 0u; cnt = 0u; mine = 0u;
#pragma unroll
        for (unsigned j = 0; j < 16; ++j) { const unsigned c = xb_ld(&bar[XB_XCNT(j)]); sum += c; cnt += (c > 0u) ? 1u : 0u; mine = (j == x) ? c : mine; }
        if (sum == G) break;
        __builtin_amdgcn_s_sleep(1);
        if ((++sp & 255u) == 0u) { if (xb_ld(&bar[XB_TMO])) break; if (sp > XB_SPIN_CAP) { atomicAdd(&bar[XB_TMO], 1u); break; } }
    }
    nloc = mine > 0u ? mine : 1u; nx = cnt > 0u ? cnt : 1u;
}
__device__ __forceinline__ void xcd_barrier(XcdBarrier& b) {
    asm volatile("s_waitcnt vmcnt(0)" ::: "memory");
    __syncthreads();
    if (threadIdx.x == 0) {
        unsigned* bar = b.bar;
        __builtin_amdgcn_s_waitcnt(0);
        unsigned nloc = b.nloc, nx = b.nx;
        if (nloc == 0u) { xcd_barrier_complete(bar, b.x, nloc, nx); b.nloc = nloc; b.nx = nx; }
        const unsigned old = xb_add(&bar[XB_XSUB(b.x)], 1u);
        const unsigned gen = old / nloc;
        if (old + 1u == (gen + 1u) * nloc) {
            __builtin_amdgcn_fence(__ATOMIC_RELEASE, "agent");
            asm volatile("s_waitcnt vmcnt(0)" ::: "memory");
            const unsigned og = xb_add(&bar[XB_TOP], 1u);
            const unsigned tg = og / nx;
            if (og + 1u == (tg + 1u) * nx) xb_add(&bar[XB_TOPGEN], 1u);
            else XB_SPIN(xb_ld(&bar[XB_TOPGEN]) == tg, bar);
            __builtin_amdgcn_fence(__ATOMIC_ACQUIRE, "agent");
            xb_add(&bar[XB_XGEN(b.x)], 1u);
            asm volatile("s_waitcnt vmcnt(0)" ::: "memory");
        } else {
            XB_SPIN(xb_ld(&bar[XB_XGEN(b.x)]) == gen, bar);
            __builtin_amdgcn_fence(__ATOMIC_ACQUIRE, "agent");
            asm volatile("s_waitcnt vmcnt(0)" ::: "memory");
        }
    }
    __syncthreads();
}

__global__ void __launch_bounds__(512, 2) fwd_kernel(Params p) {
    extern __shared__ __attribute__((aligned(16))) unsigned char lds[];
    cg::grid_group grid = cg::this_grid();
#ifndef ONLY
#define ONLY -1
#endif
#ifdef PMASK
#define RUNP(k) ((PMASK >> (k)) & 1)
#else
#define RUNP(k) (ONLY < 0 || ONLY == (k))
#endif
    const int lo = p.ph_lo, hi = p.ph_hi;
    XcdBarrier xbar = xcd_barrier_post((unsigned*)(p.ws + WS_BAR));
    LAS unsigned char* l3 = (LAS unsigned char*)lds;
#ifndef FASTMASK
#define FASTMASK 0x6FE
#endif
#define FAST(k) ((FASTMASK >> (k)) & 1)
#ifndef XFOLD
#define XFOLD 1
#endif
#define IN(k) (RUNP(k) && lo <= (k) && (k) < hi)
#ifndef PROBE_PH
#define PROBE_PH -1
#endif
#define STAMP(k) do { if (PROBE_PH >= 0 && blockIdx.x == 0 && threadIdx.x == 0) ((volatile unsigned long long*)(p.ws + WS_CNT + 1024))[k] = __builtin_amdgcn_s_memrealtime(); } while (0)
#define SEAM(k) do { if (lo <= (k) && (k) + 1 < hi) xcd_barrier(xbar); STAMP((k) + 1); } while (0)
    STAMP(0);
    if (hi > 1000) grid.sync();
    if (IN(0)) { phase_prep(p, lds); }
    SEAM(0);
    if (IN(1)) { if (FAST(1)) phase_proj_fast(p, l3); else phase_proj_simple(p); } SEAM(1);
    if (IN(2)) { finalize_colsums(p); if (XFOLD) { __syncthreads(); phase_fold(p, l3); __syncthreads(); } if (FAST(2)) { phase_sb_fast(p, l3); } else { phase_conv_simple(p); phase_sb_simple(p); } } SEAM(2);
    if (IN(3)) { if (FAST(3)) phase_outproj_fast(p, l3); else phase_outproj_simple(p); } SEAM(3);
    if (IN(4)) { if (XFOLD) phase_scores_fast(p, l3); else if (FAST(4)) phase_mq_fast(p, l3); else phase_mq_simple(p); } SEAM(4);
    if (!XFOLD) { if (IN(5)) { if (FAST(5)) phase_xattn_fast(p, l3); else phase_xattn_simple(p, lds); } SEAM(5); } else STAMP(6);
    if (IN(6)) { if (XFOLD) phase_mo_fold(p, l3); else if (FAST(6)) phase_mo_fast(p, l3); else phase_mo_simple(p); } SEAM(6);
    if (IN(7)) { if (FAST(7)) phase_router_fast(p, l3); else phase_router_simple(p); } SEAM(7);
    if (IN(8)) { if (!(FAST(7) && gridDim.x == NTOK / 256)) phase_route(p, lds); }
    if (!(FAST(7) && gridDim.x == NTOK / 256)) SEAM(8); else STAMP(9);
    if (IN(9)) { if (FAST(9)) phase_moe1_fast(p, l3); else phase_moe1_simple(p); } SEAM(9);
    if (IN(10)) { if (FAST(10)) phase_moe2_fast(p, l3); else phase_moe2_simple(p); } SEAM(10);
    if (IN(11)) { phase_final(p); }
    if (PROBE_PH >= 0 && blockIdx.x == 0 && threadIdx.x == 0) {
        STAMP(12);
        volatile unsigned long long* ts = (volatile unsigned long long*)(p.ws + WS_CNT + 1024);
        const unsigned long long d = (ts[PROBE_PH + 1] - ts[PROBE_PH]) * 8ull, t0 = __builtin_amdgcn_s_memrealtime();
        while (__builtin_amdgcn_s_memrealtime() - t0 < d) __builtin_amdgcn_s_sleep(8);
    }
}

extern "C" void kernel_launch(void* const* d_in, const int* in_sizes, int n_in, void* d_out, int out_size, void* d_ws, size_t ws_size, hipStream_t stream) {
    static int grid = 0;
    if (grid == 0) {
        if (n_in != 24 || out_size != NTOK * DM || ws_size < WS_END) { fprintf(stderr, "kernel_launch: unexpected problem: n_in %d out %d ws %zu\n", n_in, out_size, ws_size); grid = -1; return; }
        int dev = 0, cus = 0, per_cu = 0;
        (void)hipGetDevice(&dev); (void)hipDeviceGetAttribute(&cus, hipDeviceAttributeMultiprocessorCount, dev);
        (void)hipFuncSetAttribute((const void*)fwd_kernel, hipFuncAttributeMaxDynamicSharedMemorySize, LDS_BYTES);
        (void)hipOccupancyMaxActiveBlocksPerMultiprocessor(&per_cu, (const void*)fwd_kernel, 512, LDS_BYTES);
        if (per_cu < 1) { fprintf(stderr, "kernel_launch: occupancy query reports %d blocks per CU\n", per_cu); }
        grid = cus;
    }
    if (grid < 0) return;
    if (hipMemsetAsync(d_ws, 0, WS_ZERO_BYTES, stream) != hipSuccess) { fprintf(stderr, "kernel_launch: hipMemsetAsync failed\n"); return; }
    Params p{};
    const float** f = (const float**)&p;
    for (int i = 0; i < 24; ++i) f[i] = (const float*)d_in[i];
    p.out = (float*)d_out; p.ws = (unsigned char*)d_ws;
#if MK_ONE_LAUNCH
    p.ph_lo = 0; p.ph_hi = NPHASE;
    void* args[] = {&p};
    hipError_t e = hipLaunchCooperativeKernel((void*)fwd_kernel, dim3(grid), dim3(512), args, LDS_BYTES, stream);
    if (e != hipSuccess) fprintf(stderr, "cooperative launch failed: %s\n", hipGetErrorString(e));
#else
    for (int ph = 0; ph < NPHASE; ++ph) {
        p.ph_lo = ph; p.ph_hi = ph + 1;
        void* args[] = {&p};
        hipError_t e = hipLaunchCooperativeKernel((void*)fwd_kernel, dim3(grid), dim3(512), args, LDS_BYTES, stream);
        if (e != hipSuccess) { fprintf(stderr, "launch %d failed: %s\n", ph, hipGetErrorString(e)); break; }
    }
#endif
}
```

```cpp
#include <hip/hip_runtime.h>
#include <hip/hip_cooperative_groups.h>
#include <cstdio>
#include <cstdint>
namespace cg = cooperative_groups;

#ifndef MK_ONE_LAUNCH
#define MK_ONE_LAUNCH 1
#endif

typedef unsigned short bf16_t;
typedef short bf16x8 __attribute__((ext_vector_type(8)));
typedef float f32x4 __attribute__((ext_vector_type(4)));
typedef float f32x16 __attribute__((ext_vector_type(16)));
typedef unsigned u32x4 __attribute__((ext_vector_type(4)));
typedef unsigned u32x2 __attribute__((ext_vector_type(2)));

constexpr int NB = 32, SEQ = 2048, DM = 1024, NTOK = NB * SEQ;
constexpr int MEML = 256, NMEM = NB * MEML;
constexpr int NPROJ = 2560;
constexpr int PW = 3072;
constexpr int C_CB = 0, C_CC = 512, C_CH = 1024, C_Q = 1536, C_K = 2048, C_V = 2560;
constexpr int NHEAD = 8, HD = 64;
constexpr int MH = 4, MHD = 256;
constexpr int NEXP = 32, DEXP = 512, NLOG = 36, NLOGP = 64;
constexpr int CAP = 2 * NTOK;
constexpr float ALPHA = 1.189207115002721f;
constexpr float LN_EPS = 1e-5f, RMS_EPS = 1e-6f;
constexpr float LOG2E = 1.4426950408889634f;
constexpr float QS_SB = 0.125f * LOG2E;
constexpr float QS_X = 0.0625f * LOG2E;
constexpr float W8S = 64.0f, H8S = 16.0f, P8S = 256.0f, Y8S = 64.0f;

constexpr size_t MiB = 1u << 20;
constexpr size_t WS_STATS1 = 0;
constexpr size_t WS_STATS2 = 1 * MiB;
constexpr size_t WS_CNT = 2 * MiB;
constexpr size_t WS_CS1 = 2 * MiB + 4096;
constexpr size_t WS_CS2 = WS_CS1 + 8192;
constexpr size_t WS_CSGU = 3 * MiB;
constexpr size_t WS_EID = 4 * MiB;
constexpr size_t WS_GATE = 5 * MiB;
constexpr size_t WS_CSI = 6 * MiB;
constexpr size_t WS_CSB = 7 * MiB;
constexpr size_t WS_BSB = 7 * MiB + 512 * 1024;
constexpr size_t WS_ZERO_BYTES = 8 * MiB;
constexpr size_t WS_LOGIT = 8 * MiB;
constexpr size_t WS_ROWL = 24 * MiB;
constexpr size_t WS_WRT = 40 * MiB;
constexpr size_t WS_WIN = 64 * MiB;
constexpr size_t WS_WOUT = 70 * MiB;
constexpr size_t WS_WMQ = 72 * MiB, WS_WMK = 74 * MiB, WS_WMV = 76 * MiB, WS_WMO = 78 * MiB;
constexpr size_t WS_WGU = 80 * MiB;
constexpr size_t WS_WD = 144 * MiB;
constexpr size_t WS_XB = 192 * MiB;
constexpr size_t WS_T1B = 192 * MiB;
constexpr size_t WS_MEMB = 320 * MiB;
constexpr size_t WS_MEMK = 336 * MiB;
constexpr size_t WS_MEMVT = 352 * MiB;
constexpr size_t WS_PROJ = 370 * MiB;
constexpr size_t WS_QM = 370 * MiB;
constexpr size_t WS_WQK = 883 * MiB;
constexpr size_t WS_VWT = 947 * MiB;
constexpr size_t WS_WQP = 42 * MiB;
constexpr size_t WS_MEMV = 352 * MiB;
constexpr size_t WS_OB = 498 * MiB;
constexpr size_t WS_Y = 370 * MiB;
constexpr size_t WS_VT = 690 * MiB;
constexpr size_t WS_YMIX = 755 * MiB;
constexpr size_t WS_T2B = 755 * MiB;
constexpr size_t WS_H = 883 * MiB;
constexpr size_t WS_T2F8 = 626 * MiB;
constexpr size_t WS_T1F8 = 690 * MiB;
constexpr size_t WS_END = 1019 * MiB;
constexpr int VT_LD = NTOK + 64, MVT_LD = NMEM + 64;

constexpr int LDS_BYTES = 147456 + 64;
constexpr int NPHASE = 12;

struct Params {
    const float *x, *mem, *w_in, *conv_w, *gn_conv, *gn_sb, *w_out, *ln1_g, *ln1_b, *w_mq, *w_mk, *w_mv, *w_mo, *ln2_g, *ln2_b,
        *w_rg, *b_rg, *w_re, *b_re, *w_gate, *w_up, *w_down, *ln3_g, *ln3_b;
    float* out; unsigned char* ws; int ph_lo, ph_hi;
};

#define LAS __attribute__((address_space(3)))
__device__ __forceinline__ float bf2f(bf16_t v) { return __uint_as_float((unsigned)v << 16); }
__device__ __forceinline__ bf16_t f2bf(float f) { unsigned u = __float_as_uint(f); return (bf16_t)((u + 0x7fffu + ((u >> 16) & 1u)) >> 16); }
__device__ __forceinline__ unsigned pk2(float lo, float hi) { return (unsigned)f2bf(lo) | ((unsigned)f2bf(hi) << 16); }
__device__ __forceinline__ u32x2 pack8_fp8(const f32x4 a, const f32x4 b) { u32x2 w; int t = __builtin_amdgcn_cvt_pk_fp8_f32(a[0], a[1], 0, false); t = __builtin_amdgcn_cvt_pk_fp8_f32(a[2], a[3], t, true); w.x = (unsigned)t;
    t = __builtin_amdgcn_cvt_pk_fp8_f32(b[0], b[1], 0, false); t = __builtin_amdgcn_cvt_pk_fp8_f32(b[2], b[3], t, true); w.y = (unsigned)t; return w; }
__device__ __forceinline__ f32x4 unpack_fp8(unsigned w) { return (f32x4){__builtin_amdgcn_cvt_f32_fp8((int)w, 0), __builtin_amdgcn_cvt_f32_fp8((int)w, 1), __builtin_amdgcn_cvt_f32_fp8((int)w, 2), __builtin_amdgcn_cvt_f32_fp8((int)w, 3)}; }
__device__ __forceinline__ float fp8_round(float v) { return __builtin_amdgcn_cvt_f32_fp8(__builtin_amdgcn_cvt_pk_fp8_f32(v, 0.f, 0, false), 0); }
__device__ __forceinline__ float wave_sum(float v) {
#pragma unroll
    for (int o = 1; o < 64; o <<= 1) v += __shfl_xor(v, o);
    return v;
}
__device__ __forceinline__ float wave_max(float v) {
#pragma unroll
    for (int o = 1; o < 64; o <<= 1) v = fmaxf(v, __shfl_xor(v, o));
    return v;
}
__device__ __forceinline__ f32x4 unpack_lo(const u32x4 w) { return (f32x4){__uint_as_float(w.x << 16), __uint_as_float(w.x & 0xffff0000u), __uint_as_float(w.y << 16), __uint_as_float(w.y & 0xffff0000u)}; }
__device__ __forceinline__ f32x4 unpack_hi(const u32x4 w) { return (f32x4){__uint_as_float(w.z << 16), __uint_as_float(w.z & 0xffff0000u), __uint_as_float(w.w << 16), __uint_as_float(w.w & 0xffff0000u)}; }
__device__ __forceinline__ float sum4(const f32x4 v) { return (v[0] + v[1]) + (v[2] + v[3]); }
__device__ __forceinline__ float sq4(const f32x4 v) { return (v[0] * v[0] + v[1] * v[1]) + (v[2] * v[2] + v[3] * v[3]); }
#define MFMA32(a, b, c) __builtin_amdgcn_mfma_f32_32x32x16_bf16((a), (b), (c), 0, 0, 0)

template <int NBLK, class AR, class BR>
__device__ __forceinline__ void wave_tile(int K, AR arow, BR brow, f32x16 (&c)[2][2 * NBLK]) {
    const int lane = threadIdx.x & 63, r = lane & 31, h = lane >> 5;
    const bf16_t* ap[2]; const bf16_t* bp[2 * NBLK];
#pragma unroll
    for (int i = 0; i < 2; ++i) ap[i] = arow(32 * i + r) + 8 * h;
#pragma unroll
    for (int j = 0; j < 2 * NBLK; ++j) bp[j] = brow(32 * j + r) + 8 * h;
#pragma unroll
    for (int i = 0; i < 2; ++i)
#pragma unroll
        for (int j = 0; j < 2 * NBLK; ++j)
#pragma unroll
            for (int q = 0; q < 16; ++q) c[i][j][q] = 0.f;
#pragma unroll 2
    for (int k = 0; k < K; k += 16) {
        bf16x8 fa[2], fb[2 * NBLK];
#pragma unroll
        for (int i = 0; i < 2; ++i) fa[i] = *(const bf16x8*)(ap[i] + k);
#pragma unroll
        for (int j = 0; j < 2 * NBLK; ++j) fb[j] = *(const bf16x8*)(bp[j] + k);
#pragma unroll
        for (int i = 0; i < 2; ++i)
#pragma unroll
            for (int j = 0; j < 2 * NBLK; ++j) c[i][j] = MFMA32(fa[i], fb[j], c[i][j]);
    }
}
#define TROW(i, q) (32 * (i) + ((q) & 3) + 8 * ((q) >> 2) + 4 * ((int)(threadIdx.x & 63) >> 5))
#define TCOL(j) (32 * (j) + (int)(threadIdx.x & 31))

struct RowStat { float mean, rstd; };
typedef long long stat_t;
constexpr float STAT_SCALE = 16777216.0f, STAT_INV = 1.0f / 16777216.0f;
__device__ __forceinline__ void stat_add(stat_t* st, int row, float s, float q) {
    atomicAdd((unsigned long long*)st + 2 * row, (unsigned long long)__float2ll_rn(s * STAT_SCALE)); atomicAdd((unsigned long long*)st + 2 * row + 1, (unsigned long long)__float2ll_rn(q * STAT_SCALE)); }
__device__ __forceinline__ RowStat row_stat(const stat_t* st, int row) {
    const float s = (float)st[2 * row] * STAT_INV, q = (float)st[2 * row + 1] * STAT_INV;
    RowStat r; r.mean = s * (1.f / DM); const float var = fmaxf(q * (1.f / DM) - r.mean * r.mean, 0.f); r.rstd = __builtin_amdgcn_rsqf(var + LN_EPS); return r;
}

constexpr float CS_SCALE = 4294967296.0f, CS_INV = 1.0f / 4294967296.0f;
constexpr float CS_SCALE8 = 16777216.0f, CS_INV8 = 1.0f / 16777216.0f;
__device__ __forceinline__ void transpose_item(const float* W, int K, int N, int k0, int n0, bf16_t* WT, int orow0, const float* ks, float ns, const float* bvec, stat_t* csum, stat_t* bsum, int oidx0,
                                               LAS float* scr, int lane) {
    const int rq = lane >> 4, c4 = (lane & 15) * 4;
    f32x4 cs = {0.f, 0.f, 0.f, 0.f}, bs = {0.f, 0.f, 0.f, 0.f};
    f32x4 wv[16];
#pragma unroll
    for (int i = 0; i < 16; ++i) wv[i] = __builtin_nontemporal_load((const f32x4*)(W + (size_t)(k0 + 4 * i + rq) * N + n0 + c4));
#pragma unroll
    for (int i = 0; i < 16; ++i) { const int kk = 4 * i + rq; f32x4 v = wv[i];
        if (csum) { const float bk = bvec[k0 + kk] * ns; bs += v * bk; }
        if (ks) v = v * ks[k0 + kk];
        v = v * ns;
        if (csum) { cs[0] += bf2f(f2bf(v[0])); cs[1] += bf2f(f2bf(v[1])); cs[2] += bf2f(f2bf(v[2])); cs[3] += bf2f(f2bf(v[3])); }
        LAS float* d = scr + kk * 65 + c4; d[0] = v[0]; d[1] = v[1]; d[2] = v[2]; d[3] = v[3]; }
    if (csum) {
#pragma unroll
        for (int e = 0; e < 4; ++e) { cs[e] += __shfl_xor(cs[e], 16); cs[e] += __shfl_xor(cs[e], 32); bs[e] += __shfl_xor(bs[e], 16); bs[e] += __shfl_xor(bs[e], 32); }
        if (rq == 0) {
#pragma unroll
            for (int e = 0; e < 4; ++e) { atomicAdd((unsigned long long*)csum + oidx0 + c4 + e, (unsigned long long)__float2ll_rn(cs[e] * CS_SCALE)); atomicAdd((unsigned long long*)bsum + oidx0 + c4 + e, (unsigned long long)__float2ll_rn(bs[e] * CS_SCALE)); } }
    }
    asm volatile("s_waitcnt lgkmcnt(0)" ::: "memory");
    const int c = lane & 7;
#pragma unroll
    for (int j = 0; j < 8; ++j) { const int n = (lane >> 3) + 8 * j; const LAS float* sp = scr + (8 * c) * 65 + n;
        u32x4 o; o.x = pk2(sp[0 * 65], sp[1 * 65]); o.y = pk2(sp[2 * 65], sp[3 * 65]); o.z = pk2(sp[4 * 65], sp[5 * 65]); o.w = pk2(sp[6 * 65], sp[7 * 65]);
        *(u32x4*)(WT + (size_t)(orow0 + n) * K + k0 + 8 * c) = o; }
    asm volatile("s_waitcnt lgkmcnt(0)" ::: "memory");
}
__device__ __forceinline__ void tile_load(const float* W, int N, int k0, int n0, int lane, f32x4 (&wv)[16]) {
    const int rq = lane >> 4, c4 = (lane & 15) * 4;
#pragma unroll
    for (int i = 0; i < 16; ++i) wv[i] = __builtin_nontemporal_load((const f32x4*)(W + (size_t)(k0 + 4 * i + rq) * N + n0 + c4));
}
__device__ __forceinline__ void transpose_item8_pre(const f32x4 (&wv)[16], int K, int k0, unsigned char* WT8, int orow0, const float* ks, float ns, const float* bvec, float bscale, stat_t* csum, stat_t* bsum, int oidx0, LAS float* scr, int lane);
__device__ __forceinline__ void transpose_item8(const float* W, int K, int N, int k0, int n0, unsigned char* WT8, int orow0, const float* ks, float ns, const float* bvec, float bscale, stat_t* csum, stat_t* bsum, int oidx0,
                                                LAS float* scr, int lane) {
    f32x4 wv[16]; tile_load(W, N, k0, n0, lane, wv);
    transpose_item8_pre(wv, K, k0, WT8, orow0, ks, ns, bvec, bscale, csum, bsum, oidx0, scr, lane);
}
__device__ __forceinline__ void transpose_item8_pre(const f32x4 (&wv)[16], int K, int k0, unsigned char* WT8, int orow0, const float* ks, float ns, const float* bvec, float bscale, stat_t* csum, stat_t* bsum, int oidx0, LAS float* scr, int lane) {
    asm volatile("" : "+v"(lane));
    const int rq = lane >> 4, c4 = (lane & 15) * 4;
    f32x4 cs = {0.f, 0.f, 0.f, 0.f}, bs = {0.f, 0.f, 0.f, 0.f};
    const float ksv = ks ? ks[k0 + lane] : 1.f, bvv = csum ? bvec[k0 + lane] * bscale : 0.f;
#pragma unroll
    for (int i = 0; i < 16; ++i) { const int kk = 4 * i + rq; f32x4 v = wv[i];
        if (csum) { const float bk = __shfl(bvv, kk); bs += v * bk; }
        if (ks) v = v * __shfl(ksv, kk);
        v = v * ns;
        if (csum) { cs[0] += fp8_round(v[0]); cs[1] += fp8_round(v[1]); cs[2] += fp8_round(v[2]); cs[3] += fp8_round(v[3]); }
        LAS float* d = scr + kk * 65 + c4; d[0] = v[0]; d[1] = v[1]; d[2] = v[2]; d[3] = v[3]; }
    if (csum) {
#pragma unroll
        for (int e = 0; e < 4; ++e) { cs[e] += __shfl_xor(cs[e], 16); cs[e] += __shfl_xor(cs[e], 32); bs[e] += __shfl_xor(bs[e], 16); bs[e] += __shfl_xor(bs[e], 32); }
        if (rq == 0) {
#pragma unroll
            for (int e = 0; e < 4; ++e) { atomicAdd((unsigned long long*)csum + oidx0 + c4 + e, (unsigned long long)__float2ll_rn(cs[e] * CS_SCALE8)); atomicAdd((unsigned long long*)bsum + oidx0 + c4 + e, (unsigned long long)__float2ll_rn(bs[e] * CS_SCALE)); } }
    }
    asm volatile("s_waitcnt lgkmcnt(0)" ::: "memory");
    const int c = lane & 3;
#pragma unroll
    for (int j = 0; j < 4; ++j) { const int n = (lane >> 2) + 16 * j; const LAS float* sp = scr + (16 * c) * 65 + n;
        const u32x2 lo = pack8_fp8((f32x4){sp[0 * 65], sp[1 * 65], sp[2 * 65], sp[3 * 65]}, (f32x4){sp[4 * 65], sp[5 * 65], sp[6 * 65], sp[7 * 65]});
        const u32x2 hi = pack8_fp8((f32x4){sp[8 * 65], sp[9 * 65], sp[10 * 65], sp[11 * 65]}, (f32x4){sp[12 * 65], sp[13 * 65], sp[14 * 65], sp[15 * 65]});
        __builtin_nontemporal_store((u32x4){lo.x, lo.y, hi.x, hi.y}, (u32x4*)(WT8 + (size_t)(orow0 + n) * K + k0 + 16 * c)); }
    asm volatile("s_waitcnt lgkmcnt(0)" ::: "memory");
}
__device__ __forceinline__ void tile_load128(const float* W, int N, int k0, int n0, int lane, f32x4 (&wv)[16]) {
    const int rq = lane >> 3, c4 = (lane & 7) * 4;
#pragma unroll
    for (int i = 0; i < 16; ++i) wv[i] = __builtin_nontemporal_load((const f32x4*)(W + (size_t)(k0 + 8 * i + rq) * N + n0 + c4));
}
__device__ __forceinline__ void transpose_tile8_128(const f32x4 (&wv)[16], int K, int k0, unsigned char* WT8, int orow0, const float* ks, float ns, const float* bvec, float bscale, stat_t* csum, stat_t* bsum, int oidx0, LAS float* scr, int lane) {
    asm volatile("" : "+v"(lane));
    const int rq = lane >> 3, c4 = (lane & 7) * 4;
    f32x4 cs = {0.f, 0.f, 0.f, 0.f}, bs = {0.f, 0.f, 0.f, 0.f};
    const float ks0 = ks ? ks[k0 + lane] : 1.f, ks1 = ks ? ks[k0 + 64 + lane] : 1.f, bv0 = csum ? bvec[k0 + lane] * bscale : 0.f, bv1 = csum ? bvec[k0 + 64 + lane] * bscale : 0.f;
#pragma unroll
    for (int i = 0; i < 16; ++i) { const int kk = 8 * i + rq; f32x4 v = wv[i];
        if (csum) { const float bk = __shfl(i < 8 ? bv0 : bv1, kk & 63); bs += v * bk; }
        if (ks) v = v * __shfl(i < 8 ? ks0 : ks1, kk & 63);
        v = v * ns;
        if (csum) { cs[0] += fp8_round(v[0]); cs[1] += fp8_round(v[1]); cs[2] += fp8_round(v[2]); cs[3] += fp8_round(v[3]); }
        LAS float* d = scr + kk * 33 + c4; d[0] = v[0]; d[1] = v[1]; d[2] = v[2]; d[3] = v[3]; }
    if (csum) {
#pragma unroll
        for (int e = 0; e < 4; ++e) { cs[e] += __shfl_xor(cs[e], 8); cs[e] += __shfl_xor(cs[e], 16); cs[e] += __shfl_xor(cs[e], 32); bs[e] += __shfl_xor(bs[e], 8); bs[e] += __shfl_xor(bs[e], 16); bs[e] += __shfl_xor(bs[e], 32); }
        if (rq == 0) {
#pragma unroll
            for (int e = 0; e < 4; ++e) { atomicAdd((unsigned long long*)csum + oidx0 + c4 + e, (unsigned long long)__float2ll_rn(cs[e] * CS_SCALE8)); atomicAdd((unsigned long long*)bsum + oidx0 + c4 + e, (unsigned long long)__float2ll_rn(bs[e] * CS_SCALE)); } }
    }
    asm volatile("s_waitcnt lgkmcnt(0)" ::: "memory");
    const int c = lane & 7;
#pragma unroll
    for (int j = 0; j < 4; ++j) { const int n = (lane >> 3) + 8 * j; const LAS float* sp = scr + (16 * c) * 33 + n;
        const u32x2 lo = pack8_fp8((f32x4){sp[0 * 33], sp[1 * 33], sp[2 * 33], sp[3 * 33]}, (f32x4){sp[4 * 33], sp[5 * 33], sp[6 * 33], sp[7 * 33]});
        const u32x2 hi = pack8_fp8((f32x4){sp[8 * 33], sp[9 * 33], sp[10 * 33], sp[11 * 33]}, (f32x4){sp[12 * 33], sp[13 * 33], sp[14 * 33], sp[15 * 33]});
        __builtin_nontemporal_store((u32x4){lo.x, lo.y, hi.x, hi.y}, (u32x4*)(WT8 + (size_t)(orow0 + n) * K + k0 + 16 * c)); }
    asm volatile("s_waitcnt lgkmcnt(0)" ::: "memory");
}
__device__ void phase_prep(const Params& p, unsigned char* lds) {
    unsigned char* ws = p.ws;
    const int tid = threadIdx.x, lane = tid & 63, wave = tid >> 6;
    const int gw = blockIdx.x * 8 + wave, NGW = gridDim.x * 8;
    const int gt = blockIdx.x * 512 + tid, NGT = gridDim.x * 512;
    LAS float* scr = (LAS float*)((LAS unsigned char*)lds + wave * 16896);
    bf16_t* WIN = (bf16_t*)(ws + WS_WIN); bf16_t* WOUT = (bf16_t*)(ws + WS_WOUT); bf16_t* WMQ = (bf16_t*)(ws + WS_WMQ); bf16_t* WMK = (bf16_t*)(ws + WS_WMK);
    bf16_t* WMV = (bf16_t*)(ws + WS_WMV); bf16_t* WMO = (bf16_t*)(ws + WS_WMO); bf16_t* WGU = (bf16_t*)(ws + WS_WGU); bf16_t* WD = (bf16_t*)(ws + WS_WD);
    stat_t* ci = (stat_t*)(ws + WS_CSI);
    { const f32x4* x4 = (const f32x4*)p.x; u32x4* xb4 = (u32x4*)(ws + WS_XB);
      constexpr int NX = NTOK * DM / 8;
      auto xld = [&](int i, f32x4 (&v)[8]) {
#pragma unroll
          for (int u = 0; u < 4; ++u) { const int j = i + u * NGT; if (j < NX) { v[2 * u] = __builtin_nontemporal_load(x4 + 2 * j); v[2 * u + 1] = __builtin_nontemporal_load(x4 + 2 * j + 1); } } };
      auto xst = [&](int i, const f32x4 (&v)[8]) {
#pragma unroll
          for (int u = 0; u < 4; ++u) { const int j = i + u * NGT; if (j < NX) { u32x4 o; o.x = pk2(v[2 * u].x, v[2 * u].y); o.y = pk2(v[2 * u].z, v[2 * u].w); o.z = pk2(v[2 * u + 1].x, v[2 * u + 1].y); o.w = pk2(v[2 * u + 1].z, v[2 * u + 1].w); xb4[j] = o; } } };
      { f32x4 va[8], vb[8]; const int step = 4 * NGT;
        if (gt < NX) xld(gt, va);
        for (int i = gt; i < NX; i += 2 * step) {
            if (i + step < NX) xld(i + step, vb);
            xst(i, va);
            if (i + step >= NX) break;
            if (i + 2 * step < NX) xld(i + 2 * step, va);
            xst(i + step, vb); } }
      const f32x4* m4 = (const f32x4*)p.mem; u32x4* mb4 = (u32x4*)(ws + WS_MEMB);
      constexpr int NM = NMEM * DM / 8;
      for (int i = gt; i < NM; i += 4 * NGT) { f32x4 v[8];
#pragma unroll
          for (int u = 0; u < 4; ++u) { const int j = i + u * NGT; if (j < NM) { v[2 * u] = __builtin_nontemporal_load(m4 + 2 * j); v[2 * u + 1] = __builtin_nontemporal_load(m4 + 2 * j + 1); } }
#pragma unroll
          for (int u = 0; u < 4; ++u) { const int j = i + u * NGT; if (j < NM) { u32x4 o; o.x = pk2(v[2 * u].x, v[2 * u].y); o.y = pk2(v[2 * u].z, v[2 * u].w); o.z = pk2(v[2 * u + 1].x, v[2 * u + 1].y); o.w = pk2(v[2 * u + 1].z, v[2 * u + 1].w); mb4[j] = o; } } } }
    constexpr int I_IN = 16 * 48, I_SQ = 16 * 16, I_G = 32 * 16 * 8, I_D = 32 * 8 * 16;
    constexpr int NITEMS = I_IN + 5 * I_SQ + 2 * I_G + I_D;
    for (int it = gw; it < I_IN + 5 * I_SQ; it += NGW) {
        int r = it;
        if (r < I_IN) { const int kb = r / 48, n0 = (r % 48) * 64; transpose_item(p.w_in, DM, PW, kb * 64, n0, WIN, n0, nullptr, (n0 >= C_Q && n0 < C_K) ? QS_SB : 1.f, nullptr, nullptr, nullptr, 0, scr, lane); continue; } r -= I_IN;
        if (r < I_SQ) { transpose_item(p.w_out, DM, DM, (r / 16) * 64, (r % 16) * 64, WOUT, (r % 16) * 64, nullptr, 1.f, nullptr, nullptr, nullptr, 0, scr, lane); continue; } r -= I_SQ;
        if (r < I_SQ) { transpose_item(p.w_mq, DM, DM, (r / 16) * 64, (r % 16) * 64, WMQ, (r % 16) * 64, p.ln1_g, QS_X, p.ln1_b, ci, ci + 1024, (r % 16) * 64, scr, lane); continue; } r -= I_SQ;
        if (r < I_SQ) { transpose_item(p.w_mk, DM, DM, (r / 16) * 64, (r % 16) * 64, WMK, (r % 16) * 64, nullptr, 1.f, nullptr, nullptr, nullptr, 0, scr, lane); continue; } r -= I_SQ;
        if (r < I_SQ) { transpose_item(p.w_mv, DM, DM, (r / 16) * 64, (r % 16) * 64, WMV, (r % 16) * 64, nullptr, 1.f, nullptr, nullptr, nullptr, 0, scr, lane); continue; } r -= I_SQ;
        if (r < I_SQ) { transpose_item(p.w_mo, DM, DM, (r / 16) * 64, (r % 16) * 64, WMO, (r % 16) * 64, nullptr, 1.f, nullptr, nullptr, nullptr, 0, scr, lane); continue; } r -= I_SQ;
    }
    { constexpr int NMOE = 2 * I_G + I_D;
      auto src_of = [&](int r, const float*& W, int& N, int& k0, int& n0) {
          if (r < 2 * I_G) { const int up = r >= I_G; if (up) r -= I_G; const int e = r / 128, q = r % 128; W = (up ? p.w_up : p.w_gate) + (size_t)e * DM * DEXP; N = DEXP; k0 = (q / 16) * 128; n0 = (q % 16) * 32; }
          else { r -= 2 * I_G; const int e = r / 128, q = r % 128; W = p.w_down + (size_t)e * DEXP * DM; N = DM; k0 = (q / 32) * 128; n0 = (q % 32) * 32; } };
      auto process = [&](int r, const f32x4 (&wv)[16]) {
          if (r < 2 * I_G) { const int up = r >= I_G; if (up) r -= I_G; const int e = r / 128, q = r % 128, kb = q / 16, n0 = (q % 16) * 32;
              const int orow0 = 256 * (n0 / 128) + (up ? 128 : 0) + (n0 % 128);
              transpose_tile8_128(wv, DM, kb * 128, (unsigned char*)WGU + (size_t)e * 1024 * 1024, orow0, p.ln2_g, W8S, p.ln2_b, 1.f, ci + 2048, ci + 2048 + NEXP * 1024, e * 1024 + orow0, scr, lane); }
          else { r -= 2 * I_G; const int e = r / 128, q = r % 128, kb = q / 32, n0 = (q % 32) * 32; transpose_tile8_128(wv, DEXP, kb * 128, (unsigned char*)WD + (size_t)e * 1024 * 512, n0, nullptr, W8S, nullptr, 0.f, nullptr, nullptr, 0, scr, lane); } };
      f32x4 wa[16], wb[16]; const float* W; int N, k0, n0;
      int r = gw;
      if (r < NMOE) { src_of(r, W, N, k0, n0); tile_load128(W, N, k0, n0, lane, wa); }
      while (r < NMOE) {
          const int r1 = r + NGW, r2 = r + 2 * NGW;
          if (r1 < NMOE) { src_of(r1, W, N, k0, n0); tile_load128(W, N, k0, n0, lane, wb); }
          process(r, wa);
          if (r1 >= NMOE) break;
          if (r2 < NMOE) { src_of(r2, W, N, k0, n0); tile_load128(W, N, k0, n0, lane, wa); }
          process(r1, wb);
          r = r2; } }
    { bf16_t* WQP = (bf16_t*)(ws + WS_WQP); const f32x4* w4 = (const f32x4*)p.w_mq; u32x2* o2 = (u32x2*)WQP;
      for (int i = gt; i < DM * DM / 4; i += NGT) { const f32x4 v = w4[i] * (p.ln1_g[i / (DM / 4)] * QS_X); u32x2 o; o.x = pk2(v.x, v.y); o.y = pk2(v.z, v.w); o2[i] = o; } }
    { bf16_t* WRT = (bf16_t*)(ws + WS_WRT);
      for (int i = gt; i < 256 * DM; i += NGT) { const int n = i / DM, k = i % DM; float v = 0.f;
          if (n < 4) v = p.w_rg[k * 4 + n] * p.ln2_g[k]; else if (n < NLOG) v = p.w_re[k * 32 + (n - 4)] * p.ln2_g[k];
          WRT[i] = f2bf(v); }
      float* cs2 = (float*)(ws + WS_CS2); float* bs2 = cs2 + 64;
      for (int n = gw; n < 64; n += NGW) { float cs = 0.f, bs = 0.f;
          if (n < NLOG) { float wv[16];
#pragma unroll
              for (int i = 0; i < 16; ++i) { const int k = lane + 64 * i; wv[i] = n < 4 ? p.w_rg[k * 4 + n] : p.w_re[k * 32 + (n - 4)]; }
#pragma unroll
              for (int i = 0; i < 16; ++i) { const int k = lane + 64 * i; cs += bf2f(f2bf(wv[i] * p.ln2_g[k])); bs += p.ln2_b[k] * wv[i]; }
              cs = wave_sum(cs); bs = wave_sum(bs); bs += n < 4 ? p.b_rg[n] : p.b_re[n - 4]; }
          if (lane == 0) { cs2[n] = cs; bs2[n] = bs; } } }
}
__device__ __forceinline__ void finalize_colsums(const Params& p) {
    unsigned char* ws = p.ws; const int gt = blockIdx.x * 512 + threadIdx.x, NGT = gridDim.x * 512;
    const stat_t* ci = (const stat_t*)(ws + WS_CSI); float* cs1 = (float*)(ws + WS_CS1); float* csg = (float*)(ws + WS_CSGU);
    for (int i = gt; i < 2048 + 2 * NEXP * 1024; i += NGT) { const bool cs8 = i >= 2048 && i < 2048 + NEXP * 1024; const float v = (float)ci[i] * (cs8 ? CS_INV8 : CS_INV); if (i < 2048) cs1[i] = v; else csg[i - 2048] = v; }
}

__device__ void phase_proj_simple(const Params& p) {
    unsigned char* ws = p.ws; const int wave = threadIdx.x >> 6; const int gw = blockIdx.x * 8 + wave, NGW = gridDim.x * 8;
    const bf16_t* XB = (const bf16_t*)(ws + WS_XB); const bf16_t* WIN = (const bf16_t*)(ws + WS_WIN); const bf16_t* MB = (const bf16_t*)(ws + WS_MEMB);
    const bf16_t* WMK = (const bf16_t*)(ws + WS_WMK); const bf16_t* WMV = (const bf16_t*)(ws + WS_WMV);
    bf16_t* PROJ = (bf16_t*)(ws + WS_PROJ); bf16_t* VT = (bf16_t*)(ws + WS_VT); bf16_t* MK = (bf16_t*)(ws + WS_MEMK); bf16_t* MVT = (bf16_t*)(ws + WS_MEMVT);
    constexpr int TA = (NTOK / 64) * (NPROJ / 64), TB = (512 / 64) * (NTOK / 64), TC = (NMEM / 64) * (DM / 64), TD = (DM / 64) * (NMEM / 64);
    for (int t = gw; t < TA + TB + TC + TD; t += NGW) {
        const bf16_t *A, *Bt; bf16_t* O; int ldo, tm, tn, r = t;
        if (r < TA) { A = XB; Bt = WIN; O = PROJ; ldo = NPROJ; tm = r / (NPROJ / 64); tn = r % (NPROJ / 64); }
        else if ((r -= TA) < TB) { A = WIN + (size_t)C_V * DM; Bt = XB; O = VT; ldo = VT_LD; tm = r / (NTOK / 64); tn = r % (NTOK / 64); }
        else if ((r -= TB) < TC) { A = MB; Bt = WMK; O = MK; ldo = DM; tm = r / (DM / 64); tn = r % (DM / 64); }
        else { r -= TC; A = WMV; Bt = MB; O = MVT; ldo = MVT_LD; tm = r / (NMEM / 64); tn = r % (NMEM / 64); }
        f32x16 c[2][2];
        wave_tile<1>(DM, [&](int i) { return A + (size_t)(tm * 64 + i) * DM; }, [&](int j) { return Bt + (size_t)(tn * 64 + j) * DM; }, c);
#pragma unroll
        for (int i = 0; i < 2; ++i)
#pragma unroll
            for (int j = 0; j < 2; ++j)
#pragma unroll
                for (int q = 0; q < 16; ++q) O[(size_t)(tm * 64 + TROW(i, q)) * ldo + tn * 64 + TCOL(j)] = f2bf(c[i][j][q]);
    }
}

__device__ void phase_conv_simple(const Params& p) {
    unsigned char* ws = p.ws; const int lane = threadIdx.x & 63, wave = threadIdx.x >> 6; const int gw = blockIdx.x * 8 + wave, NGW = gridDim.x * 8;
    const bf16_t* PROJ = (const bf16_t*)(ws + WS_PROJ); bf16_t* YMIX = (bf16_t*)(ws + WS_YMIX);
    for (int it = gw; it < NTOK * 8; it += NGW) {
        const int tok = it >> 3, g = it & 7, c = g * 64 + lane, t = tok % SEQ;
        float acc = 0.f;
#pragma unroll
        for (int k = 0; k < 3; ++k) { const int tt = t - 2 + k; if (tt >= 0) { const bf16_t* row = PROJ + (size_t)(tok - 2 + k) * NPROJ; acc += p.conv_w[k * 512 + c] * (bf2f(row[C_CC + c]) * bf2f(row[C_CH + c])); } }
        const float y = bf2f(PROJ[(size_t)tok * NPROJ + C_CB + c]) * acc;
        const float ms = wave_sum(y * y) * (1.f / 64.f);
        YMIX[(size_t)tok * DM + c] = f2bf(y * (1.0f / sqrtf(ms + RMS_EPS)) * p.gn_conv[c]);
    }
}
__device__ void phase_sb_simple(const Params& p) {
    unsigned char* ws = p.ws; const int lane = threadIdx.x & 63, wave = threadIdx.x >> 6; const int gw = blockIdx.x * 8 + wave, NGW = gridDim.x * 8;
    const bf16_t* PROJ = (const bf16_t*)(ws + WS_PROJ); const bf16_t* VT = (const bf16_t*)(ws + WS_VT); bf16_t* YMIX = (bf16_t*)(ws + WS_YMIX);
    for (int it = gw; it < NTOK * NHEAD; it += NGW) {
        const int tok = it / NHEAD, h = it % NHEAD, b = tok / SEQ, t = tok % SEQ;
        float q[64], o[64];
        { const bf16_t* qp = PROJ + (size_t)tok * NPROJ + C_Q + h * 64;
#pragma unroll
          for (int d = 0; d < 64; ++d) { q[d] = bf2f(qp[d]); o[d] = 0.f; } }
        float R = 0.f;
        for (int c0 = t - 1; c0 >= 0; c0 -= 64) {
            const int s = c0 - lane; const bool valid = s >= 0; const int sc = valid ? s : 0;
            const bf16_t* kp = PROJ + (size_t)(b * SEQ + sc) * NPROJ + C_K + h * 64;
            float dot = 0.f;
#pragma unroll
            for (int d8 = 0; d8 < 8; ++d8) { const bf16x8 kv = *(const bf16x8*)(kp + d8 * 8);
#pragma unroll
                for (int j = 0; j < 8; ++j) dot += q[d8 * 8 + j] * bf2f((bf16_t)kv[j]); }
            const float sp = fmaxf(dot, 0.f) + __log2f(1.0f + exp2f(-fabsf(dot)));
            const float L = valid ? -sp : 0.f;
            float incl = L;
#pragma unroll
            for (int off = 1; off < 64; off <<= 1) { const float n = __shfl_up(incl, off); if (lane >= off) incl += n; }
            const float w = valid ? exp2f(dot + L + (R + incl - L)) : 0.f;
            R += __shfl(incl, 63);
            const bf16_t* vp = VT + (size_t)(h * 64) * VT_LD + b * SEQ + sc;
#pragma unroll
            for (int d = 0; d < 64; ++d) o[d] += w * bf2f(vp[(size_t)d * VT_LD]);
        }
        float ss = 0.f, mine = 0.f;
#pragma unroll
        for (int d = 0; d < 64; ++d) { const float v = wave_sum(o[d]); ss += v * v; if (d == lane) mine = v; }
        YMIX[(size_t)tok * DM + 512 + h * 64 + lane] = f2bf(mine * (1.0f / sqrtf(ss * (1.f / 64.f) + RMS_EPS)) * p.gn_sb[h * 64 + lane]);
    }
}

template <bool STATS, class Epi>
__device__ __forceinline__ void gemm_simple(const bf16_t* A, const bf16_t* Bt, int M, int N, int K, stat_t* st, Epi epi) {
    const int wave = threadIdx.x >> 6, lane = threadIdx.x & 63; const int gw = blockIdx.x * 8 + wave, NGW = gridDim.x * 8;
    const int tn_n = N / 64, nt = (M / 64) * tn_n;
    for (int t = gw; t < nt; t += NGW) {
        const int tm = t / tn_n, tn = t % tn_n;
        f32x16 c[2][2];
        wave_tile<1>(K, [&](int i) { return A + (size_t)(tm * 64 + i) * K; }, [&](int j) { return Bt + (size_t)(tn * 64 + j) * K; }, c);
#pragma unroll
        for (int i = 0; i < 2; ++i)
#pragma unroll
            for (int q = 0; q < 16; ++q) { const int row = tm * 64 + TROW(i, q); float s = 0.f, qq = 0.f;
#pragma unroll
                for (int j = 0; j < 2; ++j) { const float v = epi(row, tn * 64 + TCOL(j), c[i][j][q]); s += v; qq += v * v; }
                if (STATS) {
#pragma unroll
                    for (int o = 1; o < 32; o <<= 1) { s += __shfl_xor(s, o); qq += __shfl_xor(qq, o); }
                    if ((lane & 31) == 0) stat_add(st, row, s, qq); } }
    }
}
__device__ void phase_outproj_simple(const Params& p) {
    unsigned char* ws = p.ws; bf16_t* T1B = (bf16_t*)(ws + WS_T1B);
    gemm_simple<true>((const bf16_t*)(ws + WS_YMIX), (const bf16_t*)(ws + WS_WOUT), NTOK, DM, DM, (stat_t*)(ws + WS_STATS1),
        [=](int row, int col, float v) { const float t = ALPHA * bf2f(T1B[(size_t)row * DM + col]) + v; T1B[(size_t)row * DM + col] = f2bf(t); return t; });
}
__device__ void phase_mq_simple(const Params& p) {
    unsigned char* ws = p.ws; bf16_t* QM = (bf16_t*)(ws + WS_QM); const stat_t* st = (const stat_t*)(ws + WS_STATS1); const float* cs = (const float*)(ws + WS_CS1); const float* bs = cs + 1024;
    gemm_simple<false>((const bf16_t*)(ws + WS_T1B), (const bf16_t*)(ws + WS_WMQ), NTOK, DM, DM, nullptr,
        [=](int row, int col, float v) { const RowStat r = row_stat(st, row); QM[(size_t)row * DM + col] = f2bf(r.rstd * (v - r.mean * cs[col]) + bs[col]); return 0.f; });
}
__device__ void phase_xattn_simple(const Params& p, unsigned char* lds) {
    unsigned char* ws = p.ws; const int lane = threadIdx.x & 63, wave = threadIdx.x >> 6; const int gw = blockIdx.x * 8 + wave, NGW = gridDim.x * 8;
    const bf16_t* QM = (const bf16_t*)(ws + WS_QM); const bf16_t* MK = (const bf16_t*)(ws + WS_MEMK); const bf16_t* MVT = (const bf16_t*)(ws + WS_MEMVT); bf16_t* OB = (bf16_t*)(ws + WS_OB);
    float* qs = (float*)(lds + wave * 4096); float* ps = qs + 256;
    for (int it = gw; it < NTOK * MH; it += NGW) {
        const int tok = it / MH, h = it % MH, b = tok / SEQ;
        const bf16_t* qp = QM + (size_t)tok * DM + h * MHD;
#pragma unroll
        for (int j = 0; j < 4; ++j) qs[lane + 64 * j] = bf2f(qp[lane + 64 * j]);
        asm volatile("s_waitcnt lgkmcnt(0)" ::: "memory");
        float sc[4];
#pragma unroll
        for (int j = 0; j < 4; ++j) { const int key = lane + 64 * j; const bf16_t* kp = MK + (size_t)(b * MEML + key) * DM + h * MHD; float dot = 0.f;
#pragma unroll 2
            for (int d8 = 0; d8 < 32; ++d8) { const bf16x8 kv = *(const bf16x8*)(kp + d8 * 8);
#pragma unroll
                for (int e = 0; e < 8; ++e) dot += qs[d8 * 8 + e] * bf2f((bf16_t)kv[e]); }
            sc[j] = dot; }
        const float mx = wave_max(fmaxf(fmaxf(sc[0], sc[1]), fmaxf(sc[2], sc[3])));
        float sum = 0.f;
#pragma unroll
        for (int j = 0; j < 4; ++j) { sc[j] = exp2f(sc[j] - mx); sum += sc[j]; }
        sum = wave_sum(sum); const float inv = 1.0f / sum;
#pragma unroll
        for (int j = 0; j < 4; ++j) ps[lane + 64 * j] = sc[j] * inv;
        asm volatile("s_waitcnt lgkmcnt(0)" ::: "memory");
#pragma unroll
        for (int j = 0; j < 4; ++j) { const int d = lane + 64 * j; const bf16_t* vp = MVT + (size_t)(h * MHD + d) * MVT_LD + b * MEML; float acc = 0.f;
#pragma unroll 2
            for (int k8 = 0; k8 < 32; ++k8) { const bf16x8 vv = *(const bf16x8*)(vp + k8 * 8);
#pragma unroll
                for (int e = 0; e < 8; ++e) acc += ps[k8 * 8 + e] * bf2f((bf16_t)vv[e]); }
            OB[(size_t)tok * DM + h * MHD + d] = f2bf(acc); }
        asm volatile("s_waitcnt lgkmcnt(0)" ::: "memory");
    }
}
__device__ void phase_mo_simple(const Params& p) {
    unsigned char* ws = p.ws; bf16_t* T2B = (bf16_t*)(ws + WS_T2B); const bf16_t* T1B = (const bf16_t*)(ws + WS_T1B); const stat_t* st1 = (const stat_t*)(ws + WS_STATS1);
    const float* g1 = p.ln1_g; const float* b1 = p.ln1_b;
    gemm_simple<true>((const bf16_t*)(ws + WS_OB), (const bf16_t*)(ws + WS_WMO), NTOK, DM, DM, (stat_t*)(ws + WS_STATS2),
        [=](int row, int col, float v) { const RowStat r = row_stat(st1, row); const float x1 = (bf2f(T1B[(size_t)row * DM + col]) - r.mean) * r.rstd * g1[col] + b1[col];
            const float t = ALPHA * x1 + v; T2B[(size_t)row * DM + col] = f2bf(t); return t; });
}
__device__ void phase_router_simple(const Params& p) {
    unsigned char* ws = p.ws; float* LG = (float*)(ws + WS_LOGIT); const stat_t* st = (const stat_t*)(ws + WS_STATS2); const float* cs = (const float*)(ws + WS_CS2); const float* bs = cs + 64;
    gemm_simple<false>((const bf16_t*)(ws + WS_T2B), (const bf16_t*)(ws + WS_WRT), NTOK, 64, DM, nullptr,
        [=](int row, int col, float v) { const RowStat r = row_stat(st, row); LG[(size_t)row * NLOGP + col] = r.rstd * (v - r.mean * cs[col]) + bs[col]; return 0.f; });
}
__device__ void phase_route(const Params& p, unsigned char* lds_, int t_first = -1) {
    unsigned char* ws = p.ws; const int tid = threadIdx.x;
    const float* LG = (const float*)(ws + WS_LOGIT); int* EID = (int*)(ws + WS_EID); float* GATE = (float*)(ws + WS_GATE); unsigned* CNT = (unsigned*)(ws + WS_CNT); int* ROWL = (int*)(ws + WS_ROWL); f32x4* ROWM = (f32x4*)p.out; const stat_t* st2 = (const stat_t*)(ws + WS_STATS2);
    LAS unsigned* lc = (LAS unsigned*)lds_;
    for (int t0 = t_first >= 0 ? t_first : blockIdx.x * 512; t0 < (t_first >= 0 ? t_first + 256 : NTOK); t0 += gridDim.x * 512) {
        if (tid < 64) lc[tid] = 0u;
        __syncthreads();
        const int tok = (t_first >= 0 && tid >= 256) ? NTOK : t0 + tid; int ea = 0, eb = 0; unsigned ra = 0, rb = 0; float ga = 0.f, gb = 0.f;
        if (tok < NTOK) {
            const float* lg = LG + (size_t)tok * NLOGP;
            int grp = 0; float gm = lg[0];
#pragma unroll
            for (int g = 1; g < 4; ++g) if (lg[g] > gm) { gm = lg[g]; grp = g; }
            float gs = 0.f;
#pragma unroll
            for (int g = 0; g < 4; ++g) gs += __expf(lg[g] - gm);
            const float gprob = 1.0f / gs;
            const float* el = lg + 4 + grp * 8;
            int i1 = 0; float l1 = el[0];
#pragma unroll
            for (int j = 1; j < 8; ++j) if (el[j] > l1) { l1 = el[j]; i1 = j; }
            int i2 = -1; float l2 = 0.f;
#pragma unroll
            for (int j = 0; j < 8; ++j) if (j != i1 && (i2 < 0 || el[j] > l2)) { l2 = el[j]; i2 = j; }
            const float e2 = __expf(l2 - l1), w1 = 1.0f / (1.0f + e2), w2 = e2 * w1;
            ea = grp * 8 + i1; eb = grp * 8 + i2;
            EID[2 * tok] = ea; EID[2 * tok + 1] = eb; ga = gprob * w1; gb = gprob * w2; GATE[2 * tok] = ga; GATE[2 * tok + 1] = gb;
            ra = atomicAdd((unsigned*)(lc + ea), 1u); rb = atomicAdd((unsigned*)(lc + eb), 1u);
        }
        __syncthreads();
        if (tid < 32) lc[32 + tid] = lc[tid] ? atomicAdd(CNT + tid, lc[tid]) : 0u;
        __syncthreads();
        if (tok < NTOK) { const RowStat rs = row_stat(st2, tok); const size_t ia = (size_t)ea * CAP + lc[32 + ea] + ra, ib = (size_t)eb * CAP + lc[32 + eb] + rb;
            ROWL[ia] = 2 * tok; ROWL[ib] = 2 * tok + 1; ROWM[ia] = (f32x4){ga, rs.mean, rs.rstd, 0.f}; ROWM[ib] = (f32x4){gb, rs.mean, rs.rstd, 0.f}; }
        __syncthreads();
    }
}
__device__ void phase_moe1_simple(const Params& p) {
    unsigned char* ws = p.ws; const int wave = threadIdx.x >> 6; const int gw = blockIdx.x * 8 + wave, NGW = gridDim.x * 8;
    const unsigned* CNT = (const unsigned*)(ws + WS_CNT); const int* ROWL = (const int*)(ws + WS_ROWL); const bf16_t* T2B = (const bf16_t*)(ws + WS_T2B); const bf16_t* WGU = (const bf16_t*)(ws + WS_WGU);
    const stat_t* st = (const stat_t*)(ws + WS_STATS2); const float* csg = (const float*)(ws + WS_CSGU); const float* bsg = csg + NEXP * 1024; bf16_t* H = (bf16_t*)(ws + WS_H);
    int tbase = 0, hoff = 0;
    for (int e = 0; e < NEXP; ++e) {
        const int cnt = (int)CNT[e], nrt = (cnt + 63) / 64, ntile = nrt * 8;
        for (int t = gw - tbase; t < ntile; t += NGW) { if (t < 0) continue;
            const int tm = t / 8, ct = t % 8, pn = ct >> 1, hf = ct & 1; const int* rl = ROWL + (size_t)e * CAP; const bf16_t* W = WGU + (size_t)e * 1024 * 1024;
            f32x16 c[2][4];
            wave_tile<2>(DM, [&](int i) { int r = tm * 64 + i; r = r < cnt ? r : cnt - 1; return T2B + (size_t)(rl[r] >> 1) * DM; },
                         [&](int j) { const int row = 256 * pn + (j >= 64 ? 128 : 0) + 64 * hf + (j & 63); return W + (size_t)row * DM; }, c);
#pragma unroll
            for (int i = 0; i < 2; ++i)
#pragma unroll
                for (int q = 0; q < 16; ++q) { const int r = tm * 64 + TROW(i, q); if (r < cnt) { const RowStat rs = row_stat(st, rl[r] >> 1);
#pragma unroll
                    for (int j = 0; j < 2; ++j) { const int cg_ = 256 * pn + 64 * hf + TCOL(j), cu_ = cg_ + 128;
                        const float g = rs.rstd * (c[i][j][q] - rs.mean * csg[e * 1024 + cg_]) + bsg[e * 1024 + cg_];
                        const float u = rs.rstd * (c[i][j + 2][q] - rs.mean * csg[e * 1024 + cu_]) + bsg[e * 1024 + cu_];
                        H[(size_t)(hoff + r) * DEXP + 128 * pn + 64 * hf + TCOL(j)] = f2bf(g / (1.0f + __expf(-g)) * u); } } }
        }
        tbase = (tbase + ntile) % NGW; hoff += (cnt + 255) / 256 * 256;
    }
}
__device__ void phase_moe2_simple(const Params& p) {
    unsigned char* ws = p.ws; const int wave = threadIdx.x >> 6; const int gw = blockIdx.x * 8 + wave, NGW = gridDim.x * 8;
    const unsigned* CNT = (const unsigned*)(ws + WS_CNT); const int* ROWL = (const int*)(ws + WS_ROWL); const bf16_t* H = (const bf16_t*)(ws + WS_H); const bf16_t* WD = (const bf16_t*)(ws + WS_WD);
    const float* GATE = (const float*)(ws + WS_GATE); bf16_t* Y = (bf16_t*)(ws + WS_Y);
    int tbase = 0, hoff = 0;
    for (int e = 0; e < NEXP; ++e) {
        const int cnt = (int)CNT[e], nrt = (cnt + 63) / 64, ntile = nrt * 16;
        for (int t = gw - tbase; t < ntile; t += NGW) { if (t < 0) continue;
            const int tm = t / 16, tn = t % 16; const int* rl = ROWL + (size_t)e * CAP; const bf16_t* W = WD + (size_t)e * 1024 * 512;
            f32x16 c[2][2];
            wave_tile<1>(DEXP, [&](int i) { int r = tm * 64 + i; r = r < cnt ? r : cnt - 1; return H + (size_t)(hoff + r) * DEXP; }, [&](int j) { return W + (size_t)(tn * 64 + j) * DEXP; }, c);
#pragma unroll
            for (int i = 0; i < 2; ++i)
#pragma unroll
                for (int q = 0; q < 16; ++q) { const int r = tm * 64 + TROW(i, q); if (r < cnt) { const int a = rl[r]; const float g = GATE[a];
#pragma unroll
                    for (int j = 0; j < 2; ++j) Y[(size_t)a * DM + tn * 64 + TCOL(j)] = f2bf(g * c[i][j][q]); } }
        }
        tbase = (tbase + ntile) % NGW; hoff += (cnt + 255) / 256 * 256;
    }
}
__device__ void phase_final(const Params& p) {
    unsigned char* ws = p.ws; const int lane = threadIdx.x & 63, wave = threadIdx.x >> 6; const int gw = blockIdx.x * 8 + wave, NGW = gridDim.x * 8;
    const bf16_t* T2B = (const bf16_t*)(ws + WS_T2B); const unsigned char* Y = ws + WS_Y; const stat_t* st = (const stat_t*)(ws + WS_STATS2);
    f32x4 g2v[4], b2v[4], g3v[4], b3v[4];
#pragma unroll
    for (int j = 0; j < 2; ++j)
#pragma unroll
        for (int hf = 0; hf < 2; ++hf) { const int c0 = 512 * j + 8 * lane + 4 * hf; g2v[2 * j + hf] = *(const f32x4*)(p.ln2_g + c0); b2v[2 * j + hf] = *(const f32x4*)(p.ln2_b + c0); g3v[2 * j + hf] = *(const f32x4*)(p.ln3_g + c0); b3v[2 * j + hf] = *(const f32x4*)(p.ln3_b + c0); }
    for (int tok = gw; tok < NTOK; tok += NGW) {
        u32x4 tw[2]; u32x2 aw[2], bw[2];
#pragma unroll
        for (int j = 0; j < 2; ++j) { const int c0 = 512 * j + 8 * lane; tw[j] = *(const u32x4*)(T2B + (size_t)tok * DM + c0); aw[j] = __builtin_nontemporal_load((const u32x2*)(Y + (size_t)(2 * tok) * DM + c0)); bw[j] = __builtin_nontemporal_load((const u32x2*)(Y + (size_t)(2 * tok + 1) * DM + c0)); }
        const RowStat rs = row_stat(st, tok);
        f32x4 v[4]; float s = 0.f;
#pragma unroll
        for (int j = 0; j < 2; ++j) {
            v[2 * j] = ALPHA * ((unpack_lo(tw[j]) - rs.mean) * rs.rstd * g2v[2 * j] + b2v[2 * j]) + (unpack_fp8(aw[j].x) + unpack_fp8(bw[j].x)) * (1.0f / Y8S);
            v[2 * j + 1] = ALPHA * ((unpack_hi(tw[j]) - rs.mean) * rs.rstd * g2v[2 * j + 1] + b2v[2 * j + 1]) + (unpack_fp8(aw[j].y) + unpack_fp8(bw[j].y)) * (1.0f / Y8S);
            s += sum4(v[2 * j]) + sum4(v[2 * j + 1]); }
        const float mean = wave_sum(s) * (1.f / DM); float qq = 0.f;
#pragma unroll
        for (int i = 0; i < 4; ++i) { v[i] = v[i] - mean; qq += sq4(v[i]); }
        const float rstd = __builtin_amdgcn_rsqf(wave_sum(qq) * (1.f / DM) + LN_EPS);
#pragma unroll
        for (int j = 0; j < 2; ++j)
#pragma unroll
            for (int hf = 0; hf < 2; ++hf) __builtin_nontemporal_store(v[2 * j + hf] * rstd * g3v[2 * j + hf] + b3v[2 * j + hf], (f32x4*)(p.out + (size_t)tok * DM + 512 * j + 8 * lane + 4 * hf));
    }
}

#ifndef PROBE_SEC
#define PROBE_SEC -1
#endif
#if PROBE_SEC >= 0
__device__ unsigned long long g_psec[4];
#define PSEC_DECL unsigned long long ps_t = 0, ps_a0 = 0, ps_a1 = 0, ps_a2 = 0
#define PSEC_T0 do { if (psec) ps_t = __builtin_amdgcn_s_memrealtime(); } while (0)
#define PSEC_ADD(w) do { if (psec) { const unsigned long long n_ = __builtin_amdgcn_s_memrealtime(); ps_a##w += n_ - ps_t; ps_t = n_; } } while (0)
#define PSEC_OUT do { if (psec && blockIdx.x == 0 && threadIdx.x == 0) { g_psec[0] = ps_a0; g_psec[1] = ps_a1; g_psec[2] = ps_a2; } } while (0)
#else
#define PSEC_DECL
#define PSEC_T0
#define PSEC_ADD(w)
#define PSEC_OUT
#endif
#ifndef JIT_AB
#define JIT_AB 1
#endif
#ifndef JIT_V
#define JIT_V 1
#endif
namespace mm {
constexpr int BM = 256, BK = 64, HALF = 128, HTB = HALF * BK * 2, STAGE_BYTES = 8 * HTB, NXCD = 8, WGM = 8;
__device__ __forceinline__ int lds_byte(int r, int c) { const int st = (r >> 4) * 2 + (c >> 5), rr = r & 15, cc = c & 31, ob = rr * 64 + cc * 2; return st * 1024 + (ob ^ (((ob >> 9) & 1) << 5)); }
__device__ __forceinline__ void stage_rc(int b, int& R, int& C) { const int st = b / 1024, sb = b % 1024, swz = sb ^ (((sb >> 9) & 1) << 5); R = (st >> 1) * 16 + swz / 64; C = (st & 1) * 32 + (swz % 64) / 2; }
__device__ __forceinline__ int perm32(int rho) { const int n = rho >> 4, i = rho & 15; return 8 * (i >> 2) + 4 * n + (i & 3); }
typedef int i32x8 __attribute__((ext_vector_type(8))); typedef int i32x4v __attribute__((ext_vector_type(4)));
__device__ __forceinline__ i32x8 cat8(bf16x8 lo, bf16x8 hi) { const i32x4v a = __builtin_bit_cast(i32x4v, lo), b = __builtin_bit_cast(i32x4v, hi); return __builtin_shufflevector(a, b, 0, 1, 2, 3, 4, 5, 6, 7); }
__device__ __forceinline__ unsigned cvt_pk_bf16(float lo, float hi) { typedef float f2 __attribute__((ext_vector_type(2))); typedef __bf16 b2 __attribute__((ext_vector_type(2))); f2 v = {lo, hi}; b2 b = __builtin_convertvector(v, b2); return __builtin_bit_cast(unsigned, b); }

struct Unit { int pm, pn, aux, nvalid; const char* a; const char* b; const int* rows; };
struct Meta { float r0, r1; int r2; float c0, c1; };
constexpr int META_OFF = 137216, META_SLOT = 5120;

__device__ __forceinline__ void order_map(int L, int nM, int nN, int& pm, int& pn) {
    const int nwg = nM * nN; int wgid = L; { const int q = nwg / NXCD, r = nwg % NXCD, xcd = wgid % NXCD, off = wgid / NXCD; wgid = (xcd < r ? xcd * (q + 1) : r * (q + 1) + (xcd - r) * q) + off; }
    const int nig = WGM * nN, gid = wgid / nig, fm = gid * WGM, gsz = (nM - fm) < WGM ? (nM - fm) : WGM;
    pm = fm + ((wgid % nig) % gsz); pn = (wgid % nig) / gsz;
}

template <class Epi, class Sched, bool GATHER, bool FP8 = false>
__device__ __forceinline__ void gemm_phase(LAS unsigned char* lds, const int K, const Sched& S, const Epi& E, const int LD_ = 0, const bool psec = false) {
    PSEC_DECL;
    const int LD = LD_ ? LD_ : K;
    const int tid = threadIdx.x, wid = __builtin_amdgcn_readfirstlane(tid >> 6), lane = tid & 63, wr = wid >> 2, wc = wid & 3, fr = lane & 15, fq = lane >> 4;
    const int nt = K / BK;
    unsigned voffB, voffA, rp[2];
    { int sR, sC; stage_rc(tid * 16, sR, sC); const int Rb = Epi::PERM ? ((sR & ~31) + perm32(sR & 31)) : sR;
      voffB = (unsigned)(Rb * LD + sC) * 2u; voffA = GATHER ? (unsigned)sC * 2u : (unsigned)(sR * LD + sC) * 2u; }
    unsigned pk = 0;
    if constexpr (FP8) { int sR, sC; stage_rc(tid * 16, sR, sC); const int Rb = Epi::PERM ? ((sR & ~31) + perm32(sR & 31)) : sR;
        pk = (unsigned)(lds_byte(fr, fq * 8) >> 4) | ((unsigned)sR << 6) | ((unsigned)Rb << 12) | ((unsigned)(sC >> 3) << 18); }
    const unsigned LD2 = (unsigned)LD * 2u; const int abase = wr * 8192, bbase = wc * 4096;
    auto voffb_of = [&](unsigned q) -> unsigned { return __umul24((q >> 12) & 63u, LD2) + (((q >> 18) & 7u) << 4); };
    auto voffa_of = [&](unsigned q) -> unsigned { return GATHER ? (((q >> 18) & 7u) << 4) : __umul24((q >> 6) & 63u, LD2) + (((q >> 18) & 7u) << 4); };
    auto aoff_of = [&](unsigned q) -> int { return abase + (int)((q & 63u) << 4); };
    auto boff_of = [&](unsigned q) -> int { return bbase + (int)((q & 63u) << 4); };
    const size_t kstep = (size_t)(BK * 2), hstep = (size_t)HALF * LD * 2, r64 = (size_t)64 * LD * 2;
    const unsigned ldsw = (unsigned)wid * 1024u;
    const int aoff = lds_byte(wr * 64 + fr, fq * 8), boff = lds_byte(wc * 32 + fr, fq * 8);
    constexpr int apc = 1024, bpc = apc;
#define MM_SA(b, h) (((b) * 2 + (h)) * HTB)
#define MM_SB(b, h) ((4 + (b) * 2 + (h)) * HTB)
#define MM_GLDS(src, dst) __builtin_amdgcn_global_load_lds((const unsigned*)(src), (LAS unsigned*)(dst), 16, 0, 0)
#define MM_OPQ(v_) ({ unsigned o_ = (v_); if constexpr (FP8) asm volatile("" : "+v"(o_)); o_; })
#define MM_STAGE_B(bufoff, gbase) do { const unsigned vb_ = (FP8 && JIT_V) ? voffb_of(MM_OPQ(pk)) : voffB; MM_GLDS((const char*)(gbase) + vb_, lds + (bufoff) + ldsw); MM_GLDS((const char*)(gbase) + r64 + vb_, lds + (bufoff) + ldsw + 8192); } while (0)
#define MM_STAGE_A(bufoff, gbase, h) do { if (GATHER) { \
        MM_GLDS((const char*)(gbase) + (unsigned)((rp[h] & 0xffffu) * (unsigned)(LD * 2) + voffA), lds + (bufoff) + ldsw); MM_GLDS((const char*)(gbase) + (unsigned)((rp[h] >> 16) * (unsigned)(LD * 2) + voffA), lds + (bufoff) + ldsw + 8192); } \
      else { const unsigned va_ = (FP8 && JIT_V) ? voffa_of(MM_OPQ(pk)) : voffA; MM_GLDS((const char*)(gbase) + (h) * hstep + va_, lds + (bufoff) + ldsw); MM_GLDS((const char*)(gbase) + (h) * hstep + r64 + va_, lds + (bufoff) + ldsw + 8192); } } while (0)
#define MM_LDA(dst, b, h) do { if constexpr (FP8) { const int ao_ = JIT_AB ? aoff_of(MM_OPQ(pk)) : aoff; _Pragma("unroll") for (int m = 0; m < 4; ++m) dst##8[m] = cat8(*(const LAS bf16x8*)(lds + MM_SA(b, h) + ao_ + m * 2048), *(const LAS bf16x8*)(lds + MM_SA(b, h) + ao_ + m * 2048 + apc)); } \
        else { _Pragma("unroll") for (int m = 0; m < 4; ++m) _Pragma("unroll") for (int k = 0; k < 2; ++k) dst[m][k] = *(const LAS bf16x8*)(lds + MM_SA(b, h) + aoff + m * 2048 + k * 1024); } } while (0)
#define MM_LDB(dst, b, h) do { if constexpr (FP8) { const int bo_ = JIT_AB ? boff_of(MM_OPQ(pk)) : boff; _Pragma("unroll") for (int n = 0; n < 2; ++n) dst##8[n] = cat8(*(const LAS bf16x8*)(lds + MM_SB(b, h) + bo_ + n * 2048), *(const LAS bf16x8*)(lds + MM_SB(b, h) + bo_ + n * 2048 + bpc)); } \
        else { _Pragma("unroll") for (int n = 0; n < 2; ++n) _Pragma("unroll") for (int k = 0; k < 2; ++k) dst[n][k] = *(const LAS bf16x8*)(lds + MM_SB(b, h) + boff + n * 2048 + k * 1024); } } while (0)
#define MM_MMA(ai, bj, At, Bt) do { __builtin_amdgcn_s_setprio(1); _Pragma("unroll") for (int m = 0; m < 4; ++m) _Pragma("unroll") for (int n = 0; n < 2; ++n) { \
        if constexpr (FP8) acc[ai][bj][m][n] = __builtin_amdgcn_mfma_scale_f32_16x16x128_f8f6f4(Bt##8[n], At##8[m], acc[ai][bj][m][n], 0, 0, 0, 0x7f7f7f7f, 0, 0x7f7f7f7f); \
        else { _Pragma("unroll") for (int k = 0; k < 2; ++k) acc[ai][bj][m][n] = __builtin_amdgcn_mfma_f32_16x16x32_bf16(Bt[n][k], At[m][k], acc[ai][bj][m][n], 0, 0, 0); } } \
        __builtin_amdgcn_s_setprio(0); } while (0)
#define MM_WAIT_V(n) asm volatile("s_waitcnt vmcnt(" #n ")" ::: "memory")
#define MM_WAIT_L(n) asm volatile("s_waitcnt lgkmcnt(" #n ")" ::: "memory")
#define MM_BAR __builtin_amdgcn_s_barrier()
#define MM_SCHED __builtin_amdgcn_sched_barrier(0)
#define MM_ROWPAIRS(dst, u) do { int _t = tid; asm volatile("" : "+v"(_t)); int _sR, _sC; stage_rc(_t * 16, _sR, _sC); _Pragma("unroll") for (int _h = 0; _h < 2; ++_h) \
        dst[_h] = (unsigned)S.row(u, _h * HALF + _sR) | ((unsigned)S.row(u, _h * HALF + _sR + 64) << 16); } while (0)
#define MM_NVL() ((LAS unsigned*)(lds + 133120 + tid * 8))
#define MM_ROWS_DMA(u_) do { if (wid < 4) __builtin_amdgcn_global_load_lds((const unsigned*)((u_).rows + (tid & 255)), (LAS unsigned*)(lds + 133120 + wid * 256), 4, 0, 0); } while (0)
#define MM_RP_FROM_LDS(nv_) do { int _t = tid; asm volatile("" : "+v"(_t)); int _sR, _sC; stage_rc(_t * 16, _sR, _sC); const int _lim = (nv_) - 1; const LAS int* _rw = (const LAS int*)(lds + 133120); \
        _Pragma("unroll") for (int _h = 0; _h < 2; ++_h) { const int _r0 = min(_h * HALF + _sR, _lim), _r1 = min(_h * HALF + _sR + 64, _lim); \
            rp[_h] = (unsigned)S.rowfix(_rw[_r0]) | ((unsigned)S.rowfix(_rw[_r1]) << 16); } } while (0)
    Unit cur, nxt, nx2; int ui = 0; cur.aux = nxt.aux = nx2.aux = 0;
    if (!S.next(0, cur)) return;
    f32x4 acc[2][2][4][2];
#pragma unroll
    for (int a = 0; a < 2; ++a)
#pragma unroll
        for (int b = 0; b < 2; ++b)
#pragma unroll
            for (int m = 0; m < 4; ++m)
#pragma unroll
                for (int n = 0; n < 2; ++n) acc[a][b][m][n] = (f32x4){0.f, 0.f, 0.f, 0.f};
    bf16x8 At[4][2], B0[2][2], B1[2][2];
    i32x8 At8[4], B08[2], B18[2];
    rp[0] = rp[1] = 0u;
    if constexpr (GATHER) { MM_ROWPAIRS(rp, cur); if (S.next(1, nxt)) MM_ROWS_DMA(nxt);
        asm volatile("s_waitcnt vmcnt(0) lgkmcnt(0)" ::: "memory");
        asm volatile("" : "+v"(rp[0]), "+v"(rp[1])); }
#define MM_META_STORE_T(slot_, m_, t_) do { LAS float* s_ = (LAS float*)(lds + META_OFF + (slot_) * META_SLOT); s_[t_] = (m_).r0; s_[256 + (t_)] = (m_).r1; ((LAS int*)s_)[512 + (t_)] = (m_).r2; s_[768 + (t_)] = (m_).c0; s_[1024 + (t_)] = (m_).c1; } while (0)
#define MM_META_STORE(slot_, m_) MM_META_STORE_T(slot_, m_, tid)
    if (Epi::META) { if (tid < 256) { const Meta m0 = E.meta_load(cur, tid); MM_META_STORE(0, m0); } }
    const char* cA = cur.a; const char* cB = cur.b;
    MM_STAGE_B(MM_SB(0, 0), cB); MM_STAGE_B(MM_SB(0, 1), cB + hstep); MM_STAGE_A(MM_SA(0, 0), cA, 0); MM_STAGE_A(MM_SA(0, 1), cA, 1);
    if (wr == 1) MM_BAR;
    MM_WAIT_V(2); MM_BAR;
    MM_STAGE_B(MM_SB(1, 0), cB + kstep); MM_STAGE_A(MM_SA(1, 0), cA + kstep, 0); MM_STAGE_B(MM_SB(1, 1), cB + hstep + kstep);
    MM_WAIT_V(6); MM_BAR;
    PSEC_T0;
    for (;;) {
        const bool has_next = S.next(ui + 1, nxt);
        const char* nA = has_next ? nxt.a : cA; const char* nB = has_next ? nxt.b : cB;
        PSEC_ADD(2);
#pragma unroll 1
        for (int t = 0; t < nt; t += 2) {
            const bool last = (t == nt - 2);
            const char* a1 = cA + (size_t)(t + 1) * kstep;
            const char* a2 = last ? nA : cA + (size_t)(t + 2) * kstep; const char* b2 = last ? nB : cB + (size_t)(t + 2) * kstep;
            const char* a3 = a2 + kstep; const char* b3 = b2 + kstep;
            MM_LDB(B0, 0, 0); MM_LDB(B1, 0, 1); MM_SCHED; MM_LDA(At, 0, 0); MM_STAGE_A(MM_SA(1, 1), a1, 1);
            PSEC_ADD(0); MM_WAIT_V(8); MM_WAIT_L(0); MM_BAR; PSEC_ADD(1); MM_MMA(0, 0, At, B0); MM_MMA(0, 1, At, B1); MM_BAR; MM_SCHED;
            if constexpr (GATHER) { if (last && has_next) MM_RP_FROM_LDS(nxt.nvalid); }
            MM_LDA(At, 0, 1); MM_STAGE_B(MM_SB(0, 0), b2); MM_STAGE_B(MM_SB(0, 1), b2 + hstep); MM_STAGE_A(MM_SA(0, 0), a2, 0);
            PSEC_ADD(0); MM_WAIT_V(8); MM_WAIT_L(0); MM_BAR; PSEC_ADD(1); MM_MMA(1, 0, At, B0); MM_MMA(1, 1, At, B1); MM_BAR; MM_SCHED;
            MM_LDB(B0, 1, 0); MM_LDB(B1, 1, 1); MM_SCHED; MM_LDA(At, 1, 0); MM_STAGE_A(MM_SA(0, 1), a2, 1);
            PSEC_ADD(0); MM_WAIT_V(8); MM_WAIT_L(0); MM_BAR; PSEC_ADD(1); MM_MMA(0, 0, At, B0); MM_MMA(0, 1, At, B1); MM_BAR; MM_SCHED;
            MM_LDA(At, 1, 1); MM_STAGE_B(MM_SB(1, 0), b3); MM_STAGE_B(MM_SB(1, 1), b3 + hstep); MM_STAGE_A(MM_SA(1, 0), a3, 0);
            PSEC_ADD(0); MM_WAIT_V(8); MM_WAIT_L(0); MM_BAR; PSEC_ADD(1); MM_MMA(1, 0, At, B0); MM_MMA(1, 1, At, B1); MM_BAR; MM_SCHED;
        }
        PSEC_ADD(0);
        if constexpr (GATHER) { if (has_next && S.next(ui + 2, nx2)) MM_ROWS_DMA(nx2); }
        if (wr == 0) MM_BAR;
        int tq = tid, frq = fr, fqq = fq;
        if constexpr (FP8) { unsigned l_; asm volatile("v_mbcnt_lo_u32_b32 %0, -1, 0\n\tv_mbcnt_hi_u32_b32 %0, -1, %0" : "=v"(l_));
            tq = wid * 64 + (int)l_; frq = (int)(l_ & 15u); fqq = (int)(l_ >> 4); }
        Meta mn; const bool pm_ = Epi::META && has_next && tq < 256;
        if (pm_) mn = E.meta_load(nxt, tq);
        E(acc, cur, wr, wc, frq, fqq, (const LAS float*)(lds + META_OFF + (ui & 1) * META_SLOT));
        if (pm_) MM_META_STORE_T((ui + 1) & 1, mn, tq);
#ifdef PSEC_DRAIN
        if (psec) asm volatile("s_waitcnt vmcnt(0)" ::: "memory");
#endif
        PSEC_ADD(2);
        if (!has_next) break;
#pragma unroll
        for (int a = 0; a < 2; ++a)
#pragma unroll
            for (int b = 0; b < 2; ++b)
#pragma unroll
                for (int m = 0; m < 4; ++m)
#pragma unroll
                    for (int n = 0; n < 2; ++n) acc[a][b][m][n] = (f32x4){0.f, 0.f, 0.f, 0.f};
        cur = nxt; cA = nA; cB = nB; ++ui;
        if (wr == 1) MM_BAR;
    }
    MM_WAIT_V(0);
    MM_BAR;
    PSEC_OUT;
#undef MM_SA
#undef MM_SB
#undef MM_GLDS
#undef MM_OPQ
#undef MM_STAGE_A
#undef MM_STAGE_B
#undef MM_LDA
#undef MM_LDB
#undef MM_MMA
#undef MM_WAIT_V
#undef MM_WAIT_L
#undef MM_BAR
#undef MM_SCHED
#undef MM_META_STORE
#undef MM_META_STORE_T
#undef MM_ROWPAIRS
#undef MM_NVL
#undef MM_ROWS_DMA
#undef MM_RP_FROM_LDS
}
}

typedef mm::Unit MUnit;
typedef f32x4 AccT[2][2][4][2];
__device__ __forceinline__ u32x4 pack8(const f32x4 a, const f32x4 b) { u32x4 w; w.x = mm::cvt_pk_bf16(a[0], a[1]); w.y = mm::cvt_pk_bf16(a[2], a[3]); w.z = mm::cvt_pk_bf16(b[0], b[1]); w.w = mm::cvt_pk_bf16(b[2], b[3]); return w; }

struct SchedProj {
    const char *xb, *win, *memb, *wmk, *wmv; int G, c;
    __device__ __forceinline__ bool next(int i, MUnit& u) const {
        int L = i * G + c; u.rows = nullptr; u.nvalid = 256;
        constexpr int U0 = 256 * 10, U1 = 512, U2 = 128, U3 = 128;
        if (L < U0) { int pm, pn; mm::order_map(L, 256, 10, pm, pn); u.pm = pm; u.pn = pn; u.aux = 0; u.a = xb + (size_t)pm * 256 * 2048; u.b = win + (size_t)pn * 256 * 2048; return true; }
        L -= U0;
        if (L < U1) { u.pm = L & 1; u.pn = L >> 1; u.aux = 1; u.a = win + (size_t)(C_V + 256 * u.pm) * 2048; u.b = xb + (size_t)u.pn * 256 * 2048; return true; }
        L -= U1;
        if (L < U2) { u.pm = L >> 2; u.pn = L & 3; u.aux = 2; u.a = memb + (size_t)u.pm * 256 * 2048; u.b = wmk + (size_t)u.pn * 256 * 2048; return true; }
        L -= U2;
        if (L < U3) { u.pm = L >> 2; u.pn = L & 3; u.aux = 3; u.a = memb + (size_t)u.pm * 256 * 2048; u.b = wmv + (size_t)u.pn * 256 * 2048; return true; }
        return false;
    }
    __device__ __forceinline__ int row(const MUnit&, int r) const { return r; }
};
struct EpiProj {
    static constexpr bool PERM = true, META = false;
    bf16_t *proj, *vt, *mk, *mvt;
    __device__ __forceinline__ mm::Meta meta_load(const MUnit&, int) const { return mm::Meta{}; }
    __device__ __forceinline__ void operator()(const AccT& acc, const MUnit& u, int wr, int wc, int fr, int fq, const LAS float*) const {
        bf16_t* O = u.aux == 0 ? proj : u.aux == 1 ? vt : u.aux == 2 ? mk : mvt; const int ldc = u.aux == 0 ? NPROJ : u.aux == 1 ? VT_LD : DM;
        const int row0 = u.pm * 256 + wr * 64 + fr, col0 = u.pn * 256 + wc * 32 + 8 * fq;
#pragma unroll
        for (int ai = 0; ai < 2; ++ai)
#pragma unroll
            for (int m = 0; m < 4; ++m) { bf16_t* rowp = O + (size_t)(row0 + ai * 128 + m * 16) * ldc + col0;
#pragma unroll
                for (int bj = 0; bj < 2; ++bj) __builtin_nontemporal_store(pack8(acc[ai][bj][m][0], acc[ai][bj][m][1]), (u32x4*)(rowp + bj * 128)); }
    }
};
struct SchedDense {
    const char *A, *B; int nM, nN, G, c, rowpm;
    __device__ __forceinline__ bool next(int i, MUnit& u) const {
        int pm, pn;
        if (rowpm >= 0) { if (i >= nN) return false; pm = rowpm; pn = i; }
        else { const int L = i * G + c; if (L >= nM * nN) return false; mm::order_map(L, nM, nN, pm, pn); }
        u.pm = pm; u.pn = pn; u.aux = 0; u.nvalid = 256; u.rows = nullptr; u.a = A + (size_t)pm * 256 * 2048; u.b = B + (size_t)pn * 256 * 2048; return true;
    }
    __device__ __forceinline__ int row(const MUnit&, int r) const { return r; }
};
__device__ __forceinline__ void row_stats_add(stat_t* st, int row, float s, float q, int fq) {
    s += __shfl_xor(s, 16); s += __shfl_xor(s, 32); q += __shfl_xor(q, 16); q += __shfl_xor(q, 32);
    if (fq == 0) stat_add(st, row, s, q);
}
struct EpiOut {
    static constexpr bool PERM = true, META = false;
    bf16_t* t1b; stat_t* st; unsigned char* t1f8;
    __device__ __forceinline__ mm::Meta meta_load(const MUnit&, int) const { return mm::Meta{}; }
    __device__ __forceinline__ void operator()(const AccT& acc, const MUnit& u, int wr, int wc, int fr, int fq, const LAS float*) const {
        bf16_t* base = t1b + (size_t)(u.pm * 256 + wr * 64 + fr) * DM + u.pn * 256 + wc * 32 + 8 * fq;
        u32x4 xw[2][4][2];
#pragma unroll
        for (int ai = 0; ai < 2; ++ai)
#pragma unroll
            for (int m = 0; m < 4; ++m)
#pragma unroll
                for (int bj = 0; bj < 2; ++bj) xw[ai][m][bj] = *(const u32x4*)(base + (size_t)(ai * 128 + m * 16) * DM + bj * 128);
#pragma unroll
        for (int ai = 0; ai < 2; ++ai)
#pragma unroll
            for (int m = 0; m < 4; ++m) { const int row = u.pm * 256 + ai * 128 + wr * 64 + m * 16 + fr; float s = 0.f, q = 0.f;
#pragma unroll
                for (int bj = 0; bj < 2; ++bj) {
                    const f32x4 t0 = ALPHA * unpack_lo(xw[ai][m][bj]) + acc[ai][bj][m][0], t1 = ALPHA * unpack_hi(xw[ai][m][bj]) + acc[ai][bj][m][1];
                    *(u32x4*)(base + (size_t)(ai * 128 + m * 16) * DM + bj * 128) = pack8(t0, t1); s += sum4(t0) + sum4(t1); q += sq4(t0) + sq4(t1);
                    *(u32x2*)(t1f8 + (size_t)row * DM + u.pn * 256 + wc * 32 + 8 * fq + bj * 128) = pack8_fp8(t0, t1); }
                row_stats_add(st, row, s, q, fq); }
    }
};
struct EpiMq {
    static constexpr bool PERM = true, META = true;
    bf16_t* qm; const stat_t* st; const float *cs, *bs;
    __device__ __forceinline__ mm::Meta meta_load(const MUnit& u, int t) const { const RowStat r = row_stat(st, u.pm * 256 + t); mm::Meta m; m.r0 = r.mean; m.r1 = r.rstd; m.r2 = 0; m.c0 = cs[u.pn * 256 + t]; m.c1 = bs[u.pn * 256 + t]; return m; }
    __device__ __forceinline__ void operator()(const AccT& acc, const MUnit& u, int wr, int wc, int fr, int fq, const LAS float* ms) const {
        float mean[8], rstd[8];
#pragma unroll
        for (int g = 0; g < 8; ++g) { const int rl = (g >> 2) * 128 + wr * 64 + (g & 3) * 16 + fr; mean[g] = ms[rl]; rstd[g] = ms[256 + rl]; }
#pragma unroll
        for (int bj = 0; bj < 2; ++bj) { const int cl = bj * 128 + wc * 32 + 8 * fq, col = u.pn * 256 + cl;
            const f32x4 c0 = *(const LAS f32x4*)(ms + 768 + cl), c1 = *(const LAS f32x4*)(ms + 768 + cl + 4), b0 = *(const LAS f32x4*)(ms + 1024 + cl), b1 = *(const LAS f32x4*)(ms + 1024 + cl + 4);
#pragma unroll
            for (int ai = 0; ai < 2; ++ai)
#pragma unroll
                for (int m = 0; m < 4; ++m) { const int row = u.pm * 256 + ai * 128 + wr * 64 + m * 16 + fr; const float mu = mean[ai * 4 + m], rs = rstd[ai * 4 + m];
                    const f32x4 v0 = rs * (acc[ai][bj][m][0] - mu * c0) + b0, v1 = rs * (acc[ai][bj][m][1] - mu * c1) + b1;
                    *(u32x4*)(qm + (size_t)row * DM + col) = pack8(v0, v1); } }
    }
};
struct EpiMo {
    static constexpr bool PERM = true, META = true;
    const bf16_t* t1b; const stat_t* st1; const float *g1, *b1; bf16_t* t2b; stat_t* st2; unsigned char* t2f8; float asc;
    __device__ __forceinline__ mm::Meta meta_load(const MUnit& u, int t) const { const RowStat r = row_stat(st1, u.pm * 256 + t); mm::Meta m; m.r0 = r.mean; m.r1 = r.rstd; m.r2 = 0; m.c0 = g1[u.pn * 256 + t]; m.c1 = b1[u.pn * 256 + t]; return m; }
    __device__ __forceinline__ void operator()(const AccT& acc, const MUnit& u, int wr, int wc, int fr, int fq, const LAS float* ms) const {
        const size_t off0 = (size_t)(u.pm * 256 + wr * 64 + fr) * DM + u.pn * 256 + wc * 32 + 8 * fq;
        f32x4 gv[2][2], bv[2][2];
#pragma unroll
        for (int bj = 0; bj < 2; ++bj)
#pragma unroll
            for (int hf = 0; hf < 2; ++hf) { const int cl = bj * 128 + wc * 32 + 8 * fq + 4 * hf; gv[bj][hf] = *(const LAS f32x4*)(ms + 768 + cl); bv[bj][hf] = *(const LAS f32x4*)(ms + 1024 + cl); }
#pragma unroll
        for (int ai = 0; ai < 2; ++ai) {
            u32x4 tw[4][2]; float mean[4], rstd[4];
#pragma unroll
            for (int m = 0; m < 4; ++m) { const int rl = ai * 128 + wr * 64 + m * 16 + fr; mean[m] = ms[rl]; rstd[m] = ms[256 + rl];
#pragma unroll
                for (int bj = 0; bj < 2; ++bj) tw[m][bj] = *(const u32x4*)(t1b + off0 + (size_t)(ai * 128 + m * 16) * DM + bj * 128); }
#pragma unroll
            for (int m = 0; m < 4; ++m) { const int row = u.pm * 256 + ai * 128 + wr * 64 + m * 16 + fr; float s = 0.f, q = 0.f;
#pragma unroll
                for (int bj = 0; bj < 2; ++bj) {
                    const f32x4 x0 = (unpack_lo(tw[m][bj]) - mean[m]) * rstd[m] * gv[bj][0] + bv[bj][0], x1 = (unpack_hi(tw[m][bj]) - mean[m]) * rstd[m] * gv[bj][1] + bv[bj][1];
                    const f32x4 t0 = ALPHA * x0 + asc * acc[ai][bj][m][0], t1 = ALPHA * x1 + asc * acc[ai][bj][m][1];
                    *(u32x4*)(t2b + off0 + (size_t)(ai * 128 + m * 16) * DM + bj * 128) = pack8(t0, t1); s += sum4(t0) + sum4(t1); q += sq4(t0) + sq4(t1);
                    *(u32x2*)(t2f8 + off0 + (size_t)(ai * 128 + m * 16) * DM + bj * 128) = pack8_fp8(t0, t1); }
                row_stats_add(st2, row, s, q, fq); }
            asm volatile("" ::: "memory");
        }
    }
};
struct EpiRouter {
    static constexpr bool PERM = false, META = true;
    float* lg; const stat_t* st; const float *cs, *bs;
    __device__ __forceinline__ mm::Meta meta_load(const MUnit& u, int t) const { const RowStat r = row_stat(st, u.pm * 256 + t); mm::Meta m; m.r0 = r.mean; m.r1 = r.rstd; m.r2 = 0; m.c0 = t < 64 ? cs[t] : 0.f; m.c1 = t < 64 ? bs[t] : 0.f; return m; }
    __device__ __forceinline__ void operator()(const AccT& acc, const MUnit& u, int wr, int wc, int fr, int fq, const LAS float* ms) const {
        if (wc < 2) {
#pragma unroll
            for (int n = 0; n < 2; ++n) { const int col = wc * 32 + 16 * n + 4 * fq; const f32x4 c0 = *(const LAS f32x4*)(ms + 768 + col), b0 = *(const LAS f32x4*)(ms + 1024 + col);
#pragma unroll
                for (int ai = 0; ai < 2; ++ai)
#pragma unroll
                    for (int m = 0; m < 4; ++m) { const int rl = ai * 128 + wr * 64 + m * 16 + fr, row = u.pm * 256 + rl;
                        *(f32x4*)(lg + (size_t)row * NLOGP + col) = ms[256 + rl] * (acc[ai][0][m][n] - ms[rl] * c0) + b0; } }
        }
    }
};
constexpr int MOE_TB_OFF = 131072;
__device__ __forceinline__ void moe_tables(const unsigned* CNT, LAS int* tb) {
    if (threadIdx.x < 64) {
        const int e = threadIdx.x, c = e < NEXP ? (int)CNT[e] : 0, nt = (c + 255) / 256;
        int inc = nt;
#pragma unroll
        for (int d = 1; d < 32; d <<= 1) { const int o = __shfl_up(inc, d); if ((e & 31) >= d) inc += o; }
        const int exc = inc - nt;
        if (e < NEXP) { tb[e] = exc * 4; tb[64 + e] = exc * 256; tb[128 + e] = c; }
        if (e == NEXP - 1) tb[32] = inc * 4; }
    __syncthreads();
}
__device__ __forceinline__ int uni(int v) { return __builtin_amdgcn_readfirstlane(v); }
template <class T> __device__ __forceinline__ T* uni_ptr(T* q) { const unsigned long long v = (unsigned long long)q; const unsigned lo = __builtin_amdgcn_readfirstlane((unsigned)v), hi = __builtin_amdgcn_readfirstlane((unsigned)(v >> 32)); return (T*)(((unsigned long long)hi << 32) | lo); }
template <int WHICH> struct SchedMoe {
    const char *A, *B; const int* rowl; LAS int* tb; int G, c;
    __device__ __forceinline__ bool next(int i, MUnit& u) const {
        const int L = i * G + c, T = (L >> 5) * 8 + (L & 7), pn = (L >> 3) & 3; if (4 * T >= uni(tb[32])) return false;
        int e = uni(u.aux) & 31; if (uni(tb[e]) > 4 * T) e = 0;
        while (uni(tb[e + 1]) <= 4 * T) ++e;
        const int tm = T - (uni(tb[e]) >> 2), cnt = uni(tb[128 + e]), rem = cnt - tm * 256, ho = uni(tb[64 + e]);
        u.pm = tm; u.pn = pn; u.aux = e; u.nvalid = rem < 256 ? rem : 256; u.rows = rowl + (size_t)e * CAP + tm * 256;
        if (WHICH == 1) { u.a = A; u.b = B + ((size_t)e * 1024 + pn * 256) * 1024; }
        else { u.a = A + (size_t)(ho + tm * 256) * 512; u.b = B + ((size_t)e * 1024 + pn * 256) * 512; }
        return true;
    }
    __device__ __forceinline__ int row(const MUnit& u, int r) const { return WHICH == 1 ? (u.rows[r < u.nvalid ? r : u.nvalid - 1] >> 1) : r; }
    __device__ __forceinline__ int rowfix(int v) const { return WHICH == 1 ? (v >> 1) : v; }
};
struct EpiMoe1 {
    static constexpr bool PERM = true, META = true;
    bf16_t* H; const f32x4* rowm; const float *csg, *bsg; LAS int* tb;
    __device__ __forceinline__ mm::Meta meta_load(const MUnit& u, int t) const { const int r = t < u.nvalid ? t : u.nvalid - 1; const f32x4 rm = rowm[(size_t)u.aux * CAP + u.pm * 256 + r];
        const int wrow = u.aux * 1024 + u.pn * 256 + t; mm::Meta m; m.r0 = rm[1]; m.r1 = rm[2]; m.r2 = 0; m.c0 = csg[wrow]; m.c1 = bsg[wrow]; return m; }
    __device__ __forceinline__ void operator()(const AccT& acc, const MUnit& u, int wr, int wc, int fr, int fq, const LAS float* ms) const {
        const int e = u.aux, hrow0 = uni(tb[64 + e]) + u.pm * 256, c8 = wc * 32 + 8 * fq;
        f32x4 cg[2], bg[2], cu[2], bu[2];
#pragma unroll
        for (int n = 0; n < 2; ++n) { cg[n] = *(const LAS f32x4*)(ms + 768 + c8 + 4 * n); bg[n] = *(const LAS f32x4*)(ms + 1024 + c8 + 4 * n); cu[n] = *(const LAS f32x4*)(ms + 768 + 128 + c8 + 4 * n); bu[n] = *(const LAS f32x4*)(ms + 1024 + 128 + c8 + 4 * n); }
#pragma unroll
        for (int ai = 0; ai < 2; ++ai)
#pragma unroll
            for (int m = 0; m < 4; ++m) { const int rl = ai * 128 + wr * 64 + m * 16 + fr; const float mu = ms[rl], rs = ms[256 + rl];
                f32x4 hv[2];
#pragma unroll
                for (int n = 0; n < 2; ++n) { const f32x4 g = (rs * (1.0f / W8S)) * (acc[ai][0][m][n] - mu * cg[n]) + bg[n], uu = (rs * (1.0f / W8S)) * (acc[ai][1][m][n] - mu * cu[n]) + bu[n];
#pragma unroll
                    for (int j = 0; j < 4; ++j) hv[n][j] = g[j] * __builtin_amdgcn_rcpf(1.0f + __builtin_amdgcn_exp2f(-LOG2E * g[j])) * uu[j] * H8S; }
                *(u32x2*)((unsigned char*)H + (size_t)(hrow0 + rl) * DEXP + u.pn * 128 + c8) = pack8_fp8(hv[0], hv[1]); }
    }
};
struct EpiMoe2 {
    static constexpr bool PERM = true, META = true, TOUCH = false;
    unsigned char* Y; const f32x4* rowm; unsigned char* dummy;
    __device__ __forceinline__ mm::Meta meta_load(const MUnit& u, int t) const { const int r = t < u.nvalid ? t : u.nvalid - 1; mm::Meta m; m.r0 = rowm[(size_t)u.aux * CAP + u.pm * 256 + r][0] * (Y8S / (W8S * H8S)); m.r1 = 0.f; m.r2 = t < u.nvalid ? u.rows[r] : -1; m.c0 = 0.f; m.c1 = 0.f; return m; }
    __device__ __forceinline__ void operator()(const AccT& acc, const MUnit& u, int wr, int wc, int fr, int fq, const LAS float* ms) const {
#pragma unroll
        for (int ai = 0; ai < 2; ++ai)
#pragma unroll
            for (int m = 0; m < 4; ++m) { const int rl = ai * 128 + wr * 64 + m * 16 + fr; const int a = ((const LAS int*)ms)[512 + rl]; const float g = ms[rl];
                unsigned char* rowp = (a >= 0 ? Y + (size_t)a * DM : dummy) + u.pn * 256 + wc * 32 + 8 * fq;
#pragma unroll
                for (int bj = 0; bj < 2; ++bj) *(u32x2*)(rowp + bj * 128) = pack8_fp8(g * acc[ai][bj][m][0], g * acc[ai][bj][m][1]); }
    }
};
__device__ __forceinline__ void phase_proj_fast(const Params& p, LAS unsigned char* lds) {
    unsigned char* ws = p.ws;
    SchedProj S{(const char*)(ws + WS_XB), (const char*)(ws + WS_WIN), (const char*)(ws + WS_MEMB), (const char*)(ws + WS_WMK), (const char*)(ws + WS_WMV), (int)gridDim.x, (int)blockIdx.x};
    EpiProj E{(bf16_t*)(ws + WS_PROJ), (bf16_t*)(ws + WS_VT), (bf16_t*)(ws + WS_MEMK), (bf16_t*)(ws + WS_MEMVT)};
    mm::gemm_phase<EpiProj, SchedProj, false>(lds, DM, S, E);
}
__device__ __forceinline__ void phase_outproj_fast(const Params& p, LAS unsigned char* lds) {
    unsigned char* ws = p.ws;
    SchedDense S{(const char*)(ws + WS_YMIX), (const char*)(ws + WS_WOUT), NTOK / 256, DM / 256, (int)gridDim.x, (int)blockIdx.x, -1};
    EpiOut E{(bf16_t*)(ws + WS_T1B), (stat_t*)(ws + WS_STATS1), ws + WS_T1F8};
    mm::gemm_phase<EpiOut, SchedDense, false>(lds, DM, S, E);
}
__device__ __forceinline__ void phase_mq_fast(const Params& p, LAS unsigned char* lds) {
    unsigned char* ws = p.ws;
    SchedDense S{(const char*)(ws + WS_T1B), (const char*)(ws + WS_WMQ), NTOK / 256, DM / 256, (int)gridDim.x, (int)blockIdx.x, -1};
    EpiMq E{(bf16_t*)(ws + WS_QM), (const stat_t*)(ws + WS_STATS1), (const float*)(ws + WS_CS1), (const float*)(ws + WS_CS1) + 1024};
    mm::gemm_phase<EpiMq, SchedDense, false>(lds, DM, S, E);
}
__device__ __forceinline__ void phase_mo_fast(const Params& p, LAS unsigned char* lds) {
    unsigned char* ws = p.ws;
    SchedDense S{(const char*)(ws + WS_OB), (const char*)(ws + WS_WMO), NTOK / 256, DM / 256, (int)gridDim.x, (int)blockIdx.x, -1};
    EpiMo E{(const bf16_t*)(ws + WS_T1B), (const stat_t*)(ws + WS_STATS1), p.ln1_g, p.ln1_b, (bf16_t*)(ws + WS_T2B), (stat_t*)(ws + WS_STATS2), ws + WS_T2F8, 1.0f};
    mm::gemm_phase<EpiMo, SchedDense, false>(lds, DM, S, E);
}
__device__ __forceinline__ void phase_router_fast(const Params& p, LAS unsigned char* lds, const int rowpm = -1) {
    unsigned char* ws = p.ws;
    SchedDense S{(const char*)(ws + WS_T2B), (const char*)(ws + WS_WRT), NTOK / 256, 1, (int)gridDim.x, (int)blockIdx.x, rowpm};
    EpiRouter E{(float*)(ws + WS_LOGIT), (const stat_t*)(ws + WS_STATS2), (const float*)(ws + WS_CS2), (const float*)(ws + WS_CS2) + 64};
    mm::gemm_phase<EpiRouter, SchedDense, false>(lds, DM, S, E);
    if (gridDim.x == NTOK / 256) { int pm, pn; mm::order_map((int)blockIdx.x, NTOK / 256, 1, pm, pn); if (rowpm >= 0) pm = rowpm; asm volatile("s_waitcnt vmcnt(0)" ::: "memory"); __syncthreads(); phase_route(p, (unsigned char*)lds, pm * 256); }
}
__device__ __forceinline__ void phase_moe1_fast(const Params& p, LAS unsigned char* lds) {
    unsigned char* ws = p.ws; LAS int* tb = (LAS int*)(lds + MOE_TB_OFF);
    moe_tables((const unsigned*)(ws + WS_CNT), tb);
    SchedMoe<1> S{(const char*)(ws + WS_T2F8), (const char*)(ws + WS_WGU), (const int*)(ws + WS_ROWL), tb, (int)gridDim.x, (int)blockIdx.x};
    EpiMoe1 E{(bf16_t*)(ws + WS_H), (const f32x4*)p.out, (const float*)(ws + WS_CSGU), (const float*)(ws + WS_CSGU) + NEXP * 1024, tb};
    mm::gemm_phase<EpiMoe1, SchedMoe<1>, true, true>(lds, DM / 2, S, E);
}
__device__ __forceinline__ void phase_moe2_fast(const Params& p, LAS unsigned char* lds) {
    unsigned char* ws = p.ws; LAS int* tb = (LAS int*)(lds + MOE_TB_OFF);
    moe_tables((const unsigned*)(ws + WS_CNT), tb);
    SchedMoe<2> S{(const char*)(ws + WS_H), (const char*)(ws + WS_WD), (const int*)(ws + WS_ROWL), tb, (int)gridDim.x, (int)blockIdx.x};
    EpiMoe2 E{ws + WS_Y, (const f32x4*)p.out, ws + WS_H + 100 * MiB};
#ifndef STAG10
#define STAG10 0
#endif
    if (STAG10 > 0 && (blockIdx.x & 8)) { const unsigned long long t0 = __builtin_amdgcn_s_memrealtime(); while (__builtin_amdgcn_s_memrealtime() - t0 < (unsigned long long)STAG10) __builtin_amdgcn_s_sleep(8); }
    const int k2 = DEXP / 2;
    mm::gemm_phase<EpiMoe2, SchedMoe<2>, false, true>(lds, k2, S, E, 0, PROBE_SEC >= 0);
}


struct SchedFold {
    const char *memk, *memv, *wqp, *wmot; int G, c;
    __device__ __forceinline__ bool next(int i, MUnit& u) const {
        const int L = i * G + c; if (L >= 1024) return false;
        const int job = L >> 9, l = L & 511, b = l >> 4, h = (l >> 2) & 3, t = l & 3;
        u.aux = job; u.nvalid = 256; u.rows = nullptr;
        if (job == 0) { u.pm = b * 4 + h; u.pn = t; u.a = memk + ((size_t)(b * 256) * 1024 + h * 256) * 2; u.b = wqp + ((size_t)(t * 256) * 1024 + h * 256) * 2; }
        else { u.pm = b * 4 + t; u.pn = h; u.a = wmot + ((size_t)(t * 256) * 1024 + h * 256) * 2; u.b = memv + ((size_t)(b * 256) * 1024 + h * 256) * 2; }
        return true;
    }
    __device__ __forceinline__ int row(const MUnit&, int r) const { return r; }
};
struct EpiFold {
    static constexpr bool PERM = true, META = false;
    unsigned char *wqk, *vwt; stat_t* csb;
    __device__ __forceinline__ mm::Meta meta_load(const MUnit&, int) const { return mm::Meta{}; }
    __device__ __forceinline__ void operator()(const AccT& acc, const MUnit& u, int wr, int wc, int fr, int fq, const LAS float*) const {
        unsigned char* O = u.aux == 0 ? wqk : vwt;
#pragma unroll
        for (int ai = 0; ai < 2; ++ai)
#pragma unroll
            for (int m = 0; m < 4; ++m) { const int row = u.pm * 256 + ai * 128 + wr * 64 + m * 16 + fr; float sum = 0.f;
#pragma unroll
                for (int bj = 0; bj < 2; ++bj) { const u32x2 w = pack8_fp8(acc[ai][bj][m][0] * W8S, acc[ai][bj][m][1] * W8S); *(u32x2*)(O + (size_t)row * DM + u.pn * 256 + bj * 128 + wc * 32 + 8 * fq) = w;
                    sum += ((__builtin_amdgcn_cvt_f32_fp8((int)w.x, 0) + __builtin_amdgcn_cvt_f32_fp8((int)w.x, 1)) + (__builtin_amdgcn_cvt_f32_fp8((int)w.x, 2) + __builtin_amdgcn_cvt_f32_fp8((int)w.x, 3)))
                         + ((__builtin_amdgcn_cvt_f32_fp8((int)w.y, 0) + __builtin_amdgcn_cvt_f32_fp8((int)w.y, 1)) + (__builtin_amdgcn_cvt_f32_fp8((int)w.y, 2) + __builtin_amdgcn_cvt_f32_fp8((int)w.y, 3))); }
                if (u.aux == 0) { sum += __shfl_xor(sum, 16); sum += __shfl_xor(sum, 32); if (fq == 0) atomicAdd((unsigned long long*)csb + row, (unsigned long long)__float2ll_rn(sum * (CS_SCALE / W8S))); } }
    }
};
__device__ __forceinline__ void phase_fold(const Params& p, LAS unsigned char* lds) {
    unsigned char* ws = p.ws;
    SchedFold S{(const char*)(ws + WS_MEMK), (const char*)(ws + WS_MEMV), (const char*)(ws + WS_WQP), (const char*)(ws + WS_WMO), (int)gridDim.x, (int)blockIdx.x};
    EpiFold E{ws + WS_WQK, ws + WS_VWT, (stat_t*)(ws + WS_CSB)};
    mm::gemm_phase<EpiFold, SchedFold, false>(lds, 256, S, E, 1024);
    const int lane = threadIdx.x & 63, gw = blockIdx.x * 8 + (threadIdx.x >> 6), NGW = gridDim.x * 8;
    const bf16_t* MK = (const bf16_t*)(ws + WS_MEMK); const stat_t* bqi = (const stat_t*)(ws + WS_CSI) + 1024; float* bsb = (float*)(ws + WS_BSB);
    for (int o0 = gw; o0 < NB * 1024; o0 += 8 * NGW) {
        u32x2 kv[8]; f32x4 bv[8];
#pragma unroll
        for (int j = 0; j < 8; ++j) { const int o = o0 + j * NGW, oc = o < NB * 1024 ? o : gw, b = oc >> 10, hk = oc & 1023, h = hk >> 8, key = hk & 255;
            kv[j] = *(const u32x2*)(MK + (size_t)(b * 256 + key) * DM + h * 256 + 4 * lane);
#pragma unroll
            for (int e = 0; e < 4; ++e) bv[j][e] = (float)bqi[h * 256 + 4 * lane + e] * CS_INV; }
#pragma unroll
        for (int j = 0; j < 8; ++j) { const int o = o0 + j * NGW;
            float d = bv[j][0] * __uint_as_float(kv[j].x << 16) + bv[j][1] * __uint_as_float(kv[j].x & 0xffff0000u) + bv[j][2] * __uint_as_float(kv[j].y << 16) + bv[j][3] * __uint_as_float(kv[j].y & 0xffff0000u);
            d = wave_sum(d); if (lane == 0 && o < NB * 1024) bsb[o] = d; } }
}
template <int RB = 2048> struct SchedBatchB {
    const char *A, *B; int G, c, rowpm;
    __device__ __forceinline__ bool next(int i, MUnit& u) const {
        int pm, pn;
        if (rowpm >= 0) { if (i >= 4) return false; pm = rowpm; pn = i; }
        else { const int L = i * G + c; if (L >= (NTOK / 256) * 4) return false; mm::order_map(L, NTOK / 256, 4, pm, pn); }
        u.pm = pm; u.pn = pn; u.aux = 0; u.nvalid = 256; u.rows = nullptr;
        u.a = A + (size_t)pm * 256 * RB; u.b = B + ((size_t)(pm >> 3) * 1024 + pn * 256) * RB; return true;
    }
    __device__ __forceinline__ int row(const MUnit&, int r) const { return r; }
};
struct EpiSoftmax {
    static constexpr bool PERM = true, META = true;
    unsigned char* pb; const stat_t* st; const stat_t* csb; const float* bsb; LAS unsigned char* ldsx;
    __device__ __forceinline__ mm::Meta meta_load(const MUnit& u, int t) const { const RowStat r = row_stat(st, u.pm * 256 + t); const int n = (u.pm >> 3) * 1024 + u.pn * 256 + t;
        mm::Meta m; m.r0 = r.mean; m.r1 = r.rstd; m.r2 = 0; m.c0 = (float)csb[n] * CS_INV; m.c1 = bsb[n]; return m; }
    __device__ __forceinline__ void operator()(const AccT& acc, const MUnit& u, int wr, int wc, int fr, int fq, const LAS float* ms) const {
        LAS float* xq = (LAS float*)ldsx;
        f32x4 v[2][4][2][2];
        float mx[8];
#pragma unroll
        for (int bj = 0; bj < 2; ++bj) { const int cl = bj * 128 + wc * 32 + 8 * fq;
            const f32x4 c0 = *(const LAS f32x4*)(ms + 768 + cl), c1 = *(const LAS f32x4*)(ms + 768 + cl + 4), b0 = *(const LAS f32x4*)(ms + 1024 + cl), b1 = *(const LAS f32x4*)(ms + 1024 + cl + 4);
#pragma unroll
            for (int ai = 0; ai < 2; ++ai)
#pragma unroll
                for (int m = 0; m < 4; ++m) { const int rl = ai * 128 + wr * 64 + m * 16 + fr; const float mu = ms[rl], rs = ms[256 + rl];
                    v[ai][m][bj][0] = rs * (acc[ai][bj][m][0] * (1.0f / W8S) - mu * c0) + b0; v[ai][m][bj][1] = rs * (acc[ai][bj][m][1] * (1.0f / W8S) - mu * c1) + b1; } }
#pragma unroll
        for (int g = 0; g < 8; ++g) { float a = -INFINITY;
#pragma unroll
            for (int bj = 0; bj < 2; ++bj)
#pragma unroll
                for (int hf = 0; hf < 2; ++hf) { const f32x4 x = v[g >> 2][g & 3][bj][hf]; a = fmaxf(fmaxf(a, fmaxf(x[0], x[1])), fmaxf(x[2], x[3])); }
            a = fmaxf(a, __shfl_xor(a, 16)); a = fmaxf(a, __shfl_xor(a, 32)); mx[g] = a;
            if (fq == 0) xq[((g >> 2) * 128 + wr * 64 + (g & 3) * 16 + fr) * 4 + wc] = a; }
        asm volatile("s_waitcnt lgkmcnt(0)" ::: "memory"); __builtin_amdgcn_s_barrier(); asm volatile("" ::: "memory");
        float sm[8];
#pragma unroll
        for (int g = 0; g < 8; ++g) { const f32x4 q = *(const LAS f32x4*)(xq + ((g >> 2) * 128 + wr * 64 + (g & 3) * 16 + fr) * 4); const float M = fmaxf(fmaxf(q[0], q[1]), fmaxf(q[2], q[3])); float sacc = 0.f;
#pragma unroll
            for (int bj = 0; bj < 2; ++bj)
#pragma unroll
                for (int hf = 0; hf < 2; ++hf) { f32x4 x = v[g >> 2][g & 3][bj][hf];
#pragma unroll
                    for (int j = 0; j < 4; ++j) { x[j] = __builtin_amdgcn_exp2f(x[j] - M); sacc += x[j]; }
                    v[g >> 2][g & 3][bj][hf] = x; }
            sacc += __shfl_xor(sacc, 16); sacc += __shfl_xor(sacc, 32); sm[g] = sacc; }
        asm volatile("s_waitcnt lgkmcnt(0)" ::: "memory"); __builtin_amdgcn_s_barrier(); asm volatile("" ::: "memory");
#pragma unroll
        for (int g = 0; g < 8; ++g) if (fq == 0) xq[((g >> 2) * 128 + wr * 64 + (g & 3) * 16 + fr) * 4 + wc] = sm[g];
        asm volatile("s_waitcnt lgkmcnt(0)" ::: "memory"); __builtin_amdgcn_s_barrier(); asm volatile("" ::: "memory");
#pragma unroll
        for (int g = 0; g < 8; ++g) { const f32x4 q = *(const LAS f32x4*)(xq + ((g >> 2) * 128 + wr * 64 + (g & 3) * 16 + fr) * 4); const float inv = P8S * __builtin_amdgcn_rcpf((q[0] + q[1]) + (q[2] + q[3]));
            const int row = u.pm * 256 + (g >> 2) * 128 + wr * 64 + (g & 3) * 16 + fr;
#pragma unroll
            for (int bj = 0; bj < 2; ++bj) *(u32x2*)(pb + (size_t)row * DM + u.pn * 256 + bj * 128 + wc * 32 + 8 * fq) = pack8_fp8(v[g >> 2][g & 3][bj][0] * inv, v[g >> 2][g & 3][bj][1] * inv); }
        asm volatile("s_waitcnt lgkmcnt(0)" ::: "memory"); __builtin_amdgcn_s_barrier(); asm volatile("" ::: "memory");
    }
};
__device__ __forceinline__ void phase_scores_fast(const Params& p, LAS unsigned char* lds, const int rowpm = -1) {
    unsigned char* ws = p.ws;
    SchedBatchB<1024> S{(const char*)(ws + WS_T1F8), (const char*)(ws + WS_WQK), (int)gridDim.x, (int)blockIdx.x, rowpm};
    EpiSoftmax E{ws + WS_OB, (const stat_t*)(ws + WS_STATS1), (const stat_t*)(ws + WS_CSB), (const float*)(ws + WS_BSB), lds + 133120};
    mm::gemm_phase<EpiSoftmax, SchedBatchB<1024>, false, true>(lds, DM / 2, S, E);
}
__device__ __forceinline__ void phase_mo_fold(const Params& p, LAS unsigned char* lds, const int rowpm = -1) {
    unsigned char* ws = p.ws;
    SchedBatchB<1024> S{(const char*)(ws + WS_OB), (const char*)(ws + WS_VWT), (int)gridDim.x, (int)blockIdx.x, rowpm};
    EpiMo E{(const bf16_t*)(ws + WS_T1B), (const stat_t*)(ws + WS_STATS1), p.ln1_g, p.ln1_b, (bf16_t*)(ws + WS_T2B), (stat_t*)(ws + WS_STATS2), ws + WS_T2F8, 1.0f / (P8S * W8S)};
    mm::gemm_phase<EpiMo, SchedBatchB<1024>, false, true>(lds, DM / 2, S, E);
}

constexpr int SB_LDS_WAVE = 18432, SB_KROW = 144, SB_VROW = 136;
__device__ __forceinline__ float fexp2(float x) { return __builtin_amdgcn_exp2f(x); }
__device__ __forceinline__ float flog2(float x) { return __builtin_amdgcn_logf(x); }

template <bool MASK>
__device__ __forceinline__ void sb_scan(f32x16 (&pp)[2], float& R, const int kb, const int lim, const int hi) {
    float gp[8];
#pragma unroll
    for (int a = 0; a < 8; ++a) {
        float be[4], om[4];
#pragma unroll
        for (int i = 0; i < 4; ++i) { const float sc = __builtin_amdgcn_fmed3f(pp[a >> 2][4 * (a & 3) + i], -80.f, 80.f);
            const float e = fexp2(-sc); be[i] = __builtin_amdgcn_rcpf(1.0f + e); om[i] = e * be[i];
            if (MASK) { const int kv = kb + 8 * a + 4 * hi + i; if (!(kv < lim)) { be[i] = 0.f; om[i] = 1.f; } } }
        const float s23 = om[2] * om[3], s123 = om[1] * s23;
        pp[a >> 2][4 * (a & 3) + 3] = be[3];
        pp[a >> 2][4 * (a & 3) + 2] = be[2] * om[3];
        pp[a >> 2][4 * (a & 3) + 1] = be[1] * s23;
        pp[a >> 2][4 * (a & 3) + 0] = be[0] * s123;
        gp[a] = om[0] * s123;
        if (a < 7) { const int an = a + 1;
            asm volatile("" : "+v"(gp[a]), "+v"(pp[an >> 2][4 * (an & 3) + 0]), "+v"(pp[an >> 2][4 * (an & 3) + 1]), "+v"(pp[an >> 2][4 * (an & 3) + 2]), "+v"(pp[an >> 2][4 * (an & 3) + 3])); }
    }
    float base[8];
    {
        float ev[8], od[8];
#pragma unroll
        for (int a = 0; a < 8; ++a) { const unsigned own = __float_as_uint(gp[a]); auto rr = __builtin_amdgcn_permlane32_swap(own, own, false, false);
            const float other = __uint_as_float(rr[0] == own ? rr[1] : rr[0]);
            ev[a] = hi ? other : gp[a]; od[a] = hi ? gp[a] : other; }
        float run = R;
#pragma unroll
        for (int a = 7; a >= 0; --a) { const float b_od = run; run *= od[a]; const float b_ev = run; run *= ev[a]; base[a] = hi ? b_od : b_ev; }
        R = run;
    }
#pragma unroll
    for (int a = 0; a < 8; ++a)
#pragma unroll
        for (int i = 0; i < 4; ++i) pp[a >> 2][4 * (a & 3) + i] *= base[a];
}

constexpr int SB_SLOT = 64 * SB_KROW + 64 * SB_VROW  , SB_NSLOT = 7, SB_GAIN_OFF = SB_NSLOT * SB_SLOT;
__device__ __forceinline__ void phase_sb_fast(const Params& p, LAS unsigned char* lds) {
    unsigned char* ws = p.ws; const int lane = threadIdx.x & 63, wave = __builtin_amdgcn_readfirstlane(threadIdx.x >> 6), r32 = lane & 31, hi = lane >> 5;
    const bf16_t* PROJ = (const bf16_t*)(ws + WS_PROJ); const bf16_t* VT = (const bf16_t*)(ws + WS_VT); bf16_t* YMIX = (bf16_t*)(ws + WS_YMIX);
    const int srow = lane >> 3, sch = lane & 7;
    const unsigned koff = (unsigned)(srow * NPROJ + 8 * sch) * 2u, voff = (unsigned)(srow * VT_LD + 8 * sch) * 2u;
    constexpr int NGRP = NB * NHEAD * (SEQ / 256);
    LAS unsigned char* myslot = lds + wave * SB_SLOT;
    LAS float* gl = (LAS float*)(lds + SB_GAIN_OFF);
    LAS float* cwl = (LAS float*)(lds + SB_GAIN_OFF + 256);
    for (int i = threadIdx.x; i < 2048; i += 512) cwl[i] = i < 1536 ? p.conv_w[i] : p.gn_conv[i - 1536];
    u32x4 kst[8], vst[8]; bf16x8 qf[4];
#define SB_LOADT(Kg_, Vg_, kbx) do { const char* kt_ = (const char*)((Kg_) + (size_t)(kbx) * NPROJ); const char* vt_ = (const char*)((Vg_) + (kbx)); \
        _Pragma("unroll") for (int i = 0; i < 8; ++i) { kst[i] = *(const u32x4*)(kt_ + (size_t)i * (8 * NPROJ * 2) + koff); vst[i] = *(const u32x4*)(vt_ + (size_t)i * (8 * VT_LD * 2) + voff); } } while (0)
#define SB_WRITET(kl_) do { _Pragma("unroll") for (int i = 0; i < 8; ++i) { *(LAS u32x4*)((kl_) + (srow + 8 * i) * SB_KROW + 16 * sch) = kst[i]; \
        *(LAS u32x2*)((kl_) + 64 * SB_KROW + (srow + 8 * i) * SB_VROW + 16 * sch) = (u32x2){vst[i].x, vst[i].y}; *(LAS u32x2*)((kl_) + 64 * SB_KROW + (srow + 8 * i) * SB_VROW + 16 * sch + 8) = (u32x2){vst[i].z, vst[i].w}; } } while (0)
#define SB_GROUP(g_, b_, h_, q0_, Kg_, Vg_) do { const int bh_ = (g_) >> 3; b_ = bh_ >> 3; h_ = bh_ & 7; q0_ = ((g_) & 7) * 256; \
        Kg_ = PROJ + (size_t)(b_ * SEQ) * NPROJ + C_K + h_ * 64; Vg_ = VT + (size_t)(h_ * 64) * VT_LD + b_ * SEQ; } while (0)
#define SB_LOADQ(dst, b_, h_, r0_) do { const bf16_t* qp_ = PROJ + (size_t)(b_ * SEQ + r0_ + r32) * NPROJ + C_Q + h_ * 64 + 8 * hi; \
        _Pragma("unroll") for (int d0 = 0; d0 < 4; ++d0) dst[d0] = *(const bf16x8*)(qp_ + 16 * d0); } while (0)
    int g = blockIdx.x, b = 0, h = 0, q0 = 0; const bf16_t* Kg = PROJ; const bf16_t* Vg = VT;
    if (g < NGRP) { SB_GROUP(g, b, h, q0, Kg, Vg); SB_LOADQ(qf, b, h, q0 + 32 * wave); const int tl = (q0 >> 6) + 3 - wave; if (wave < SB_NSLOT && tl >= 0) SB_LOADT(Kg, Vg, 64 * tl); }
    while (g < NGRP) {
        const int ttop = (q0 >> 6) + 3, r0 = q0 + 32 * wave;
        if (wave < SB_NSLOT && ttop - wave >= 0) SB_WRITET(myslot);
        if (wave == 7) gl[lane] = p.gn_sb[h * 64 + lane];
        asm volatile("s_waitcnt vmcnt(0) lgkmcnt(0)" ::: "memory");
        asm volatile("" : "+v"(qf[0]), "+v"(qf[1]), "+v"(qf[2]), "+v"(qf[3]));
        __builtin_amdgcn_s_barrier();
        asm volatile("" ::: "memory");
        const int gn = g + gridDim.x; const int bc = b, hc = h; const bf16_t* Kc = Kg; const bf16_t* Vc = Vg; bf16x8 qn[4];
        if (gn < NGRP) { SB_GROUP(gn, b, h, q0, Kg, Vg); SB_LOADQ(qn, b, h, q0 + 32 * wave); const int tl = (q0 >> 6) + 3 - wave; if (wave < SB_NSLOT && tl >= 0) SB_LOADT(Kg, Vg, 64 * tl); }
        f32x16 o[2];
#pragma unroll
        for (int r = 0; r < 16; ++r) { o[0][r] = 0.f; o[1][r] = 0.f; }
        float R = 1.0f;
        for (int T = (r0 + 31) >> 6, j = 0; T >= 0; --T, ++j) {
            const int kb = 64 * T, si = ttop - T;
            f32x16 pp[2];
#pragma unroll
            for (int r = 0; r < 16; ++r) { pp[0][r] = 0.f; pp[1][r] = 0.f; }
            const LAS unsigned char* kl = lds + si * SB_SLOT;
            if (si < SB_NSLOT) {
#pragma unroll
                for (int half = 0; half < 2; ++half)
#pragma unroll
                    for (int d0 = 0; d0 < 4; ++d0) { const bf16x8 kf = *(const LAS bf16x8*)(kl + (32 * half + r32) * SB_KROW + 32 * d0 + 16 * hi); pp[half] = MFMA32(kf, qf[d0], pp[half]); }
            } else {
#pragma unroll
                for (int half = 0; half < 2; ++half)
#pragma unroll
                    for (int d0 = 0; d0 < 4; ++d0) { const bf16x8 kf = *(const bf16x8*)(Kc + (size_t)(kb + 32 * half + r32) * NPROJ + 16 * d0 + 8 * hi); pp[half] = MFMA32(kf, qf[d0], pp[half]); }
            }
            __builtin_amdgcn_sched_barrier(0);
            if (j == 0) sb_scan<true>(pp, R, kb, r0 + r32, hi); else sb_scan<false>(pp, R, kb, r0 + r32, hi);
            __builtin_amdgcn_sched_barrier(0);
            u32x4 pw[4];
#pragma unroll
            for (int ks = 0; ks < 4; ++ks) {
                pw[ks].x = mm::cvt_pk_bf16(pp[ks >> 1][8 * (ks & 1) + 0], pp[ks >> 1][8 * (ks & 1) + 1]); pw[ks].y = mm::cvt_pk_bf16(pp[ks >> 1][8 * (ks & 1) + 2], pp[ks >> 1][8 * (ks & 1) + 3]);
                pw[ks].z = mm::cvt_pk_bf16(pp[ks >> 1][8 * (ks & 1) + 4], pp[ks >> 1][8 * (ks & 1) + 5]); pw[ks].w = mm::cvt_pk_bf16(pp[ks >> 1][8 * (ks & 1) + 6], pp[ks >> 1][8 * (ks & 1) + 7]); }
            if (si < SB_NSLOT) {
#pragma unroll
                for (int ks = 0; ks < 4; ++ks)
#pragma unroll
                    for (int dh = 0; dh < 2; ++dh) { const LAS unsigned char* vp = kl + 64 * SB_KROW + (32 * dh + r32) * SB_VROW + 32 * ks + 8 * hi;
                        const u32x2 lo = *(const LAS u32x2*)vp, hh = *(const LAS u32x2*)(vp + 16); const u32x4 vf = {lo.x, lo.y, hh.x, hh.y};
                        o[dh] = MFMA32(__builtin_bit_cast(bf16x8, vf), __builtin_bit_cast(bf16x8, pw[ks]), o[dh]); }
            } else {
#pragma unroll
                for (int ks = 0; ks < 4; ++ks)
#pragma unroll
                    for (int dh = 0; dh < 2; ++dh) { const bf16_t* vp = Vc + (size_t)(32 * dh + r32) * VT_LD + kb + 16 * ks + 4 * hi;
                        const u32x2 lo = *(const u32x2*)vp, hh = *(const u32x2*)(vp + 8); const u32x4 vf = {lo.x, lo.y, hh.x, hh.y};
                        o[dh] = MFMA32(__builtin_bit_cast(bf16x8, vf), __builtin_bit_cast(bf16x8, pw[ks]), o[dh]); }
            }
            if (__all(R == 0.0f)) break;
        }
        bf16_t* yp = YMIX + (size_t)(bc * SEQ + r0 + r32) * DM + 512 + hc * 64 + 4 * hi;
        f32x4 gv[2][4];
#pragma unroll
        for (int dh = 0; dh < 2; ++dh)
#pragma unroll
            for (int g4 = 0; g4 < 4; ++g4) gv[dh][g4] = *(const LAS f32x4*)(gl + 4 * hi + 32 * dh + 8 * g4);
        float ss = 0.f;
#pragma unroll
        for (int r = 0; r < 16; ++r) ss += o[0][r] * o[0][r] + o[1][r] * o[1][r];
        ss += __shfl_xor(ss, 32);
        const float rn = __builtin_amdgcn_rsqf(ss * (1.f / 64.f) + RMS_EPS);
#pragma unroll
        for (int dh = 0; dh < 2; ++dh)
#pragma unroll
            for (int g4 = 0; g4 < 4; ++g4) { const f32x4 gg = gv[dh][g4];
                u32x2 w; w.x = mm::cvt_pk_bf16(o[dh][4 * g4] * rn * gg[0], o[dh][4 * g4 + 1] * rn * gg[1]); w.y = mm::cvt_pk_bf16(o[dh][4 * g4 + 2] * rn * gg[2], o[dh][4 * g4 + 3] * rn * gg[3]);
                *(u32x2*)(yp + 32 * dh + 8 * g4) = w; }
#pragma unroll
        for (int d0 = 0; d0 < 4; ++d0) qf[d0] = qn[d0];
        { const int ci = g * 8 + wave, tok0 = 4 * ci, t0 = tok0 & (SEQ - 1), c0 = 8 * lane;
          u32x4 cw_[6], hw_[6], bw_[4];
#pragma unroll
          for (int i = 0; i < 6; ++i) { const int tk = (t0 == 0 && i < 2) ? tok0 : tok0 - 2 + i; const bf16_t* row = PROJ + (size_t)tk * NPROJ + c0; cw_[i] = *(const u32x4*)(row + C_CC); hw_[i] = *(const u32x4*)(row + C_CH); if (i >= 2) bw_[i - 2] = *(const u32x4*)(row + C_CB); }
          f32x4 w0l = *(const LAS f32x4*)(cwl + c0), w0h = *(const LAS f32x4*)(cwl + c0 + 4), w1l = *(const LAS f32x4*)(cwl + 512 + c0), w1h = *(const LAS f32x4*)(cwl + 512 + c0 + 4);
          f32x4 w2l = *(const LAS f32x4*)(cwl + 1024 + c0), w2h = *(const LAS f32x4*)(cwl + 1024 + c0 + 4), gl_ = *(const LAS f32x4*)(cwl + 1536 + c0), gh_ = *(const LAS f32x4*)(cwl + 1536 + c0 + 4);
          f32x4 ul[6], uh[6];
#pragma unroll
          for (int i = 0; i < 6; ++i) { ul[i] = unpack_lo(cw_[i]) * unpack_lo(hw_[i]); uh[i] = unpack_hi(cw_[i]) * unpack_hi(hw_[i]); if (t0 == 0 && i < 2) { ul[i] = ul[i] * 0.f; uh[i] = uh[i] * 0.f; } }
#pragma unroll
          for (int i = 0; i < 4; ++i) {
              const f32x4 yl = unpack_lo(bw_[i]) * (w0l * ul[i] + w1l * ul[i + 1] + w2l * ul[i + 2]), yh = unpack_hi(bw_[i]) * (w0h * uh[i] + w1h * uh[i + 1] + w2h * uh[i + 2]);
              float ssq = sq4(yl) + sq4(yh); ssq += __shfl_xor(ssq, 1); ssq += __shfl_xor(ssq, 2); ssq += __shfl_xor(ssq, 4);
              const float rnc = __builtin_amdgcn_rsqf(ssq * (1.f / 64.f) + RMS_EPS);
              *(u32x4*)(YMIX + (size_t)(tok0 + i) * DM + c0) = pack8(yl * rnc * gl_, yh * rnc * gh_); } }
        g = gn;
        asm volatile("s_waitcnt lgkmcnt(0)" ::: "memory");
        __builtin_amdgcn_s_barrier();
        asm volatile("" ::: "memory");
    }
#undef SB_LOADT
#undef SB_WRITET
#undef SB_GROUP
#undef SB_LOADQ
}
__device__ __forceinline__ void phase_conv_fast(const Params& p) {
    unsigned char* ws = p.ws; const int lane = threadIdx.x & 63, wave = threadIdx.x >> 6; const int gw = blockIdx.x * 8 + wave, NGW = gridDim.x * 8;
    const bf16_t* PROJ = (const bf16_t*)(ws + WS_PROJ); bf16_t* YMIX = (bf16_t*)(ws + WS_YMIX);
    const int c0 = 8 * lane;
    float w0[8], w1[8], w2[8], gn[8];
#pragma unroll
    for (int e = 0; e < 8; ++e) { w0[e] = p.conv_w[c0 + e]; w1[e] = p.conv_w[512 + c0 + e]; w2[e] = p.conv_w[1024 + c0 + e]; gn[e] = p.gn_conv[c0 + e]; }
    constexpr int TCH = 16;
    for (int it = gw; it < NTOK / TCH; it += NGW) {
        const int tok0 = it * TCH, t0 = tok0 % SEQ;
        float um2[8], um1[8];
#pragma unroll
        for (int e = 0; e < 8; ++e) { um2[e] = 0.f; um1[e] = 0.f; }
        if (t0 >= 2) {
            const u32x4 a2 = *(const u32x4*)(PROJ + (size_t)(tok0 - 2) * NPROJ + C_CC + c0), h2 = *(const u32x4*)(PROJ + (size_t)(tok0 - 2) * NPROJ + C_CH + c0);
            const u32x4 a1 = *(const u32x4*)(PROJ + (size_t)(tok0 - 1) * NPROJ + C_CC + c0), h1 = *(const u32x4*)(PROJ + (size_t)(tok0 - 1) * NPROJ + C_CH + c0);
            const f32x4 a2l = unpack_lo(a2), a2h = unpack_hi(a2), h2l = unpack_lo(h2), h2h = unpack_hi(h2), a1l = unpack_lo(a1), a1h = unpack_hi(a1), h1l = unpack_lo(h1), h1h = unpack_hi(h1);
#pragma unroll
            for (int e = 0; e < 4; ++e) { um2[e] = a2l[e] * h2l[e]; um2[4 + e] = a2h[e] * h2h[e]; um1[e] = a1l[e] * h1l[e]; um1[4 + e] = a1h[e] * h1h[e]; }
        }
#pragma unroll 1
        for (int i0 = 0; i0 < TCH; i0 += 4) {
            u32x4 bw[4], cw[4], hw[4];
#pragma unroll
            for (int i = 0; i < 4; ++i) { const bf16_t* row = PROJ + (size_t)(tok0 + i0 + i) * NPROJ + c0; bw[i] = *(const u32x4*)(row + C_CB); cw[i] = *(const u32x4*)(row + C_CC); hw[i] = *(const u32x4*)(row + C_CH); }
#pragma unroll
            for (int i = 0; i < 4; ++i) {
                const f32x4 bl = unpack_lo(bw[i]), bh_ = unpack_hi(bw[i]), cl = unpack_lo(cw[i]), ch_ = unpack_hi(cw[i]), hl = unpack_lo(hw[i]), hh = unpack_hi(hw[i]);
                float y[8], ss = 0.f;
#pragma unroll
                for (int e = 0; e < 8; ++e) { const float u = (e < 4 ? cl[e & 3] * hl[e & 3] : ch_[e & 3] * hh[e & 3]); const float bb = e < 4 ? bl[e & 3] : bh_[e & 3];
                    y[e] = bb * (w0[e] * um2[e] + w1[e] * um1[e] + w2[e] * u); um2[e] = um1[e]; um1[e] = u; ss += y[e] * y[e]; }
                ss += __shfl_xor(ss, 1); ss += __shfl_xor(ss, 2); ss += __shfl_xor(ss, 4);
                const float rn = __builtin_amdgcn_rsqf(ss * (1.f / 64.f) + RMS_EPS);
                f32x4 ol, oh;
#pragma unroll
                for (int e = 0; e < 4; ++e) { ol[e] = y[e] * rn * gn[e]; oh[e] = y[4 + e] * rn * gn[4 + e]; }
                *(u32x4*)(YMIX + (size_t)(tok0 + i0 + i) * DM + c0) = pack8(ol, oh);
            }
        }
    }
}
constexpr int XA_KROW = 528, XA_VROW = 528;
__device__ __forceinline__ void phase_xattn_fast(const Params& p, LAS unsigned char* lds) {
    unsigned char* ws = p.ws; const int tid = threadIdx.x, lane = tid & 63, wave = __builtin_amdgcn_readfirstlane(tid >> 6), r32 = lane & 31, hi = lane >> 5;
    const bf16_t* QM = (const bf16_t*)(ws + WS_QM); const bf16_t* MK = (const bf16_t*)(ws + WS_MEMK); const bf16_t* MVT = (const bf16_t*)(ws + WS_MEMVT); bf16_t* OB = (bf16_t*)(ws + WS_OB);
    const int G = gridDim.x, vcu = (G % 8 == 0) ? ((int)blockIdx.x % 8) * (G / 8) + (int)blockIdx.x / 8 : (int)blockIdx.x;
#define XA_BAR() do { asm volatile("s_waitcnt lgkmcnt(0)" ::: "memory"); __builtin_amdgcn_s_barrier(); asm volatile("" ::: "memory"); } while (0)
#define XA_LOADK(Kg_) do { _Pragma("unroll") for (int i = 0; i < 16; ++i) { const int c = tid + 512 * i; st[i] = *(const u32x4*)((Kg_) + (size_t)(c >> 5) * DM + 8 * (c & 31)); } } while (0)
#define XA_WRITEK() do { _Pragma("unroll") for (int i = 0; i < 16; ++i) { const int c = tid + 512 * i; *(LAS u32x4*)(lds + (c >> 5) * XA_KROW + 16 * (c & 31)) = st[i]; } } while (0)
#define XA_LOADV(Vg_) do { _Pragma("unroll") for (int i = 0; i < 16; ++i) { const int c = tid + 512 * i; st[i] = *(const u32x4*)((Vg_) + (size_t)(c >> 5) * MVT_LD + 8 * (c & 31)); } } while (0)
#define XA_WRITEV() do { _Pragma("unroll") for (int i = 0; i < 16; ++i) { const int c = tid + 512 * i, pc = c & 31; LAS unsigned char* d_ = lds + (c >> 5) * XA_VROW + 32 * (pc >> 1) + 8 * (pc & 1); \
            *(LAS u32x2*)d_ = (u32x2){st[i].x, st[i].y}; *(LAS u32x2*)(d_ + 16) = (u32x2){st[i].z, st[i].w}; } } while (0)
    u32x4 st[16];
    for (int U = vcu; U < NB * MH * 8; U += G) {
        const int bm = U >> 3, qblk = U & 7, b = bm >> 2, mh = bm & 3, q0 = qblk * 256 + wave * 32;
        const bf16_t* Vg = MVT + (size_t)(mh * MHD) * MVT_LD + b * MEML;
        const bf16_t* qp = QM + (size_t)(b * SEQ + q0 + r32) * DM + mh * MHD + 8 * hi;
        XA_LOADK(MK + (size_t)(b * MEML) * DM + mh * MHD);
        XA_WRITEK();
        __builtin_amdgcn_sched_barrier(0);
        bf16x8 qa[2], qb[2], qc[2];
#pragma unroll
        for (int sk = 0; sk < 2; ++sk) { qa[sk] = *(const bf16x8*)(qp + 16 * sk); qb[sk] = *(const bf16x8*)(qp + 32 + 16 * sk); qc[sk] = *(const bf16x8*)(qp + 64 + 16 * sk); }
        XA_BAR();
        f32x16 s[8];
#pragma unroll
        for (int kt = 0; kt < 8; ++kt)
#pragma unroll
            for (int r = 0; r < 16; ++r) s[kt][r] = 0.f;
#pragma unroll 1
        for (int sig = 0; sig < 8; ++sig) {
            bf16x8 qd[2];
#pragma unroll
            for (int sk = 0; sk < 2; ++sk) qd[sk] = (sig < 5) ? *(const bf16x8*)(qp + 32 * (sig + 3) + 16 * sk) : qc[sk];
            const LAS unsigned char* kb_ = lds + r32 * XA_KROW + 64 * sig + 16 * hi;
#pragma unroll
            for (int kt = 0; kt < 8; ++kt)
#pragma unroll
                for (int sk = 0; sk < 2; ++sk) { const bf16x8 kf = *(const LAS bf16x8*)(kb_ + kt * 32 * XA_KROW + 32 * sk); s[kt] = MFMA32(kf, qa[sk], s[kt]); }
#pragma unroll
            for (int sk = 0; sk < 2; ++sk) { qa[sk] = qb[sk]; qb[sk] = qc[sk]; qc[sk] = qd[sk]; }
        }
        float mx = s[0][0];
#pragma unroll
        for (int kt = 0; kt < 8; ++kt)
#pragma unroll
            for (int r = 0; r < 16; ++r) mx = fmaxf(mx, s[kt][r]);
        mx = fmaxf(mx, __shfl_xor(mx, 32));
        float sum = 0.f;
#pragma unroll
        for (int kt = 0; kt < 8; ++kt)
#pragma unroll
            for (int r = 0; r < 16; ++r) { s[kt][r] = __builtin_amdgcn_exp2f(s[kt][r] - mx); sum += s[kt][r]; }
        sum += __shfl_xor(sum, 32);
        const float inv = __builtin_amdgcn_rcpf(sum);
        u32x4 pw[16];
#pragma unroll
        for (int ks = 0; ks < 16; ++ks) { const int kt = ks >> 1, r0_ = 8 * (ks & 1);
            pw[ks].x = mm::cvt_pk_bf16(s[kt][r0_ + 0], s[kt][r0_ + 1]); pw[ks].y = mm::cvt_pk_bf16(s[kt][r0_ + 2], s[kt][r0_ + 3]);
            pw[ks].z = mm::cvt_pk_bf16(s[kt][r0_ + 4], s[kt][r0_ + 5]); pw[ks].w = mm::cvt_pk_bf16(s[kt][r0_ + 6], s[kt][r0_ + 7]); }
        __builtin_amdgcn_sched_barrier(0);
        XA_LOADV(Vg);
        XA_BAR();
        XA_WRITEV();
        XA_BAR();
        bf16_t* op = OB + (size_t)(b * SEQ + q0 + r32) * DM + mh * MHD + 4 * hi;
#pragma unroll 1
        for (int dt = 0; dt < 8; ++dt) {
            f32x16 o;
#pragma unroll
            for (int r = 0; r < 16; ++r) o[r] = 0.f;
            const LAS unsigned char* vb_ = lds + (32 * dt + r32) * XA_VROW + 16 * hi;
#pragma unroll
            for (int ks = 0; ks < 16; ++ks) { const bf16x8 vf = *(const LAS bf16x8*)(vb_ + 32 * ks);
                o = MFMA32(vf, __builtin_bit_cast(bf16x8, pw[ks]), o); }
#pragma unroll
            for (int g = 0; g < 4; ++g) { u32x2 w; w.x = mm::cvt_pk_bf16(o[4 * g] * inv, o[4 * g + 1] * inv); w.y = mm::cvt_pk_bf16(o[4 * g + 2] * inv, o[4 * g + 3] * inv);
                *(u32x2*)(op + 32 * dt + 8 * g) = w; }
        }
        XA_BAR();
    }
#undef XA_BAR
#undef XA_LOADK
#undef XA_WRITEK
#undef XA_LOADV
#undef XA_WRITEV
}

constexpr size_t WS_BAR = 2 * MiB + 65536;
#define XB_TMO      128
#define XB_XCNT(j)  (256  + 64 * (j))
#define XB_XSUB(j)  (1280 + 64 * (j))
#define XB_XGEN(j)  (2304 + 64 * (j))
#define XB_TOP      3328
#define XB_TOPGEN   3392
#define XCD_BAR_WORDS 3456
#define XB_SPIN_CAP (1u << 22)
__device__ __forceinline__ unsigned xb_ld(unsigned* q)              { return __hip_atomic_load(q, __ATOMIC_RELAXED, __HIP_MEMORY_SCOPE_AGENT); }
__device__ __forceinline__ unsigned xb_add(unsigned* q, unsigned v) { return __hip_atomic_fetch_add(q, v, __ATOMIC_RELAXED, __HIP_MEMORY_SCOPE_AGENT); }
__device__ __forceinline__ unsigned xb_xcc_id() { return (unsigned)__builtin_amdgcn_s_getreg((3 << 11) | 20) & 0xFu; }
#define XB_SPIN(cond, bar) do { unsigned _sp = 0; while (cond) { __builtin_amdgcn_s_sleep(1); \
    if ((++_sp & 255u) == 0u) { if (xb_ld(&(bar)[XB_TMO])) break; if (_sp > XB_SPIN_CAP) { atomicAdd(&(bar)[XB_TMO], 1u); break; } } } } while (0)
struct XcdBarrier { unsigned* bar; unsigned x; LAS unsigned* cen; };
__device__ __forceinline__ XcdBarrier xcd_barrier_post(unsigned* bar, LAS unsigned* cen) {
    XcdBarrier b; b.bar = bar; b.x = xb_xcc_id(); b.cen = cen;
    if (threadIdx.x == 0) { cen[0] = 0u; cen[1] = 0u; (void)xb_add(&bar[XB_XCNT(b.x)], 1u); }
    return b;
}
__device__ __forceinline__ void xcd_barrier_complete(unsigned* bar, unsigned x, unsigned& nloc, unsigned& nx) {
    const unsigned G = gridDim.x * gridDim.y * gridDim.z;
    unsigned sum, cnt, mine, sp = 0u;
    for (;;) {
        sum = 0u; cnt = 0u; mine = 0u;
#pragma unroll
        for (unsigned j = 0; j < 16; ++j) { const unsigned c = xb_ld(&bar[XB_XCNT(j)]); sum += c; cnt += (c > 0u) ? 1u : 0u; mine = (j == x) ? c : mine; }
        if (sum == G) break;
        __builtin_amdgcn_s_sleep(1);
        if ((++sp & 255u) == 0u) { if (xb_ld(&bar[XB_TMO])) break; if (sp > XB_SPIN_CAP) { atomicAdd(&bar[XB_TMO], 1u); break; } }
    }
    nloc = mine > 0u ? mine : 1u; nx = cnt > 0u ? cnt : 1u;
}
__device__ __forceinline__ void xcd_barrier(XcdBarrier& b) {
    asm volatile("s_waitcnt vmcnt(0)" ::: "memory");
    __syncthreads();
    if (threadIdx.x == 0) {
        unsigned* bar = b.bar;
        __builtin_amdgcn_s_waitcnt(0);
        unsigned nloc = b.cen[0], nx = b.cen[1];
        if (nloc == 0u) { xcd_barrier_complete(bar, b.x, nloc, nx); b.cen[0] = nloc; b.cen[1] = nx; }
        const unsigned old = xb_add(&bar[XB_XSUB(b.x)], 1u);
        const unsigned gen = old / nloc;
        if (old + 1u == (gen + 1u) * nloc) {
            __builtin_amdgcn_fence(__ATOMIC_RELEASE, "agent");
            asm volatile("s_waitcnt vmcnt(0)" ::: "memory");
            const unsigned og = xb_add(&bar[XB_TOP], 1u);
            const unsigned tg = og / nx;
            if (og + 1u == (tg + 1u) * nx) xb_add(&bar[XB_TOPGEN], 1u);
            else XB_SPIN(xb_ld(&bar[XB_TOPGEN]) == tg, bar);
            __builtin_amdgcn_fence(__ATOMIC_ACQUIRE, "agent");
            xb_add(&bar[XB_XGEN(b.x)], 1u);
            asm volatile("s_waitcnt vmcnt(0)" ::: "memory");
        } else {
            XB_SPIN(xb_ld(&bar[XB_XGEN(b.x)]) == gen, bar);
            __builtin_amdgcn_fence(__ATOMIC_ACQUIRE, "agent");
            asm volatile("s_waitcnt vmcnt(0)" ::: "memory");
        }
    }
    __syncthreads();
}

__global__ void __launch_bounds__(512, 2) fwd_kernel(Params p) {
    extern __shared__ __attribute__((aligned(16))) unsigned char lds[];
    cg::grid_group grid = cg::this_grid();
#ifndef ONLY
#define ONLY -1
#endif
#ifdef PMASK
#define RUNP(k) ((PMASK >> (k)) & 1)
#else
#define RUNP(k) (ONLY < 0 || ONLY == (k))
#endif
    const int lo = p.ph_lo, hi = p.ph_hi;
    XcdBarrier xbar = xcd_barrier_post((unsigned*)(p.ws + WS_BAR), (LAS unsigned*)((LAS unsigned char*)lds + 147456));
    LAS unsigned char* l3 = (LAS unsigned char*)lds;
#ifndef FASTMASK
#define FASTMASK 0x6FE
#endif
#define FAST(k) ((FASTMASK >> (k)) & 1)
#ifndef XFOLD
#define XFOLD 1
#endif
#define IN(k) (RUNP(k) && lo <= (k) && (k) < hi)
#ifndef PROBE_PH
#define PROBE_PH -1
#endif
#define STAMP(k) do { if (PROBE_PH >= 0 && blockIdx.x == 0 && threadIdx.x == 0) ((volatile unsigned long long*)(p.ws + WS_CNT + 1024))[k] = __builtin_amdgcn_s_memrealtime(); } while (0)
#define SEAM(k) do { if (lo <= (k) && (k) + 1 < hi) xcd_barrier(xbar); STAMP((k) + 1); } while (0)
    STAMP(0);
    if (hi > 1000) grid.sync();
    if (IN(0)) { phase_prep(p, lds); }
    SEAM(0);
    if (IN(1)) { if (FAST(1)) phase_proj_fast(p, l3); else phase_proj_simple(p); } SEAM(1);
    if (IN(2)) { finalize_colsums(p); if (XFOLD) { __syncthreads(); phase_fold(p, l3); __syncthreads(); } if (FAST(2)) { phase_sb_fast(p, l3); } else { phase_conv_simple(p); phase_sb_simple(p); } } SEAM(2);
    if (IN(3)) { if (FAST(3)) phase_outproj_fast(p, l3); else phase_outproj_simple(p); } SEAM(3);
#ifndef CHAIN
#define CHAIN 1
#endif
    const int rowpm = (CHAIN && XFOLD && FAST(7) && gridDim.x == NTOK / 256 && lo <= 4 && hi >= 8) ? (int)((blockIdx.x & 7) * 32 + (blockIdx.x >> 3)) : -1;
#define SEAMC(k) do { if (rowpm < 0) { SEAM(k); } else { __syncthreads(); STAMP((k) + 1); } } while (0)
    if (IN(4)) { if (XFOLD) phase_scores_fast(p, l3, rowpm); else if (FAST(4)) phase_mq_fast(p, l3); else phase_mq_simple(p); } SEAMC(4);
    if (!XFOLD) { if (IN(5)) { if (FAST(5)) phase_xattn_fast(p, l3); else phase_xattn_simple(p, lds); } SEAM(5); } else STAMP(6);
    if (IN(6)) { if (XFOLD) phase_mo_fold(p, l3, rowpm); else if (FAST(6)) phase_mo_fast(p, l3); else phase_mo_simple(p); } SEAMC(6);
    if (IN(7)) { if (FAST(7)) phase_router_fast(p, l3, rowpm); else phase_router_simple(p); } SEAM(7);
    if (IN(8)) { if (!(FAST(7) && gridDim.x == NTOK / 256)) phase_route(p, lds); }
    if (!(FAST(7) && gridDim.x == NTOK / 256)) SEAM(8); else STAMP(9);
    if (IN(9)) { if (FAST(9)) phase_moe1_fast(p, l3); else phase_moe1_simple(p); } SEAM(9);
    if (IN(10)) { if (FAST(10)) phase_moe2_fast(p, l3); else phase_moe2_simple(p); } SEAM(10);
    if (IN(11)) { phase_final(p); }
    if (PROBE_PH >= 0 && blockIdx.x == 0 && threadIdx.x == 0) {
        STAMP(12);
        volatile unsigned long long* ts = (volatile unsigned long long*)(p.ws + WS_CNT + 1024);
#if PROBE_SEC >= 0
        const unsigned long long d = g_psec[PROBE_SEC] * 8ull, t0 = __builtin_amdgcn_s_memrealtime();
#else
        const unsigned long long d = (ts[PROBE_PH + 1] - ts[PROBE_PH]) * 8ull, t0 = __builtin_amdgcn_s_memrealtime();
#endif
        while (__builtin_amdgcn_s_memrealtime() - t0 < d) __builtin_amdgcn_s_sleep(8);
    }
}

extern "C" void kernel_launch(void* const* d_in, const int* in_sizes, int n_in, void* d_out, int out_size, void* d_ws, size_t ws_size, hipStream_t stream) {
    static int grid = 0;
    if (grid == 0) {
        if (n_in != 24 || out_size != NTOK * DM || ws_size < WS_END) { fprintf(stderr, "kernel_launch: unexpected problem: n_in %d out %d ws %zu\n", n_in, out_size, ws_size); grid = -1; return; }
        int dev = 0, cus = 0, per_cu = 0;
        (void)hipGetDevice(&dev); (void)hipDeviceGetAttribute(&cus, hipDeviceAttributeMultiprocessorCount, dev);
        (void)hipFuncSetAttribute((const void*)fwd_kernel, hipFuncAttributeMaxDynamicSharedMemorySize, LDS_BYTES);
        (void)hipOccupancyMaxActiveBlocksPerMultiprocessor(&per_cu, (const void*)fwd_kernel, 512, LDS_BYTES);
        if (per_cu < 1) { fprintf(stderr, "kernel_launch: occupancy query reports %d blocks per CU\n", per_cu); }
        grid = cus;
    }
    if (grid < 0) return;
    if (hipMemsetAsync(d_ws, 0, WS_ZERO_BYTES, stream) != hipSuccess) { fprintf(stderr, "kernel_launch: hipMemsetAsync failed\n"); return; }
    Params p{};
    const float** f = (const float**)&p;
    for (int i = 0; i < 24; ++i) f[i] = (const float*)d_in[i];
    p.out = (float*)d_out; p.ws = (unsigned char*)d_ws;
#if MK_ONE_LAUNCH
    p.ph_lo = 0; p.ph_hi = NPHASE;
    void* args[] = {&p};
    hipError_t e = hipLaunchCooperativeKernel((void*)fwd_kernel, dim3(grid), dim3(512), args, LDS_BYTES, stream);
    if (e != hipSuccess) fprintf(stderr, "cooperative launch failed: %s\n", hipGetErrorString(e));
#else
    for (int ph = 0; ph < NPHASE; ++ph) {
        p.ph_lo = ph; p.ph_hi = ph + 1;
        void* args[] = {&p};
        hipError_t e = hipLaunchCooperativeKernel((void*)fwd_kernel, dim3(grid), dim3(512), args, LDS_BYTES, stream);
        if (e != hipSuccess) { fprintf(stderr, "launch %d failed: %s\n", ph, hipGetErrorString(e)); break; }
    }
#endif
}
```
